# Optimizing an MI355X kernel written in HIP

```python
import math
import jax
import jax.numpy as jnp
from jax import lax
import numpy as np

D_MODEL = 1024
BATCH = 2
SEQ = 16384
DEPTH = 2

GRID_W = 64
CTX_LEN = 256

HY_WIDTH = D_MODEL // 4
NA_HEAD_DIM = 64
NA_WIDTH = D_MODEL // 2
NA_HEADS = NA_WIDTH // NA_HEAD_DIM
LRU_WIDTH = D_MODEL // 4
LRU_BLOCKS = 4
MIX_WIDTH = HY_WIDTH + NA_WIDTH + LRU_WIDTH
IN_WIDTH = 3 * HY_WIDTH + 3 * NA_WIDTH + 2 * LRU_WIDTH

HY_ORDER = 2
HY_SHORT_CONV = 3
HY_BANDS = 16
HY_EMB = 2 * HY_BANDS + 1
HY_FILTER_HIDDEN = 64
HY_FAST_DECAY = 0.3
HY_SLOW_DECAY = 1.5
HY_DECAY_TARGET = 1e-2

NA_WIN_ROWS = 8
NA_WIN_COLS = 16
NA_COL_BLOCK = 16
NA_KEY_COLS = 32

LRU_CONV = 4
LRU_C = 8.0

D_FF = -(-8 * D_MODEL // (3 * 256)) * 256
RMS_EPS = 1e-6
NEG_INF = -1e30

kernel_name = 'hybrid_hyena_natten_rglru_diffusion_block'


def rmsnorm(x, g):
    xf = x.astype(jnp.float32)
    y = xf * lax.rsqrt(jnp.mean(xf * xf, axis=-1, keepdims=True) + RMS_EPS)
    return (y * g.astype(jnp.float32)).astype(x.dtype)


def modulation(cond, w, b):
    m = jax.nn.silu(cond) @ w + b
    return jnp.split(m, 6, axis=-1)


def conv_centred(x, w, b):
    K = w.shape[0]
    L = x.shape[1]
    pl = K // 2
    pr = K - 1 - pl
    xp = jnp.pad(x, ((0, 0), (pl, pr), (0, 0)))
    y = b
    for k in range(K):
        y = y + w[k] * xp[:, k:k + L]
    return y


def hyena_filters(L, f_w1, f_b1, f_w2, f_b2, f_w3, f_freq):
    t = jnp.arange(L, dtype=jnp.float32) / L
    bands = jnp.arange(1, HY_BANDS + 1, dtype=jnp.float32)
    ang = 2.0 * math.pi * t[:, None] * bands[None, :]
    z = jnp.concatenate([t[:, None], jnp.cos(ang), jnp.sin(ang)], axis=-1)
    h = jnp.sin(f_freq[0] * (z @ f_w1 + f_b1))
    h = jnp.sin(f_freq[1] * (h @ f_w2 + f_b2))
    k = (h @ f_w3).astype(jnp.float32).reshape(L, HY_ORDER, 2, HY_WIDTH)
    deltas = jnp.abs(jnp.linspace(math.log(HY_DECAY_TARGET) / HY_FAST_DECAY,
                                  math.log(HY_DECAY_TARGET) / HY_SLOW_DECAY,
                                  HY_WIDTH, dtype=jnp.float32))
    k = k * jnp.exp(-t[:, None, None, None] * deltas)
    kf = k[:, :, 0]
    kb = k[:, :, 1]
    k_circ = jnp.concatenate([kf, jnp.zeros_like(kf[:1]), kb[:0:-1]], axis=0)
    k_circ = k_circ / jnp.sum(jnp.abs(k_circ), axis=0, keepdims=True)
    return jnp.fft.rfft(k_circ, axis=0)


def fft_conv(u, k_f):
    L = u.shape[1]
    U = jnp.fft.rfft(u, n=2 * L, axis=1)
    return jnp.fft.irfft(U * k_f[None], n=2 * L, axis=1)[:, :L]


def hyena_mixer(p, conv_w, conv_b, filt, hy_bias):
    L = p.shape[1]
    u = conv_centred(p, conv_w, conv_b).astype(jnp.float32)
    v, x1, x2 = jnp.split(u, 3, axis=-1)
    k_f = hyena_filters(L, *filt)
    z = v
    for n, gate in enumerate((x1, x2)):
        z = gate * (fft_conv(z, k_f[:, n]) + hy_bias[n].astype(jnp.float32) * z)
    return z


def na_static(grid_w):
    n_cb = grid_w // NA_COL_BLOCK
    qc = np.arange(grid_w).reshape(n_cb, NA_COL_BLOCK)
    kc0 = np.clip(np.arange(n_cb) * NA_COL_BLOCK - NA_WIN_COLS // 2, 0, grid_w - NA_KEY_COLS)
    kc = kc0[:, None] + np.arange(NA_KEY_COLS)[None, :]
    start = np.clip(qc - NA_WIN_COLS // 2, 0, grid_w - NA_WIN_COLS)
    valid = (kc[:, None, :] >= start[:, :, None]) & (kc[:, None, :] < start[:, :, None] + NA_WIN_COLS)
    dc = np.clip(kc[:, None, :] - qc[:, :, None], -(NA_WIN_COLS - 1), NA_WIN_COLS - 1) + NA_WIN_COLS - 1
    return kc, valid, dc


def na_latent(q, k, v, k_ctx, v_ctx, rpb, rows):
    B, L, H, dh = q.shape
    kr = min(NA_WIN_ROWS, rows)
    kc, valid, dc = na_static(GRID_W)
    n_cb = kc.shape[0]
    n_loc = kr * NA_KEY_COLS
    scale = dh ** -0.5
    valid = jnp.asarray(valid)[:, :, None, :]
    qg = q.reshape(B, rows, n_cb, NA_COL_BLOCK, H, dh).transpose(1, 0, 4, 2, 3, 5)
    kg = k.reshape(B, rows, GRID_W, H, dh).transpose(0, 3, 1, 2, 4)
    vg = v.reshape(B, rows, GRID_W, H, dh).transpose(0, 3, 1, 2, 4)
    kcx = k_ctx.transpose(0, 2, 1, 3)
    vcx = v_ctx.transpose(0, 2, 1, 3)

    def row_step(args):
        q_r, r = args
        rs = jnp.clip(r - kr // 2, 0, rows - kr)
        k_blk = lax.dynamic_slice_in_dim(kg, rs, kr, axis=2)[:, :, :, kc]
        v_blk = lax.dynamic_slice_in_dim(vg, rs, kr, axis=2)[:, :, :, kc]
        s_loc = jnp.einsum('bhnqd,bhrnkd->bhnqrk', q_r, k_blk).astype(jnp.float32) * scale
        dr = rs + jnp.arange(kr) - r + NA_WIN_ROWS - 1
        bias = rpb[:, dr][:, :, dc].transpose(0, 2, 3, 1, 4)
        s_loc = jnp.where(valid, s_loc + bias[None].astype(jnp.float32), NEG_INF)
        s_ctx = jnp.einsum('bhnqd,bhcd->bhnqc', q_r, kcx).astype(jnp.float32) * scale
        s = jnp.concatenate([s_loc.reshape(B, H, n_cb, NA_COL_BLOCK, n_loc), s_ctx], axis=-1)
        p = jax.nn.softmax(s, axis=-1)
        p_loc = p[..., :n_loc].reshape(B, H, n_cb, NA_COL_BLOCK, kr, NA_KEY_COLS).astype(v.dtype)
        p_ctx = p[..., n_loc:].astype(v.dtype)
        return (jnp.einsum('bhnqrk,bhrnkd->bhnqd', p_loc, v_blk)
                + jnp.einsum('bhnqc,bhcd->bhnqd', p_ctx, vcx))

    o = lax.map(row_step, (qg, jnp.arange(rows)))
    return o.transpose(1, 0, 3, 4, 2, 5).reshape(B, L, H * dh)


def attn_ctx(q, k, v):
    B, Lc, H, dh = q.shape
    s = jnp.einsum('bqhd,bkhd->bhqk', q, k).astype(jnp.float32) * (dh ** -0.5)
    p = jax.nn.softmax(s, axis=-1).astype(v.dtype)
    return jnp.einsum('bhqk,bkhd->bqhd', p, v).reshape(B, Lc, H * dh)


def linear_scan(a, b, h0, reverse):
    idx = -1 if reverse else 0
    b = b.at[:, idx].add(a[:, idx] * h0)

    def combine(e1, e2):
        a1, b1 = e1
        a2, b2 = e2
        return a1 * a2, a2 * b1 + b2

    _, h = lax.associative_scan(combine, (a, b), reverse=reverse, axis=1)
    return h


def rglru_coeffs(u, wa, ba, wi, bi, lam):
    B, L, C = u.shape
    ub = u.reshape(B, L, LRU_BLOCKS, C // LRU_BLOCKS)
    r = jax.nn.sigmoid(jnp.einsum('blnc,ncd->blnd', ub, wa.astype(jnp.float32)).reshape(B, L, C) + ba)
    i = jax.nn.sigmoid(jnp.einsum('blnc,ncd->blnd', ub, wi.astype(jnp.float32)).reshape(B, L, C) + bi)
    log_a = -LRU_C * r * jax.nn.softplus(-lam.astype(jnp.float32))
    a = jnp.exp(log_a)
    b = jnp.sqrt(-jnp.expm1(2.0 * log_a)) * (i * u)
    return a, b


def lru_mixer(p, pc, conv_w, conv_b, wa, ba, wi, bi, lam, with_ctx_out):
    xr, xg = jnp.split(p, 2, axis=-1)
    xr_c, xg_c = jnp.split(pc, 2, axis=-1)
    u = conv_centred(xr, conv_w, conv_b).astype(jnp.float32)
    u_c = conv_centred(xr_c, conv_w, conv_b).astype(jnp.float32)
    h_lat = 0.0
    h_ctx = 0.0
    for d, rev in enumerate((False, True)):
        a_c, b_c = rglru_coeffs(u_c, wa[d], ba[d], wi[d], bi[d], lam[d])
        hc = linear_scan(a_c, b_c, jnp.zeros_like(b_c[:, 0]), rev)
        h_end = hc[:, 0] if rev else hc[:, -1]
        a_l, b_l = rglru_coeffs(u, wa[d], ba[d], wi[d], bi[d], lam[d])
        h_lat = h_lat + linear_scan(a_l, b_l, h_end, rev)
        h_ctx = h_ctx + hc
    y = (h_lat * jax.nn.gelu(xg.astype(jnp.float32))).astype(p.dtype)
    if not with_ctx_out:
        return y, None
    yc = (h_ctx * jax.nn.gelu(xg_c.astype(jnp.float32))).astype(p.dtype)
    return y, yc


def mixer(h, hc, rows, with_ctx_out, w_in, w_out, hy_conv_w, hy_conv_b, hy_filt, hy_bias, na_rpb, lru_params):
    B, L, _ = h.shape
    Lc = hc.shape[1]
    s1 = 3 * HY_WIDTH
    s2 = s1 + 3 * NA_WIDTH
    p = h @ w_in
    pc = hc @ w_in
    y_hy = hyena_mixer(p[..., :s1], hy_conv_w, hy_conv_b, hy_filt, hy_bias).astype(h.dtype)
    qkv = p[..., s1:s2].reshape(B, L, 3, NA_HEADS, NA_HEAD_DIM)
    qkv_c = pc[..., s1:s2].reshape(B, Lc, 3, NA_HEADS, NA_HEAD_DIM)
    y_na = na_latent(qkv[:, :, 0], qkv[:, :, 1], qkv[:, :, 2], qkv_c[:, :, 1], qkv_c[:, :, 2], na_rpb, rows)
    y_lru, yc_lru = lru_mixer(p[..., s2:], pc[..., s2:], *lru_params, with_ctx_out)
    y = jnp.concatenate([y_hy, y_na, y_lru], axis=-1) @ w_out
    if not with_ctx_out:
        return y, None
    yc_hy = hyena_mixer(pc[..., :s1], hy_conv_w, hy_conv_b, hy_filt, hy_bias).astype(hc.dtype)
    yc_na = attn_ctx(qkv_c[:, :, 0], qkv_c[:, :, 1], qkv_c[:, :, 2])
    yc = jnp.concatenate([yc_hy, yc_na, yc_lru], axis=-1) @ w_out
    return y, yc


def swiglu(h, w_gu, w_down):
    g, u = jnp.split(h @ w_gu, 2, axis=-1)
    return (jax.nn.silu(g) * u) @ w_down


def setup_inputs(seed: int = 0) -> dict:
    key = jax.random.key(seed)
    ks = jax.random.split(key, 32)
    f32 = jnp.float32
    D = D_MODEL
    blk = LRU_WIDTH // LRU_BLOCKS

    def nrm(i, shape, scale):
        return scale * jax.random.normal(ks[i], shape, f32)

    a8 = jax.random.uniform(ks[28], (DEPTH, 2, LRU_WIDTH), f32, 0.9, 0.999)
    a_base = a8 ** (1.0 / LRU_C)
    lru_lam = jnp.log(a_base) - jnp.log1p(-a_base)
    return {
        'x': nrm(0, (BATCH, SEQ, D), 1.0),
        'c': nrm(1, (BATCH, D), 1.0),
        'ctx': nrm(2, (BATCH, CTX_LEN, D), 1.0),
        'c_ctx': nrm(3, (D,), 1.0),
        'ada_w': nrm(4, (DEPTH, D, 6 * D), D ** -0.5),
        'ada_b': nrm(5, (DEPTH, 6 * D), 0.02),
        'g_mix_pre': 1.0 + nrm(6, (DEPTH, D), 0.02),
        'g_mix_post': 1.0 + nrm(7, (DEPTH, D), 0.02),
        'g_ffn_pre': 1.0 + nrm(8, (DEPTH, D), 0.02),
        'g_ffn_post': 1.0 + nrm(9, (DEPTH, D), 0.02),
        'w_in': nrm(10, (DEPTH, D, IN_WIDTH), D ** -0.5),
        'w_out': nrm(11, (DEPTH, MIX_WIDTH, D), MIX_WIDTH ** -0.5),
        'hy_conv_w': nrm(12, (DEPTH, HY_SHORT_CONV, 3 * HY_WIDTH), HY_SHORT_CONV ** -0.5),
        'hy_conv_b': nrm(13, (DEPTH, 3 * HY_WIDTH), 0.02),
        'hy_f_w1': nrm(14, (DEPTH, HY_EMB, HY_FILTER_HIDDEN), HY_EMB ** -0.5),
        'hy_f_b1': nrm(15, (DEPTH, HY_FILTER_HIDDEN), 0.02),
        'hy_f_w2': nrm(16, (DEPTH, HY_FILTER_HIDDEN, HY_FILTER_HIDDEN), HY_FILTER_HIDDEN ** -0.5),
        'hy_f_b2': nrm(17, (DEPTH, HY_FILTER_HIDDEN), 0.02),
        'hy_f_w3': nrm(18, (DEPTH, HY_FILTER_HIDDEN, HY_ORDER * 2 * HY_WIDTH), HY_FILTER_HIDDEN ** -0.5),
        'hy_f_freq': 1.0 + nrm(19, (DEPTH, 2, HY_FILTER_HIDDEN), 0.1),
        'hy_bias': nrm(20, (DEPTH, HY_ORDER, HY_WIDTH), 1.0),
        'na_rpb': nrm(21, (DEPTH, NA_HEADS, 2 * NA_WIN_ROWS - 1, 2 * NA_WIN_COLS - 1), 0.02),
        'lru_conv_w': nrm(22, (DEPTH, LRU_CONV, LRU_WIDTH), LRU_CONV ** -0.5),
        'lru_conv_b': nrm(23, (DEPTH, LRU_WIDTH), 0.02),
        'lru_wa': nrm(24, (DEPTH, 2, LRU_BLOCKS, blk, blk), blk ** -0.5),
        'lru_ba': nrm(25, (DEPTH, 2, LRU_WIDTH), 0.02),
        'lru_wi': nrm(26, (DEPTH, 2, LRU_BLOCKS, blk, blk), blk ** -0.5),
        'lru_bi': nrm(27, (DEPTH, 2, LRU_WIDTH), 0.02),
        'lru_lam': lru_lam,
        'ffn_w_gu': nrm(29, (DEPTH, D, 2 * D_FF), D ** -0.5),
        'ffn_w_down': nrm(30, (DEPTH, D_FF, D), D_FF ** -0.5),
    }


def reference(x, c, ctx, c_ctx, ada_w, ada_b, g_mix_pre, g_mix_post, g_ffn_pre, g_ffn_post,
              w_in, w_out, hy_conv_w, hy_conv_b, hy_f_w1, hy_f_b1, hy_f_w2, hy_f_b2, hy_f_w3,
              hy_f_freq, hy_bias, na_rpb, lru_conv_w, lru_conv_b, lru_wa, lru_ba, lru_wi, lru_bi,
              lru_lam, ffn_w_gu, ffn_w_down):
    rows = x.shape[1] // GRID_W
    xc = ctx
    for l in range(DEPTH):
        with_ctx_out = l < DEPTH - 1
        sh_m, sc_m, gt_m, sh_f, sc_f, gt_f = [t[:, None, :] for t in modulation(c, ada_w[l], ada_b[l])]
        csh_m, csc_m, cgt_m, csh_f, csc_f, cgt_f = modulation(c_ctx, ada_w[l], ada_b[l])

        h = rmsnorm(x, g_mix_pre[l]) * (1.0 + sc_m) + sh_m
        hc = rmsnorm(xc, g_mix_pre[l]) * (1.0 + csc_m) + csh_m
        hy_filt = (hy_f_w1[l], hy_f_b1[l], hy_f_w2[l], hy_f_b2[l], hy_f_w3[l], hy_f_freq[l])
        lru_params = (lru_conv_w[l], lru_conv_b[l], lru_wa[l], lru_ba[l], lru_wi[l], lru_bi[l], lru_lam[l])
        y, yc = mixer(h, hc, rows, with_ctx_out, w_in[l], w_out[l], hy_conv_w[l], hy_conv_b[l],
                      hy_filt, hy_bias[l], na_rpb[l], lru_params)
        x = x + gt_m * rmsnorm(y, g_mix_post[l])

        h = rmsnorm(x, g_ffn_pre[l]) * (1.0 + sc_f) + sh_f
        x = x + gt_f * rmsnorm(swiglu(h, ffn_w_gu[l], ffn_w_down[l]), g_ffn_post[l])

        if with_ctx_out:
            xc = xc + cgt_m * rmsnorm(yc, g_mix_post[l])
            hc = rmsnorm(xc, g_ffn_pre[l]) * (1.0 + csc_f) + csh_f
            xc = xc + cgt_f * rmsnorm(swiglu(hc, ffn_w_gu[l], ffn_w_down[l]), g_ffn_post[l])
    return x
```

```cpp
#include <hip/hip_runtime.h>
#include <cstdio>
#include <cstdint>
#include <cmath>

#define LAS __attribute__((address_space(3)))
typedef unsigned short bf16_t;
typedef short bf16x8 __attribute__((ext_vector_type(8)));
typedef float f32x4 __attribute__((ext_vector_type(4)));
typedef float f32x2 __attribute__((ext_vector_type(2)));
typedef unsigned u32x4 __attribute__((ext_vector_type(4)));
typedef unsigned u32x2 __attribute__((ext_vector_type(2)));

constexpr int D = 1024, NB = 2, SEQ = 16384, DEPTH = 2, GRIDW = 64, GROWS = 256, CTXL = 256;
constexpr int NLAT = NB * SEQ, NCTX = NB * CTXL, MT = NLAT + NCTX;
constexpr int HYW = 256, NAW = 512, NHEAD = 8, DH = 64, LRW = 256, INW = 2816, DFF = 2816;
constexpr int NPTV = 1280;
constexpr int NQKL = 1536;
constexpr int FPOS = SEQ + CTXL;

constexpr size_t MiB = 1u << 20;
constexpr size_t WS_CTL = 0;
constexpr size_t WS_WIN = 1 * MiB, WS_WOUT = 12 * MiB, WS_WGU = 16 * MiB, WS_WDN = 38 * MiB;
constexpr size_t WS_MOD = 49 * MiB;
constexpr size_t WS_XC = 50 * MiB;
constexpr size_t WS_H2 = 52 * MiB;
constexpr size_t WS_KN = 61 * MiB;
constexpr size_t WS_H = 64 * MiB;
constexpr size_t WS_Y = 129 * MiB;
constexpr size_t WS_PTV = 194 * MiB;
constexpr size_t WS_QKL = WS_PTV + (size_t)NPTV * MT * 2;
constexpr size_t WS_ACT = WS_PTV;
constexpr size_t WS_YMIX = 373 * MiB;
constexpr size_t WS_KF = 438 * MiB;
constexpr size_t WS_KFC = 502 * MiB;
constexpr size_t WS_END = 504 * MiB;
constexpr size_t WS_HF = WS_H, WS_HR = WS_H + (size_t)MT * LRW * 4;
constexpr size_t WS_Z1 = WS_Y;
static_assert(WS_QKL + (size_t)MT * NQKL * 2 <= WS_YMIX && WS_ACT + (size_t)MT * DFF * 2 <= WS_YMIX, "ws map");
static_assert(WS_HR + (size_t)MT * LRW * 4 <= WS_Y && WS_Z1 + (size_t)256 * 2 * SEQ * 4 <= WS_PTV, "ws map");

__device__ __forceinline__ unsigned f2bf(float f) { unsigned u = __float_as_uint(f); return (u + 0x7fffu + ((u >> 16) & 1u)) >> 16; }
__device__ __forceinline__ unsigned pk2(float lo, float hi) { return f2bf(lo) | (f2bf(hi) << 16); }
__device__ __forceinline__ float bf2f(unsigned h) { return __uint_as_float(h << 16); }
__device__ __forceinline__ float wave_sum(float v) {
#pragma unroll
    for (int o = 1; o < 64; o <<= 1) v += __shfl_xor(v, o);
    return v;
}
__device__ __forceinline__ float wave_max(float v) {
#pragma unroll
    for (int o = 1; o < 64; o <<= 1) v = fmaxf(v, __shfl_xor(v, o));
    return v;
}
__device__ __forceinline__ float silu_f(float g) { return g * __builtin_amdgcn_rcpf(1.0f + __builtin_amdgcn_exp2f(-1.44269504089f * g)); }
__device__ __forceinline__ float sigmoid_f(float g) { return 1.0f / (1.0f + expf(-g)); }
__device__ __forceinline__ float gelu_tanh(float x) { const float u = 0.7978845608028654f * (x + 0.044715f * x * x * x); return 0.5f * x * (1.0f + tanhf(u)); }

namespace pg8 {
constexpr int BM = 256, BK = 64, HALF = 128, HTB = HALF * BK * 2, STAGE_BYTES = 8 * HTB;
__host__ __device__ __forceinline__ int lds_byte(int r, int c) { const int st = (r >> 4) * 2 + (c >> 5), rr = r & 15, cc = c & 31, ob = rr * 64 + cc * 2; return st * 1024 + (ob ^ (((ob >> 9) & 1) << 5)); }
__host__ __device__ __forceinline__ void stage_rc(int b, int& R, int& C) { const int st = b / 1024, sb = b % 1024, swz = sb ^ (((sb >> 9) & 1) << 5); R = (st >> 1) * 16 + swz / 64; C = (st & 1) * 32 + (swz % 64) / 2; }
__host__ __device__ __forceinline__ int perm32(int rho) { const int n = rho >> 4, i = rho & 15; return 8 * (i >> 2) + 4 * n + (i & 3); }

struct GSeg { const bf16_t* A; const bf16_t* B; bf16_t* C; int nM, nN, ldc, epi; };
struct GPhase { GSeg s0, s1; int n0, total, K, pad; };
struct Unit { const char* a; const char* b; bf16_t* C; int ldc, epi, pm, pn; };

struct Sched {
    GPhase ph; int G, c;
    __device__ __forceinline__ bool next(int i, Unit& u) const {
        const long L = (long)i * G + c; if (L >= ph.total) return false;
        int wgid = (int)L; { const int nwg = ph.total, q = nwg / 8, r = nwg % 8, xcd = wgid % 8, off = wgid / 8; wgid = (xcd < r ? xcd * (q + 1) : r * (q + 1) + (xcd - r) * q) + off; }
        const bool first = wgid < ph.n0; if (!first) wgid -= ph.n0;
        const bf16_t* A = first ? ph.s0.A : ph.s1.A; const bf16_t* B = first ? ph.s0.B : ph.s1.B; bf16_t* C = first ? ph.s0.C : ph.s1.C;
        const int nM = first ? ph.s0.nM : ph.s1.nM, nN = first ? ph.s0.nN : ph.s1.nN;
        u.ldc = first ? ph.s0.ldc : ph.s1.ldc; u.epi = first ? ph.s0.epi : ph.s1.epi; u.C = C;
        const int nig = 8 * nN, gid = wgid / nig, fm = gid * 8, gsz = (nM - fm) < 8 ? (nM - fm) : 8;
        u.pm = fm + ((wgid % nig) % gsz); u.pn = (wgid % nig) / gsz;
        u.a = (const char*)A + (size_t)u.pm * BM * ph.K * 2; u.b = (const char*)B + (size_t)u.pn * BM * ph.K * 2;
        return true;
    }
};

__device__ __forceinline__ unsigned cvt_pk_bf16(float lo, float hi) { unsigned r; asm volatile("v_cvt_pk_bf16_f32 %0, %1, %2" : "=v"(r) : "v"(lo), "v"(hi)); return r; }

struct Epi {
    __device__ __forceinline__ void operator()(const f32x4 (&acc)[2][2][4][2], const Unit& u, int wr, int wc, int fr, int fq) const {
        const int row0 = u.pm * BM + wr * 64 + fr;
        if (u.epi == 0) {
            const int col0 = u.pn * BM + wc * 32 + 8 * fq;
#pragma unroll
            for (int ai = 0; ai < 2; ++ai)
#pragma unroll
                for (int m = 0; m < 4; ++m) { bf16_t* rowp = u.C + (size_t)(row0 + ai * HALF + m * 16) * u.ldc + col0;
#pragma unroll
                    for (int bj = 0; bj < 2; ++bj) { const f32x4 v0 = acc[ai][bj][m][0], v1 = acc[ai][bj][m][1];
                        u32x4 w; w.x = cvt_pk_bf16(v0[0], v0[1]); w.y = cvt_pk_bf16(v0[2], v0[3]); w.z = cvt_pk_bf16(v1[0], v1[1]); w.w = cvt_pk_bf16(v1[2], v1[3]);
                        *(u32x4*)(rowp + bj * HALF) = w; } }
        } else {
            const int col0 = u.pn * HALF + wc * 32 + 8 * fq;
#pragma unroll
            for (int ai = 0; ai < 2; ++ai)
#pragma unroll
                for (int m = 0; m < 4; ++m) { bf16_t* rowp = u.C + (size_t)(row0 + ai * HALF + m * 16) * u.ldc + col0;
                    const f32x4 g0 = acc[ai][0][m][0], g1 = acc[ai][0][m][1], u0 = acc[ai][1][m][0], u1 = acc[ai][1][m][1];
                    u32x4 w; w.x = cvt_pk_bf16(silu_f(g0[0]) * u0[0], silu_f(g0[1]) * u0[1]); w.y = cvt_pk_bf16(silu_f(g0[2]) * u0[2], silu_f(g0[3]) * u0[3]);
                    w.z = cvt_pk_bf16(silu_f(g1[0]) * u1[0], silu_f(g1[1]) * u1[1]); w.w = cvt_pk_bf16(silu_f(g1[2]) * u1[2], silu_f(g1[3]) * u1[3]);
                    *(u32x4*)rowp = w; }
        }
    }
};

__device__ __forceinline__ void gemm_phase(LAS unsigned char* lds, const Sched& S, const Epi& E) {
    const int tid = threadIdx.x, wid = __builtin_amdgcn_readfirstlane(tid >> 6), lane = tid & 63, wr = wid >> 2, wc = wid & 3, fr = lane & 15, fq = lane >> 4;
    const int K = S.ph.K, nt = K / BK;
    unsigned voffA[2], voffB[2];
#pragma unroll
    for (int i = 0; i < 2; ++i) { int R, C; stage_rc(tid * 16 + i * 8192, R, C); const int Rb = (R & ~31) + perm32(R & 31);
        voffA[i] = (unsigned)(R * K + C) * 2u; voffB[i] = (unsigned)(Rb * K + C) * 2u; }
    const size_t kstep = (size_t)(BK * 2);
    const size_t hstep = (size_t)HALF * K * 2;
    const unsigned ldsw = (unsigned)wid * 1024u;
    const int aoff = lds_byte(wr * 64 + fr, fq * 8), boff = lds_byte(wc * 32 + fr, fq * 8);
#define PG8_SA(b, h) (((b) * 2 + (h)) * HTB)
#define PG8_SB(b, h) ((4 + (b) * 2 + (h)) * HTB)
#define PG8_STAGE(bufoff, gbase, voff) do { _Pragma("unroll") for (int _i = 0; _i < 2; ++_i) \
        __builtin_amdgcn_global_load_lds((const unsigned*)((const char*)(gbase) + (voff)[_i]), (LAS unsigned*)(lds + (bufoff) + ldsw + _i * 8192), 16, 0, 0); } while (0)
#define PG8_LDA(dst, b, h) do { _Pragma("unroll") for (int m = 0; m < 4; ++m) _Pragma("unroll") for (int k = 0; k < 2; ++k) dst[m][k] = *(const LAS bf16x8*)(lds + PG8_SA(b, h) + aoff + m * 2048 + k * 1024); } while (0)
#define PG8_LDB(dst, b, h) do { _Pragma("unroll") for (int n = 0; n < 2; ++n) _Pragma("unroll") for (int k = 0; k < 2; ++k) dst[n][k] = *(const LAS bf16x8*)(lds + PG8_SB(b, h) + boff + n * 2048 + k * 1024); } while (0)
#define PG8_MMA(ai, bj, At, Bt) do { __builtin_amdgcn_s_setprio(1); _Pragma("unroll") for (int m = 0; m < 4; ++m) _Pragma("unroll") for (int n = 0; n < 2; ++n) _Pragma("unroll") for (int k = 0; k < 2; ++k) \
        acc[ai][bj][m][n] = __builtin_amdgcn_mfma_f32_16x16x32_bf16(Bt[n][k], At[m][k], acc[ai][bj][m][n], 0, 0, 0); __builtin_amdgcn_s_setprio(0); } while (0)
#define PG8_WAIT_V(n) asm volatile("s_waitcnt vmcnt(" #n ")" ::: "memory")
#define PG8_WAIT_L(n) asm volatile("s_waitcnt lgkmcnt(" #n ")" ::: "memory")
#define PG8_BAR __builtin_amdgcn_s_barrier()
#define PG8_SCHED __builtin_amdgcn_sched_barrier(0)
    Unit cur, nxt; int ui = 0;
    if (!S.next(0, cur)) return;
    f32x4 acc[2][2][4][2];
#pragma unroll
    for (int a = 0; a < 2; ++a)
#pragma unroll
        for (int b = 0; b < 2; ++b)
#pragma unroll
            for (int m = 0; m < 4; ++m)
#pragma unroll
                for (int n = 0; n < 2; ++n) acc[a][b][m][n] = (f32x4){0.f, 0.f, 0.f, 0.f};
    bf16x8 At[4][2], B0[2][2], B1[2][2];
    const char* cA = cur.a; const char* cB = cur.b;
    PG8_STAGE(PG8_SB(0, 0), cB, voffB); PG8_STAGE(PG8_SB(0, 1), cB + hstep, voffB); PG8_STAGE(PG8_SA(0, 0), cA, voffA); PG8_STAGE(PG8_SA(0, 1), cA + hstep, voffA);
    if (wr == 1) PG8_BAR;
    PG8_WAIT_V(2); PG8_BAR;
    PG8_STAGE(PG8_SB(1, 0), cB + kstep, voffB); PG8_STAGE(PG8_SA(1, 0), cA + kstep, voffA); PG8_STAGE(PG8_SB(1, 1), cB + hstep + kstep, voffB);
    PG8_WAIT_V(6); PG8_BAR;
    for (;;) {
        const bool has_next = S.next(ui + 1, nxt);
        const char* nA = has_next ? nxt.a : cA; const char* nB = has_next ? nxt.b : cB;
        for (int t = 0; t < nt; t += 2) {
            const bool last = (t == nt - 2);
            const char* a1 = cA + (size_t)(t + 1) * kstep;
            const char* a2 = last ? nA : cA + (size_t)(t + 2) * kstep; const char* b2 = last ? nB : cB + (size_t)(t + 2) * kstep;
            const char* a3 = a2 + kstep; const char* b3 = b2 + kstep;
            PG8_LDB(B0, 0, 0); PG8_LDB(B1, 0, 1); PG8_SCHED; PG8_LDA(At, 0, 0); PG8_STAGE(PG8_SA(1, 1), a1 + hstep, voffA);
            PG8_WAIT_V(8); PG8_WAIT_L(0); PG8_BAR; PG8_MMA(0, 0, At, B0); PG8_MMA(0, 1, At, B1); PG8_BAR; PG8_SCHED;
            PG8_LDA(At, 0, 1); PG8_STAGE(PG8_SB(0, 0), b2, voffB); PG8_STAGE(PG8_SB(0, 1), b2 + hstep, voffB); PG8_STAGE(PG8_SA(0, 0), a2, voffA);
            PG8_WAIT_V(8); PG8_WAIT_L(0); PG8_BAR; PG8_MMA(1, 0, At, B0); PG8_MMA(1, 1, At, B1); PG8_BAR; PG8_SCHED;
            PG8_LDB(B0, 1, 0); PG8_LDB(B1, 1, 1); PG8_SCHED; PG8_LDA(At, 1, 0); PG8_STAGE(PG8_SA(0, 1), a2 + hstep, voffA);
            PG8_WAIT_V(8); PG8_WAIT_L(0); PG8_BAR; PG8_MMA(0, 0, At, B0); PG8_MMA(0, 1, At, B1); PG8_BAR; PG8_SCHED;
            PG8_LDA(At, 1, 1); PG8_STAGE(PG8_SB(1, 0), b3, voffB); PG8_STAGE(PG8_SB(1, 1), b3 + hstep, voffB); PG8_STAGE(PG8_SA(1, 0), a3, voffA);
            PG8_WAIT_V(8); PG8_WAIT_L(0); PG8_BAR; PG8_MMA(1, 0, At, B0); PG8_MMA(1, 1, At, B1); PG8_BAR; PG8_SCHED;
        }
        if (wr == 0) PG8_BAR;
        E(acc, cur, wr, wc, fr, fq);
        if (!has_next) break;
#pragma unroll
        for (int a = 0; a < 2; ++a)
#pragma unroll
            for (int b = 0; b < 2; ++b)
#pragma unroll
                for (int m = 0; m < 4; ++m)
#pragma unroll
                    for (int n = 0; n < 2; ++n) acc[a][b][m][n] = (f32x4){0.f, 0.f, 0.f, 0.f};
        cur = nxt; cA = nA; cB = nB; ++ui;
        if (wr == 1) PG8_BAR;
    }
    PG8_WAIT_V(0);
    PG8_BAR;
#undef PG8_SA
#undef PG8_SB
#undef PG8_STAGE
#undef PG8_LDA
#undef PG8_LDB
#undef PG8_MMA
#undef PG8_WAIT_V
#undef PG8_WAIT_L
#undef PG8_BAR
#undef PG8_SCHED
}
}
__device__ __forceinline__ int wrowmap(int kind, int n0) {
    if (kind == 0) { if (n0 < 768) return n0; if (n0 < 1792) return 1280 + (n0 - 768); if (n0 < 2304) return 768 + (n0 - 1792); return n0; }
    if (kind == 2) { if (n0 < DFF) return 256 * (n0 / 128) + (n0 % 128); const int m = n0 - DFF; return 256 * (m / 128) + 128 + (m % 128); }
    return n0;
}
__device__ __forceinline__ void transpose_item(const float* W, int K, int N, bf16_t* WT, int kind, LAS float* scr, int item, int lane) {
    const int nblk = N / 32, kb = item / nblk, nb = item % nblk, k0 = 64 * kb, n0 = 32 * nb, r0 = wrowmap(kind, n0);
#pragma unroll 8
    for (int i = 0; i < 32; ++i) { const int kk = 2 * i + (lane >> 5); scr[kk * 33 + (lane & 31)] = W[(size_t)(k0 + kk) * N + n0 + (lane & 31)]; }
    asm volatile("s_waitcnt lgkmcnt(0)" ::: "memory");
    const int c = lane & 7;
#pragma unroll
    for (int j = 0; j < 4; ++j) { const int n = (lane >> 3) + 8 * j; const LAS float* s = scr + (8 * c) * 33 + n;
        u32x4 o; o.x = pk2(s[0 * 33], s[1 * 33]); o.y = pk2(s[2 * 33], s[3 * 33]); o.z = pk2(s[4 * 33], s[5 * 33]); o.w = pk2(s[6 * 33], s[7 * 33]);
        *(u32x4*)(WT + (size_t)(r0 + n) * K + k0 + 8 * c) = o; }
    asm volatile("s_waitcnt lgkmcnt(0)" ::: "memory");
}
constexpr int WI_IN = (D / 64) * (INW / 32), WI_OUT = (D / 64) * (D / 32), WI_GU = (D / 64) * (2 * DFF / 32), WI_DN = (DFF / 64) * (D / 32), WI_LAYER = WI_IN + WI_OUT + WI_GU + WI_DN;
__device__ __forceinline__ void wconv_item(int it, const float* w_in, const float* w_out, const float* w_gu, const float* w_dn, unsigned char* ws, LAS float* scr, int lane) {
    const int l = it / WI_LAYER; int r = it % WI_LAYER;
    if (r < WI_IN) { transpose_item(w_in + (size_t)l * D * INW, D, INW, (bf16_t*)(ws + WS_WIN) + (size_t)l * INW * D, 0, scr, r, lane); return; } r -= WI_IN;
    if (r < WI_OUT) { transpose_item(w_out + (size_t)l * D * D, D, D, (bf16_t*)(ws + WS_WOUT) + (size_t)l * D * D, 1, scr, r, lane); return; } r -= WI_OUT;
    if (r < WI_GU) { transpose_item(w_gu + (size_t)l * D * 2 * DFF, D, 2 * DFF, (bf16_t*)(ws + WS_WGU) + (size_t)l * 2 * DFF * D, 2, scr, r, lane); return; } r -= WI_GU;
    transpose_item(w_dn + (size_t)l * DFF * D, DFF, D, (bf16_t*)(ws + WS_WDN) + (size_t)l * D * DFF, 1, scr, r, lane);
}
__global__ void __launch_bounds__(256) k_wconv(const float* w_in, const float* w_out, const float* w_gu, const float* w_dn, unsigned char* ws) {
    __shared__ float scr_all[4 * 64 * 33];
    const int wave = threadIdx.x >> 6, lane = threadIdx.x & 63;
    LAS float* scr = (LAS float*)scr_all + wave * 64 * 33;
    for (int it = blockIdx.x * 4 + wave; it < DEPTH * WI_LAYER; it += gridDim.x * 4) wconv_item(it, w_in, w_out, w_gu, w_dn, ws, scr, lane);
}

__global__ void __launch_bounds__(256) k_mod(const float* c, const float* c_ctx, const float* ada_w, const float* ada_b, float* MOD) {
    __shared__ float sc[3][D];
    for (int i = threadIdx.x; i < 3 * D; i += 256) { const int cd = i / D, k = i % D; const float v = cd < 2 ? c[cd * D + k] : c_ctx[k]; sc[cd][k] = v / (1.0f + expf(-v)); }
    __syncthreads();
    const int gid = blockIdx.x * 256 + threadIdx.x; if (gid >= DEPTH * 6 * D) return;
    const int l = gid / (6 * D), n = gid % (6 * D);
    const float* w = ada_w + (size_t)l * D * 6 * D + n;
    float a0 = 0.f, a1 = 0.f, a2 = 0.f;
#pragma unroll 8
    for (int k = 0; k < D; ++k) { const float wv = w[(size_t)k * 6 * D]; a0 += sc[0][k] * wv; a1 += sc[1][k] * wv; a2 += sc[2][k] * wv; }
    const float bv = ada_b[l * 6 * D + n];
    MOD[(l * 3 + 0) * 6 * D + n] = a0 + bv; MOD[(l * 3 + 1) * 6 * D + n] = a1 + bv; MOD[(l * 3 + 2) * 6 * D + n] = a2 + bv;
}

__global__ void __launch_bounds__(256) k_filt_h2(const float* w1, const float* b1, const float* w2, const float* b2, const float* freq, float* H2) {
    __shared__ float z[4][36]; __shared__ float h1[4][64];
    const int l = blockIdx.x / (FPOS / 4), p0 = (blockIdx.x % (FPOS / 4)) * 4, pl = threadIdx.x >> 6, j = threadIdx.x & 63, p = p0 + pl;
    const float t = p < SEQ ? (float)p / (float)SEQ : (float)(p - SEQ) / (float)CTXL;
    if (j < 33) { float v; if (j == 0) v = t; else { const int bnd = j <= 16 ? j : j - 16; float s, c; sincospif(2.0f * t * (float)bnd, &s, &c); v = j <= 16 ? c : s; } z[pl][j] = v; }
    __syncthreads();
    const float* W1 = w1 + l * 33 * 64; float a = b1[l * 64 + j];
#pragma unroll
    for (int i = 0; i < 33; ++i) a += z[pl][i] * W1[i * 64 + j];
    h1[pl][j] = sinf(freq[(l * 2 + 0) * 64 + j] * a);
    __syncthreads();
    const float* W2 = w2 + l * 64 * 64; float a2 = b2[l * 64 + j];
#pragma unroll
    for (int i = 0; i < 64; ++i) a2 += h1[pl][i] * W2[i * 64 + j];
    H2[((size_t)l * FPOS + p) * 64 + j] = sinf(freq[(l * 2 + 1) * 64 + j] * a2);
}
__global__ void __launch_bounds__(256) k_filt_k(const float* H2l, const float* w3l, float* KF, float* KFC) {
    __shared__ float hs[64][65]; __shared__ float wsm[64][65];
    int bx = blockIdx.x; const bool isctx = bx >= (SEQ / 64) * 16; if (isctx) bx -= (SEQ / 64) * 16;
    const int L = isctx ? CTXL : SEQ; const int pt = bx / 16, ct = bx % 16, p0 = pt * 64, c0 = ct * 64;
    const float* Hs = H2l + (size_t)(isctx ? SEQ : 0) * 64;
    for (int i = threadIdx.x; i < 64 * 64; i += 256) { const int r = i >> 6, cc = i & 63; hs[r][cc] = Hs[(size_t)(p0 + r) * 64 + cc]; wsm[r][cc] = w3l[r * 1024 + c0 + cc]; }
    __syncthreads();
    const int tx = threadIdx.x & 15, ty = threadIdx.x >> 4;
    float acc[4][4];
#pragma unroll
    for (int a = 0; a < 4; ++a)
#pragma unroll
        for (int b = 0; b < 4; ++b) acc[a][b] = 0.f;
    for (int j = 0; j < 64; ++j) {
        float hv[4], wv[4];
#pragma unroll
        for (int a = 0; a < 4; ++a) { hv[a] = hs[4 * tx + a][j]; wv[a] = wsm[j][4 * ty + a]; }
#pragma unroll
        for (int a = 0; a < 4; ++a)
#pragma unroll
            for (int b = 0; b < 4; ++b) acc[a][b] += hv[a] * wv[b];
    }
    float* out = isctx ? KFC : KF;
#pragma unroll
    for (int b = 0; b < 4; ++b) { const int col = c0 + 4 * ty + b, ch = col & 255;
        const float d0 = 15.350567286626973f, d1 = 3.0701134573253946f; const float delta = d0 + (d1 - d0) * ((float)ch / 255.0f);
        f32x4 o;
#pragma unroll
        for (int a = 0; a < 4; ++a) { const float t = (float)(p0 + 4 * tx + a) / (float)L; o[a] = acc[a][b] * expf(-t * delta); }
        *(f32x4*)(out + (size_t)col * L + p0 + 4 * tx) = o; }
}
__global__ void __launch_bounds__(256) k_knorm(const float* KF, float* KN) {
    __shared__ float red[4];
    const int oc = blockIdx.x, order = oc >> 8, c = oc & 255;
    const float* kf = KF + (size_t)((order * 2 + 0) * 256 + c) * SEQ; const float* kb = KF + (size_t)((order * 2 + 1) * 256 + c) * SEQ;
    float s = 0.f;
    for (int p = threadIdx.x; p < SEQ; p += 256) s += fabsf(kf[p]) + (p >= 1 ? fabsf(kb[p]) : 0.f);
    s = wave_sum(s); if ((threadIdx.x & 63) == 0) red[threadIdx.x >> 6] = s;
    __syncthreads();
    if (threadIdx.x == 0) KN[oc] = 1.0f / (red[0] + red[1] + red[2] + red[3]);
}

__global__ void __launch_bounds__(256) k_rownorm0(const float* x, const float* ctx, const float* g, const float* MOD0, bf16_t* H, float* XC) {
    const int lane = threadIdx.x & 63, row = blockIdx.x * 4 + (threadIdx.x >> 6); if (row >= MT) return;
    const bool isctx = row >= NLAT; const int cond = isctx ? 2 : row / SEQ;
    const float* xr = isctx ? ctx + (size_t)(row - NLAT) * D : x + (size_t)row * D;
    const float* sh = MOD0 + (size_t)cond * 6 * D; const float* sc = sh + D;
    f32x4 v[4]; float ss = 0.f;
#pragma unroll
    for (int j = 0; j < 4; ++j) { v[j] = *(const f32x4*)(xr + 4 * lane + 256 * j); ss += v[j][0] * v[j][0] + v[j][1] * v[j][1] + v[j][2] * v[j][2] + v[j][3] * v[j][3]; }
    const float rinv = 1.0f / sqrtf(wave_sum(ss) * (1.0f / D) + 1e-6f);
#pragma unroll
    for (int j = 0; j < 4; ++j) { const int col = 4 * lane + 256 * j; const f32x4 gv = *(const f32x4*)(g + col), scv = *(const f32x4*)(sc + col), shv = *(const f32x4*)(sh + col);
        if (isctx) *(f32x4*)(XC + (size_t)(row - NLAT) * D + col) = v[j];
        float o[4];
#pragma unroll
        for (int e = 0; e < 4; ++e) o[e] = v[j][e] * rinv * gv[e] * (1.0f + scv[e]) + shv[e];
        u32x2 w; w.x = pk2(o[0], o[1]); w.y = pk2(o[2], o[3]); *(u32x2*)(H + (size_t)row * D + col) = w; }
}
__global__ void __launch_bounds__(256) k_rowpass(const bf16_t* Y, const float* xin_lat, const float* xin_ctx, float* xout_lat, float* xout_ctx, const float* g_post, const float* modp, int gate_idx,
                                                 const float* g_next, const float* modn, int nidx, bf16_t* H, int nrows) {
    const int lane = threadIdx.x & 63, row = blockIdx.x * 4 + (threadIdx.x >> 6); if (row >= nrows) return;
    const bool isctx = row >= NLAT; const int cond = isctx ? 2 : row / SEQ;
    const float* xi = isctx ? xin_ctx + (size_t)(row - NLAT) * D : xin_lat + (size_t)row * D;
    float* xo = isctx ? xout_ctx + (size_t)(row - NLAT) * D : xout_lat + (size_t)row * D;
    const float* gate = modp + (size_t)cond * 6 * D + gate_idx * D;
    float y[4][4]; float ss = 0.f;
#pragma unroll
    for (int j = 0; j < 4; ++j) { const u32x2 w = *(const u32x2*)(Y + (size_t)row * D + 4 * lane + 256 * j);
        y[j][0] = bf2f(w.x & 0xffffu); y[j][1] = bf2f(w.x >> 16); y[j][2] = bf2f(w.y & 0xffffu); y[j][3] = bf2f(w.y >> 16);
        ss += y[j][0] * y[j][0] + y[j][1] * y[j][1] + y[j][2] * y[j][2] + y[j][3] * y[j][3]; }
    const float rinv = 1.0f / sqrtf(wave_sum(ss) * (1.0f / D) + 1e-6f);
    f32x4 xn[4]; float s2 = 0.f;
#pragma unroll
    for (int j = 0; j < 4; ++j) { const int col = 4 * lane + 256 * j; const f32x4 xv = *(const f32x4*)(xi + col), gp = *(const f32x4*)(g_post + col), gt = *(const f32x4*)(gate + col);
#pragma unroll
        for (int e = 0; e < 4; ++e) { xn[j][e] = xv[e] + gt[e] * (y[j][e] * rinv * gp[e]); s2 += xn[j][e] * xn[j][e]; }
        *(f32x4*)(xo + col) = xn[j]; }
    if (g_next) {
        const float r2 = 1.0f / sqrtf(wave_sum(s2) * (1.0f / D) + 1e-6f);
        const float* sh = modn + (size_t)cond * 6 * D + nidx * D; const float* sc = sh + D;
#pragma unroll
        for (int j = 0; j < 4; ++j) { const int col = 4 * lane + 256 * j; const f32x4 gv = *(const f32x4*)(g_next + col), scv = *(const f32x4*)(sc + col), shv = *(const f32x4*)(sh + col);
            float o[4];
#pragma unroll
            for (int e = 0; e < 4; ++e) o[e] = xn[j][e] * r2 * gv[e] * (1.0f + scv[e]) + shv[e];
            u32x2 w; w.x = pk2(o[0], o[1]); w.y = pk2(o[2], o[3]); *(u32x2*)(H + (size_t)row * D + col) = w; }
    }
}

__global__ void __launch_bounds__(512, 2) k_gemm(pg8::GPhase ph) {
    extern __shared__ __attribute__((aligned(16))) unsigned char lds[];
    pg8::Sched S; S.ph = ph; S.G = gridDim.x; S.c = blockIdx.x;
    pg8::Epi E;
    pg8::gemm_phase((LAS unsigned char*)lds, S, E);
}
__device__ __forceinline__ float conv3_at(const bf16_t* rowp, int s, int Lseq, float w0, float w1, float w2, float bias) {
    float a = bias + w1 * bf2f(rowp[s]);
    if (s > 0) a += w0 * bf2f(rowp[s - 1]);
    if (s + 1 < Lseq) a += w2 * bf2f(rowp[s + 1]);
    return a;
}
template <int ORDER>
__global__ void __launch_bounds__(512) k_hy_naive(const bf16_t* PTV, const float* KF, const float* KN, const float* cw, const float* cb, const float* hbias, float* Z1, bf16_t* YMIX) {
    __shared__ float us[2][2048]; __shared__ float kw[4096];
    const int c = blockIdx.x & 255, tt = blockIdx.x >> 8, T0 = tt * 2048, tid = threadIdx.x;
    const float* kf = KF + (size_t)((ORDER * 2 + 0) * 256 + c) * SEQ; const float* kb = KF + (size_t)((ORDER * 2 + 1) * 256 + c) * SEQ;
    const float w0 = cw[0 * 768 + c], w1 = cw[1 * 768 + c], w2 = cw[2 * 768 + c], wb = cb[c];
    float acc[2][4];
#pragma unroll
    for (int b = 0; b < 2; ++b)
#pragma unroll
        for (int i = 0; i < 4; ++i) acc[b][i] = 0.f;
    for (int st = 0; st < 8; ++st) {
        const int S0 = st * 2048;
        for (int i = tid; i < 4096; i += 512) { const int b = i >> 11, s = S0 + (i & 2047);
            us[b][i & 2047] = ORDER == 0 ? conv3_at(PTV + (size_t)c * MT + (size_t)b * SEQ, s, SEQ, w0, w1, w2, wb) : Z1[((size_t)c * 2 + b) * SEQ + s]; }
        const int dmin = T0 - S0 - 2047;
        for (int i = tid; i < 4095; i += 512) { const int d = dmin + i; kw[i] = d >= 0 ? kf[d] : kb[-d]; }
        __syncthreads();
        for (int s = 0; s < 2048; ++s) {
            const float u0 = us[0][s], u1 = us[1][s];
#pragma unroll
            for (int i = 0; i < 4; ++i) { const float kv = kw[tid + 512 * i - s + 2047]; acc[0][i] += kv * u0; acc[1][i] += kv * u1; }
        }
        __syncthreads();
    }
    const float invn = KN[ORDER * 256 + c], hb = hbias[ORDER * 256 + c];
    const int grow = (ORDER == 0 ? 256 : 512) + c;
    const float g0 = cw[0 * 768 + grow], g1 = cw[1 * 768 + grow], g2 = cw[2 * 768 + grow], gb = cb[grow];
#pragma unroll
    for (int b = 0; b < 2; ++b)
#pragma unroll
        for (int i = 0; i < 4; ++i) { const int t = T0 + tid + 512 * i;
            const float in_t = ORDER == 0 ? conv3_at(PTV + (size_t)c * MT + (size_t)b * SEQ, t, SEQ, w0, w1, w2, wb) : Z1[((size_t)c * 2 + b) * SEQ + t];
            const float gate = conv3_at(PTV + (size_t)grow * MT + (size_t)b * SEQ, t, SEQ, g0, g1, g2, gb);
            const float res = gate * (acc[b][i] * invn + hb * in_t);
            if (ORDER == 0) Z1[((size_t)c * 2 + b) * SEQ + t] = res; else YMIX[((size_t)b * SEQ + t) * D + c] = (bf16_t)f2bf(res); }
}
__global__ void __launch_bounds__(512) k_hy_ctx(const bf16_t* PTV, const float* KFC, const float* cw, const float* cb, const float* hbias, bf16_t* YMIX) {
    __shared__ float zin[2][256]; __shared__ float kc[512]; __shared__ float red[8];
    const int c = blockIdx.x, tid = threadIdx.x, b = tid >> 8, t = tid & 255, lane = tid & 63, wave = tid >> 6;
    const bf16_t* base = PTV + NLAT + b * CTXL;
    float zcur = conv3_at(base + (size_t)c * MT, t, CTXL, cw[c], cw[768 + c], cw[1536 + c], cb[c]);
    for (int order = 0; order < 2; ++order) {
        __syncthreads();
        zin[b][t] = zcur;
        const float* kf = KFC + (size_t)((order * 2 + 0) * 256 + c) * CTXL; const float* kb = KFC + (size_t)((order * 2 + 1) * 256 + c) * CTXL;
        float kv = 0.f; if (tid >= 1) { const int d = tid - 256; kv = d >= 0 ? kf[d] : kb[-d]; } kc[tid] = kv;
        float s = wave_sum(fabsf(kv)); if (lane == 0) red[wave] = s;
        __syncthreads();
        float tot = 0.f;
#pragma unroll
        for (int i = 0; i < 8; ++i) tot += red[i];
        float acc = 0.f;
        for (int s2 = 0; s2 < 256; ++s2) acc += kc[t - s2 + 256] * zin[b][s2];
        const int grow = (order == 0 ? 256 : 512) + c;
        const float gate = conv3_at(base + (size_t)grow * MT, t, CTXL, cw[grow], cw[768 + grow], cw[1536 + grow], cb[grow]);
        zcur = gate * (acc / tot + hbias[order * 256 + c] * zcur);
    }
    YMIX[(size_t)(NLAT + b * CTXL + t) * D + c] = (bf16_t)f2bf(zcur);
}

__global__ void __launch_bounds__(256) k_na_naive(const bf16_t* QKL, const bf16_t* PTV, const float* rpb, bf16_t* YMIX, int nrows) {
    __shared__ float qs[4][64];
    const int wave = threadIdx.x >> 6, lane = threadIdx.x & 63;
    const int item = blockIdx.x * 4 + wave; const int row = item >> 3, h = item & 7;
    if (row >= nrows) return;
    const bool isctx = row >= NLAT; const int b = isctx ? (row - NLAT) / CTXL : row / SEQ;
    qs[wave][lane] = bf2f(QKL[(size_t)row * NQKL + h * 64 + lane]) * 0.125f;
    asm volatile("s_waitcnt lgkmcnt(0)" ::: "memory");
    const bf16_t* VT = PTV + (size_t)768 * MT;
    int tok[6]; float sc[6];
    int r = 0, cq = 0, rs = 0, start = 0;
    if (!isctx) { const int t = row % SEQ; r = t / GRIDW; cq = t % GRIDW; rs = min(max(r - 4, 0), GROWS - 8); start = min(max(cq - 8, 0), GRIDW - 16); }
#pragma unroll
    for (int g = 0; g < 6; ++g) {
        float bias = 0.f; bool valid = true;
        if (g < 2) { const int kr = (lane >> 4) + 4 * g, kcol = start + (lane & 15); tok[g] = b * SEQ + (rs + kr) * GRIDW + kcol; valid = !isctx;
            if (valid) bias = rpb[(h * 15 + (rs + kr - r + 7)) * 31 + (kcol - cq + 15)]; else tok[g] = 0; }
        else tok[g] = NLAT + b * CTXL + (g - 2) * 64 + lane;
        const bf16_t* kp = QKL + (size_t)tok[g] * NQKL + 512 + h * 64;
        float dot = 0.f;
#pragma unroll
        for (int d8 = 0; d8 < 8; ++d8) { const u32x4 w = *(const u32x4*)(kp + 8 * d8);
            dot += qs[wave][8 * d8 + 0] * bf2f(w.x & 0xffffu) + qs[wave][8 * d8 + 1] * bf2f(w.x >> 16) + qs[wave][8 * d8 + 2] * bf2f(w.y & 0xffffu) + qs[wave][8 * d8 + 3] * bf2f(w.y >> 16)
                 + qs[wave][8 * d8 + 4] * bf2f(w.z & 0xffffu) + qs[wave][8 * d8 + 5] * bf2f(w.z >> 16) + qs[wave][8 * d8 + 6] * bf2f(w.w & 0xffffu) + qs[wave][8 * d8 + 7] * bf2f(w.w >> 16); }
        sc[g] = valid ? dot + bias : -1e30f;
    }
    float m = sc[0];
#pragma unroll
    for (int g = 1; g < 6; ++g) m = fmaxf(m, sc[g]);
    m = wave_max(m);
    float sum = 0.f;
#pragma unroll
    for (int g = 0; g < 6; ++g) { sc[g] = expf(sc[g] - m); sum += sc[g]; }
    sum = wave_sum(sum);
    float o = 0.f;
    for (int d = 0; d < 64; ++d) {
        const bf16_t* vp = VT + (size_t)(h * 64 + d) * MT;
        float part = 0.f;
#pragma unroll
        for (int g = 0; g < 6; ++g) part += sc[g] * bf2f(vp[tok[g]]);
        part = wave_sum(part);
        if (lane == d) o = part;
    }
    YMIX[(size_t)row * D + 256 + h * 64 + lane] = (bf16_t)f2bf(o / sum);
}

__global__ void __launch_bounds__(64) k_lru_naive(const bf16_t* QKL, const float* cw, const float* cb, const float* wa, const float* ba, const float* wi, const float* bi, const float* lam, float* HS) {
    __shared__ float us[64];
    const int lane = threadIdx.x, dir = blockIdx.x & 1, blk = (blockIdx.x >> 1) & 3, b = blockIdx.x >> 3, ch = blk * 64 + lane;
    float war[64], wir[64];
#pragma unroll
    for (int j = 0; j < 64; ++j) { war[j] = wa[((dir * 4 + blk) * 64 + j) * 64 + lane]; wir[j] = wi[((dir * 4 + blk) * 64 + j) * 64 + lane]; }
    const float bav = ba[dir * 256 + ch], biv = bi[dir * 256 + ch];
    const float lm = lam[dir * 256 + ch]; const float sp = log1pf(expf(-lm));
    const float c0 = cw[0 * 256 + ch], c1 = cw[1 * 256 + ch], c2 = cw[2 * 256 + ch], c3 = cw[3 * 256 + ch], cbv = cb[ch];
    float h = 0.f;
    for (int seg = 0; seg < 2; ++seg) {
        const int Ls = seg == 0 ? CTXL : SEQ; const int row0 = seg == 0 ? NLAT + b * CTXL : b * SEQ;
        for (int i = 0; i < Ls; ++i) {
            const int t = dir == 0 ? i : Ls - 1 - i;
            const bf16_t* xp = QKL + (size_t)(row0 + t) * NQKL + 1024 + ch;
            float u = cbv + c2 * bf2f(xp[0]);
            if (t >= 2) u += c0 * bf2f(xp[-2 * NQKL]);
            if (t >= 1) u += c1 * bf2f(xp[-1 * NQKL]);
            if (t + 1 < Ls) u += c3 * bf2f(xp[NQKL]);
            __syncthreads();
            us[lane] = u;
            __syncthreads();
            float ra = bav, ri = biv;
#pragma unroll
            for (int j = 0; j < 64; ++j) { const float uj = us[j]; ra += uj * war[j]; ri += uj * wir[j]; }
            const float rg = sigmoid_f(ra), ig = sigmoid_f(ri);
            const float log_a = -8.0f * rg * sp; const float a = expf(log_a); const float bb = sqrtf(-expm1f(2.0f * log_a)) * (ig * u);
            h = a * h + bb;
            HS[((size_t)dir * MT + row0 + t) * LRW + ch] = h;
        }
    }
}
__global__ void __launch_bounds__(256) k_lru_comb(const float* HS, const bf16_t* QKL, bf16_t* YMIX, int nrows) {
    const int row = blockIdx.x, ch = threadIdx.x; if (row >= nrows) return;
    const float hsum = HS[(size_t)row * LRW + ch] + HS[((size_t)MT + row) * LRW + ch];
    const float xg = bf2f(QKL[(size_t)row * NQKL + 1280 + ch]);
    YMIX[(size_t)row * D + 768 + ch] = (bf16_t)f2bf(hsum * gelu_tanh(xg));
}
static void launch_gemm(const pg8::GPhase& ph, hipStream_t stream) { hipLaunchKernelGGL(k_gemm, dim3(256), dim3(512), pg8::STAGE_BYTES, stream, ph); }
static pg8::GPhase one_seg(const bf16_t* A, const bf16_t* B, bf16_t* C, int nM, int nN, int ldc, int epi, int K) {
    pg8::GPhase ph{}; ph.s0 = pg8::GSeg{A, B, C, nM, nN, ldc, epi}; ph.s1 = ph.s0; ph.n0 = nM * nN; ph.total = nM * nN; ph.K = K; ph.pad = 0; return ph;
}
extern "C" void kernel_launch(void* const* d_in, const int* in_sizes, int n_in, void* d_out, int out_size, void* d_ws, size_t ws_size, hipStream_t stream) {
    static int inited = 0;
    if (!inited) {
        if (n_in != 31 || in_sizes[0] != NLAT * D || out_size != NLAT * D || ws_size < WS_END) { fprintf(stderr, "kernel_launch: unexpected shapes (n_in %d, in0 %d, out %d, ws %zu)\n", n_in, n_in > 0 ? in_sizes[0] : -1, out_size, ws_size); inited = -1; return; }
        if (hipFuncSetAttribute((const void*)k_gemm, hipFuncAttributeMaxDynamicSharedMemorySize, pg8::STAGE_BYTES) != hipSuccess) { fprintf(stderr, "kernel_launch: hipFuncSetAttribute failed\n"); inited = -1; return; }
        inited = 1;
    }
    if (inited < 0) return;
    const float* x = (const float*)d_in[0]; const float* c = (const float*)d_in[1]; const float* ctx = (const float*)d_in[2]; const float* c_ctx = (const float*)d_in[3];
    const float* ada_w = (const float*)d_in[4]; const float* ada_b = (const float*)d_in[5];
    const float* g_mix_pre = (const float*)d_in[6]; const float* g_mix_post = (const float*)d_in[7]; const float* g_ffn_pre = (const float*)d_in[8]; const float* g_ffn_post = (const float*)d_in[9];
    const float* w_in = (const float*)d_in[10]; const float* w_out = (const float*)d_in[11];
    const float* hy_conv_w = (const float*)d_in[12]; const float* hy_conv_b = (const float*)d_in[13];
    const float* hy_f_w1 = (const float*)d_in[14]; const float* hy_f_b1 = (const float*)d_in[15]; const float* hy_f_w2 = (const float*)d_in[16]; const float* hy_f_b2 = (const float*)d_in[17];
    const float* hy_f_w3 = (const float*)d_in[18]; const float* hy_f_freq = (const float*)d_in[19]; const float* hy_bias = (const float*)d_in[20];
    const float* na_rpb = (const float*)d_in[21];
    const float* lru_conv_w = (const float*)d_in[22]; const float* lru_conv_b = (const float*)d_in[23]; const float* lru_wa = (const float*)d_in[24]; const float* lru_ba = (const float*)d_in[25];
    const float* lru_wi = (const float*)d_in[26]; const float* lru_bi = (const float*)d_in[27]; const float* lru_lam = (const float*)d_in[28];
    const float* w_gu = (const float*)d_in[29]; const float* w_dn = (const float*)d_in[30];
    unsigned char* ws = (unsigned char*)d_ws; float* out = (float*)d_out;
    bf16_t* Win_t = (bf16_t*)(ws + WS_WIN); bf16_t* Wout_t = (bf16_t*)(ws + WS_WOUT); bf16_t* Wgu_t = (bf16_t*)(ws + WS_WGU); bf16_t* Wdn_t = (bf16_t*)(ws + WS_WDN);
    float* MOD = (float*)(ws + WS_MOD); float* XC = (float*)(ws + WS_XC); float* H2 = (float*)(ws + WS_H2); float* KN = (float*)(ws + WS_KN);
    bf16_t* H = (bf16_t*)(ws + WS_H); bf16_t* Y = (bf16_t*)(ws + WS_Y); bf16_t* PTV = (bf16_t*)(ws + WS_PTV); bf16_t* QKL = (bf16_t*)(ws + WS_QKL); bf16_t* ACT = (bf16_t*)(ws + WS_ACT);
    bf16_t* YMIX = (bf16_t*)(ws + WS_YMIX); float* KF = (float*)(ws + WS_KF); float* KFC = (float*)(ws + WS_KFC);
    float* HS = (float*)(ws + WS_HF); float* Z1 = (float*)(ws + WS_Z1);

    hipLaunchKernelGGL(k_wconv, dim3(1024), dim3(256), 0, stream, w_in, w_out, w_gu, w_dn, ws);
    hipLaunchKernelGGL(k_mod, dim3(DEPTH * 6 * D / 256), dim3(256), 0, stream, c, c_ctx, ada_w, ada_b, MOD);
    hipLaunchKernelGGL(k_filt_h2, dim3(DEPTH * FPOS / 4), dim3(256), 0, stream, hy_f_w1, hy_f_b1, hy_f_w2, hy_f_b2, hy_f_freq, H2);
    hipLaunchKernelGGL(k_rownorm0, dim3(MT / 4), dim3(256), 0, stream, x, ctx, g_mix_pre, MOD, H, XC);
    for (int l = 0; l < DEPTH; ++l) {
        const float* modl = MOD + (size_t)l * 3 * 6 * D;
        hipLaunchKernelGGL(k_filt_k, dim3((SEQ / 64) * 16 + (CTXL / 64) * 16), dim3(256), 0, stream, H2 + (size_t)l * FPOS * 64, hy_f_w3 + (size_t)l * 64 * 1024, KF, KFC);
        hipLaunchKernelGGL(k_knorm, dim3(512), dim3(256), 0, stream, KF, KN);
        {
            pg8::GPhase ph{}; const bf16_t* W = Win_t + (size_t)l * INW * D;
            ph.s0 = pg8::GSeg{W, H, PTV, NPTV / 256, MT / 256, MT, 0}; ph.s1 = pg8::GSeg{H, W + (size_t)NPTV * D, QKL, MT / 256, NQKL / 256, NQKL, 0};
            ph.n0 = (NPTV / 256) * (MT / 256); ph.total = ph.n0 + (MT / 256) * (NQKL / 256); ph.K = D; ph.pad = 0;
            launch_gemm(ph, stream);
        }
        const float* hcw = hy_conv_w + (size_t)l * 3 * 768; const float* hcb = hy_conv_b + (size_t)l * 768; const float* hb = hy_bias + (size_t)l * 2 * 256;
        hipLaunchKernelGGL(k_hy_naive<0>, dim3(256 * 8), dim3(512), 0, stream, PTV, KF, KN, hcw, hcb, hb, Z1, YMIX);
        hipLaunchKernelGGL(k_hy_naive<1>, dim3(256 * 8), dim3(512), 0, stream, PTV, KF, KN, hcw, hcb, hb, Z1, YMIX);
        const int nrows = (l == 0) ? MT : NLAT;
        if (l == 0) hipLaunchKernelGGL(k_hy_ctx, dim3(256), dim3(512), 0, stream, PTV, KFC, hcw, hcb, hb, YMIX);
        hipLaunchKernelGGL(k_na_naive, dim3(nrows * 8 / 4), dim3(256), 0, stream, QKL, PTV, na_rpb + (size_t)l * 8 * 15 * 31, YMIX, nrows);
        hipLaunchKernelGGL(k_lru_naive, dim3(16), dim3(64), 0, stream, QKL, lru_conv_w + (size_t)l * 4 * 256, lru_conv_b + (size_t)l * 256, lru_wa + (size_t)l * 2 * 4 * 64 * 64, lru_ba + (size_t)l * 512,
                           lru_wi + (size_t)l * 2 * 4 * 64 * 64, lru_bi + (size_t)l * 512, lru_lam + (size_t)l * 512, HS);
        hipLaunchKernelGGL(k_lru_comb, dim3(nrows), dim3(256), 0, stream, HS, QKL, YMIX, nrows);
        launch_gemm(one_seg(YMIX, Wout_t + (size_t)l * D * D, Y, MT / 256, D / 256, D, 0, D), stream);
        hipLaunchKernelGGL(k_rowpass, dim3(MT / 4), dim3(256), 0, stream, Y, l == 0 ? x : out, l == 0 ? ctx : XC, out, XC, g_mix_post + (size_t)l * D, modl, 2,
                           g_ffn_pre + (size_t)l * D, modl, 3, H, nrows);
        launch_gemm(one_seg(H, Wgu_t + (size_t)l * 2 * DFF * D, ACT, MT / 256, 2 * DFF / 256, DFF, 1, D), stream);
        launch_gemm(one_seg(ACT, Wdn_t + (size_t)l * D * DFF, Y, MT / 256, D / 256, D, 0, DFF), stream);
        const bool lastl = (l == DEPTH - 1);
        hipLaunchKernelGGL(k_rowpass, dim3(MT / 4), dim3(256), 0, stream, Y, out, XC, out, XC, g_ffn_post + (size_t)l * D, modl, 5,
                           lastl ? (const float*)nullptr : g_mix_pre + (size_t)(l + 1) * D, lastl ? modl : modl + 3 * 6 * D, 0, H, nrows);
    }
}
```

```cpp
#include <hip/hip_runtime.h>
#include <cstdio>
#include <cstdint>
#include <cmath>

#define LAS __attribute__((address_space(3)))
typedef unsigned short bf16_t;
typedef short bf16x8 __attribute__((ext_vector_type(8)));
typedef float f32x4 __attribute__((ext_vector_type(4)));
typedef float f32x2 __attribute__((ext_vector_type(2)));
typedef unsigned u32x4 __attribute__((ext_vector_type(4)));
typedef unsigned u32x2 __attribute__((ext_vector_type(2)));

constexpr int D = 1024, NB = 2, SEQ = 16384, DEPTH = 2, GRIDW = 64, GROWS = 256, CTXL = 256;
constexpr int NLAT = NB * SEQ, NCTX = NB * CTXL, MT = NLAT + NCTX;
constexpr int HYW = 256, NAW = 512, NHEAD = 8, DH = 64, LRW = 256, INW = 2816, DFF = 2816;
constexpr int NPTV = 1280;
constexpr int NQKL = 1536;
constexpr int FPOS = SEQ + CTXL;

constexpr size_t MiB = 1u << 20;
constexpr size_t WS_CTL = 0;
constexpr size_t WS_WIN = 1 * MiB, WS_WOUT = 12 * MiB, WS_WGU = 16 * MiB, WS_WDN = 38 * MiB;
constexpr size_t WS_MOD = 49 * MiB;
constexpr size_t WS_XC = 50 * MiB;
constexpr size_t WS_H2 = 52 * MiB;
constexpr size_t WS_KN = 61 * MiB;
constexpr size_t WS_H = 64 * MiB;
constexpr size_t WS_Y = 129 * MiB;
constexpr size_t WS_PTV = 194 * MiB;
constexpr size_t WS_QKL = WS_PTV + (size_t)NPTV * MT * 2;
constexpr size_t WS_ACT = WS_PTV;
constexpr size_t WS_YMIX = 373 * MiB;
constexpr size_t WS_KF = 438 * MiB;
constexpr size_t WS_KFC = 502 * MiB;
constexpr size_t WS_END = 504 * MiB;
constexpr size_t WS_HF = WS_H, WS_HR = WS_H + (size_t)MT * LRW * 4;
constexpr size_t WS_Z1 = WS_Y;
static_assert(WS_QKL + (size_t)MT * NQKL * 2 <= WS_YMIX && WS_ACT + (size_t)MT * DFF * 2 <= WS_YMIX, "ws map");
static_assert(WS_HR + (size_t)MT * LRW * 4 <= WS_Y && WS_Z1 + (size_t)256 * 2 * SEQ * 4 <= WS_PTV, "ws map");

__device__ __forceinline__ unsigned f2bf(float f) { unsigned u = __float_as_uint(f); return (u + 0x7fffu + ((u >> 16) & 1u)) >> 16; }
__device__ __forceinline__ unsigned pk2(float lo, float hi) { return f2bf(lo) | (f2bf(hi) << 16); }
__device__ __forceinline__ float bf2f(unsigned h) { return __uint_as_float(h << 16); }
__device__ __forceinline__ float wave_sum(float v) {
#pragma unroll
    for (int o = 1; o < 64; o <<= 1) v += __shfl_xor(v, o);
    return v;
}
__device__ __forceinline__ float wave_max(float v) {
#pragma unroll
    for (int o = 1; o < 64; o <<= 1) v = fmaxf(v, __shfl_xor(v, o));
    return v;
}
__device__ __forceinline__ float silu_f(float g) { return g * __builtin_amdgcn_rcpf(1.0f + __builtin_amdgcn_exp2f(-1.44269504089f * g)); }
__device__ __forceinline__ float sigmoid_f(float g) { return 1.0f / (1.0f + expf(-g)); }
__device__ __forceinline__ float gelu_tanh(float x) { const float u = 0.7978845608028654f * (x + 0.044715f * x * x * x); return 0.5f * x * (1.0f + tanhf(u)); }

namespace pg8 {
constexpr int BM = 256, BK = 64, HALF = 128, HTB = HALF * BK * 2, STAGE_BYTES = 8 * HTB;
__host__ __device__ __forceinline__ int lds_byte(int r, int c) { const int st = (r >> 4) * 2 + (c >> 5), rr = r & 15, cc = c & 31, ob = rr * 64 + cc * 2; return st * 1024 + (ob ^ (((ob >> 9) & 1) << 5)); }
__host__ __device__ __forceinline__ void stage_rc(int b, int& R, int& C) { const int st = b / 1024, sb = b % 1024, swz = sb ^ (((sb >> 9) & 1) << 5); R = (st >> 1) * 16 + swz / 64; C = (st & 1) * 32 + (swz % 64) / 2; }
__host__ __device__ __forceinline__ int perm32(int rho) { const int n = rho >> 4, i = rho & 15; return 8 * (i >> 2) + 4 * n + (i & 3); }

struct GSeg { const bf16_t* A; const bf16_t* B; bf16_t* C; int nM, nN, ldc, epi; };
struct GPhase { GSeg s0, s1; int n0, total, K, pad; };
struct Unit { const char* a; const char* b; bf16_t* C; int ldc, epi, pm, pn; };

struct Sched {
    GPhase ph; int G, c;
    __device__ __forceinline__ bool next(int i, Unit& u) const {
        const long L = (long)i * G + c; if (L >= ph.total) return false;
        int wgid = (int)L; { const int nwg = ph.total, q = nwg / 8, r = nwg % 8, xcd = wgid % 8, off = wgid / 8; wgid = (xcd < r ? xcd * (q + 1) : r * (q + 1) + (xcd - r) * q) + off; }
        const bool first = wgid < ph.n0; if (!first) wgid -= ph.n0;
        const bf16_t* A = first ? ph.s0.A : ph.s1.A; const bf16_t* B = first ? ph.s0.B : ph.s1.B; bf16_t* C = first ? ph.s0.C : ph.s1.C;
        const int nM = first ? ph.s0.nM : ph.s1.nM, nN = first ? ph.s0.nN : ph.s1.nN;
        u.ldc = first ? ph.s0.ldc : ph.s1.ldc; u.epi = first ? ph.s0.epi : ph.s1.epi; u.C = C;
        const int nig = 8 * nN, gid = wgid / nig, fm = gid * 8, gsz = (nM - fm) < 8 ? (nM - fm) : 8;
        u.pm = fm + ((wgid % nig) % gsz); u.pn = (wgid % nig) / gsz;
        u.a = (const char*)A + (size_t)u.pm * BM * ph.K * 2; u.b = (const char*)B + (size_t)u.pn * BM * ph.K * 2;
        return true;
    }
};

__device__ __forceinline__ unsigned cvt_pk_bf16(float lo, float hi) { unsigned r; asm volatile("v_cvt_pk_bf16_f32 %0, %1, %2" : "=v"(r) : "v"(lo), "v"(hi)); return r; }

struct Epi {
    __device__ __forceinline__ void operator()(const f32x4 (&acc)[2][2][4][2], const Unit& u, int wr, int wc, int fr, int fq) const {
        const int row0 = u.pm * BM + wr * 64 + fr;
        if (u.epi == 0) {
            const int col0 = u.pn * BM + wc * 32 + 8 * fq;
#pragma unroll
            for (int ai = 0; ai < 2; ++ai)
#pragma unroll
                for (int m = 0; m < 4; ++m) { bf16_t* rowp = u.C + (size_t)(row0 + ai * HALF + m * 16) * u.ldc + col0;
#pragma unroll
                    for (int bj = 0; bj < 2; ++bj) { const f32x4 v0 = acc[ai][bj][m][0], v1 = acc[ai][bj][m][1];
                        u32x4 w; w.x = cvt_pk_bf16(v0[0], v0[1]); w.y = cvt_pk_bf16(v0[2], v0[3]); w.z = cvt_pk_bf16(v1[0], v1[1]); w.w = cvt_pk_bf16(v1[2], v1[3]);
                        *(u32x4*)(rowp + bj * HALF) = w; } }
        } else {
            const int col0 = u.pn * HALF + wc * 32 + 8 * fq;
#pragma unroll
            for (int ai = 0; ai < 2; ++ai)
#pragma unroll
                for (int m = 0; m < 4; ++m) { bf16_t* rowp = u.C + (size_t)(row0 + ai * HALF + m * 16) * u.ldc + col0;
                    const f32x4 g0 = acc[ai][0][m][0], g1 = acc[ai][0][m][1], u0 = acc[ai][1][m][0], u1 = acc[ai][1][m][1];
                    u32x4 w; w.x = cvt_pk_bf16(silu_f(g0[0]) * u0[0], silu_f(g0[1]) * u0[1]); w.y = cvt_pk_bf16(silu_f(g0[2]) * u0[2], silu_f(g0[3]) * u0[3]);
                    w.z = cvt_pk_bf16(silu_f(g1[0]) * u1[0], silu_f(g1[1]) * u1[1]); w.w = cvt_pk_bf16(silu_f(g1[2]) * u1[2], silu_f(g1[3]) * u1[3]);
                    *(u32x4*)rowp = w; }
        }
    }
};

__device__ __forceinline__ void gemm_phase(LAS unsigned char* lds, const Sched& S, const Epi& E) {
    const int tid = threadIdx.x, wid = __builtin_amdgcn_readfirstlane(tid >> 6), lane = tid & 63, wr = wid >> 2, wc = wid & 3, fr = lane & 15, fq = lane >> 4;
    const int K = S.ph.K, nt = K / BK;
    unsigned voffA[2], voffB[2];
#pragma unroll
    for (int i = 0; i < 2; ++i) { int R, C; stage_rc(tid * 16 + i * 8192, R, C); const int Rb = (R & ~31) + perm32(R & 31);
        voffA[i] = (unsigned)(R * K + C) * 2u; voffB[i] = (unsigned)(Rb * K + C) * 2u; }
    const size_t kstep = (size_t)(BK * 2);
    const size_t hstep = (size_t)HALF * K * 2;
    const unsigned ldsw = (unsigned)wid * 1024u;
    const int aoff = lds_byte(wr * 64 + fr, fq * 8), boff = lds_byte(wc * 32 + fr, fq * 8);
#define PG8_SA(b, h) (((b) * 2 + (h)) * HTB)
#define PG8_SB(b, h) ((4 + (b) * 2 + (h)) * HTB)
#define PG8_STAGE(bufoff, gbase, voff) do { _Pragma("unroll") for (int _i = 0; _i < 2; ++_i) \
        __builtin_amdgcn_global_load_lds((const unsigned*)((const char*)(gbase) + (voff)[_i]), (LAS unsigned*)(lds + (bufoff) + ldsw + _i * 8192), 16, 0, 0); } while (0)
#define PG8_LDA(dst, b, h) do { _Pragma("unroll") for (int m = 0; m < 4; ++m) _Pragma("unroll") for (int k = 0; k < 2; ++k) dst[m][k] = *(const LAS bf16x8*)(lds + PG8_SA(b, h) + aoff + m * 2048 + k * 1024); } while (0)
#define PG8_LDB(dst, b, h) do { _Pragma("unroll") for (int n = 0; n < 2; ++n) _Pragma("unroll") for (int k = 0; k < 2; ++k) dst[n][k] = *(const LAS bf16x8*)(lds + PG8_SB(b, h) + boff + n * 2048 + k * 1024); } while (0)
#define PG8_MMA(ai, bj, At, Bt) do { __builtin_amdgcn_s_setprio(1); _Pragma("unroll") for (int m = 0; m < 4; ++m) _Pragma("unroll") for (int n = 0; n < 2; ++n) _Pragma("unroll") for (int k = 0; k < 2; ++k) \
        acc[ai][bj][m][n] = __builtin_amdgcn_mfma_f32_16x16x32_bf16(Bt[n][k], At[m][k], acc[ai][bj][m][n], 0, 0, 0); __builtin_amdgcn_s_setprio(0); } while (0)
#define PG8_WAIT_V(n) asm volatile("s_waitcnt vmcnt(" #n ")" ::: "memory")
#define PG8_WAIT_L(n) asm volatile("s_waitcnt lgkmcnt(" #n ")" ::: "memory")
#define PG8_BAR __builtin_amdgcn_s_barrier()
#define PG8_SCHED __builtin_amdgcn_sched_barrier(0)
    Unit cur, nxt; int ui = 0;
    if (!S.next(0, cur)) return;
    f32x4 acc[2][2][4][2];
#pragma unroll
    for (int a = 0; a < 2; ++a)
#pragma unroll
        for (int b = 0; b < 2; ++b)
#pragma unroll
            for (int m = 0; m < 4; ++m)
#pragma unroll
                for (int n = 0; n < 2; ++n) acc[a][b][m][n] = (f32x4){0.f, 0.f, 0.f, 0.f};
    bf16x8 At[4][2], B0[2][2], B1[2][2];
    const char* cA = cur.a; const char* cB = cur.b;
    PG8_STAGE(PG8_SB(0, 0), cB, voffB); PG8_STAGE(PG8_SB(0, 1), cB + hstep, voffB); PG8_STAGE(PG8_SA(0, 0), cA, voffA); PG8_STAGE(PG8_SA(0, 1), cA + hstep, voffA);
    if (wr == 1) PG8_BAR;
    PG8_WAIT_V(2); PG8_BAR;
    PG8_STAGE(PG8_SB(1, 0), cB + kstep, voffB); PG8_STAGE(PG8_SA(1, 0), cA + kstep, voffA); PG8_STAGE(PG8_SB(1, 1), cB + hstep + kstep, voffB);
    PG8_WAIT_V(6); PG8_BAR;
    for (;;) {
        const bool has_next = S.next(ui + 1, nxt);
        const char* nA = has_next ? nxt.a : cA; const char* nB = has_next ? nxt.b : cB;
        for (int t = 0; t < nt; t += 2) {
            const bool last = (t == nt - 2);
            const char* a1 = cA + (size_t)(t + 1) * kstep;
            const char* a2 = last ? nA : cA + (size_t)(t + 2) * kstep; const char* b2 = last ? nB : cB + (size_t)(t + 2) * kstep;
            const char* a3 = a2 + kstep; const char* b3 = b2 + kstep;
            PG8_LDB(B0, 0, 0); PG8_LDB(B1, 0, 1); PG8_SCHED; PG8_LDA(At, 0, 0); PG8_STAGE(PG8_SA(1, 1), a1 + hstep, voffA);
            PG8_WAIT_V(8); PG8_WAIT_L(0); PG8_BAR; PG8_MMA(0, 0, At, B0); PG8_MMA(0, 1, At, B1); PG8_BAR; PG8_SCHED;
            PG8_LDA(At, 0, 1); PG8_STAGE(PG8_SB(0, 0), b2, voffB); PG8_STAGE(PG8_SB(0, 1), b2 + hstep, voffB); PG8_STAGE(PG8_SA(0, 0), a2, voffA);
            PG8_WAIT_V(8); PG8_WAIT_L(0); PG8_BAR; PG8_MMA(1, 0, At, B0); PG8_MMA(1, 1, At, B1); PG8_BAR; PG8_SCHED;
            PG8_LDB(B0, 1, 0); PG8_LDB(B1, 1, 1); PG8_SCHED; PG8_LDA(At, 1, 0); PG8_STAGE(PG8_SA(0, 1), a2 + hstep, voffA);
            PG8_WAIT_V(8); PG8_WAIT_L(0); PG8_BAR; PG8_MMA(0, 0, At, B0); PG8_MMA(0, 1, At, B1); PG8_BAR; PG8_SCHED;
            PG8_LDA(At, 1, 1); PG8_STAGE(PG8_SB(1, 0), b3, voffB); PG8_STAGE(PG8_SB(1, 1), b3 + hstep, voffB); PG8_STAGE(PG8_SA(1, 0), a3, voffA);
            PG8_WAIT_V(8); PG8_WAIT_L(0); PG8_BAR; PG8_MMA(1, 0, At, B0); PG8_MMA(1, 1, At, B1); PG8_BAR; PG8_SCHED;
        }
        if (wr == 0) PG8_BAR;
        E(acc, cur, wr, wc, fr, fq);
        if (!has_next) break;
#pragma unroll
        for (int a = 0; a < 2; ++a)
#pragma unroll
            for (int b = 0; b < 2; ++b)
#pragma unroll
                for (int m = 0; m < 4; ++m)
#pragma unroll
                    for (int n = 0; n < 2; ++n) acc[a][b][m][n] = (f32x4){0.f, 0.f, 0.f, 0.f};
        cur = nxt; cA = nA; cB = nB; ++ui;
        if (wr == 1) PG8_BAR;
    }
    PG8_WAIT_V(0);
    PG8_BAR;
#undef PG8_SA
#undef PG8_SB
#undef PG8_STAGE
#undef PG8_LDA
#undef PG8_LDB
#undef PG8_MMA
#undef PG8_WAIT_V
#undef PG8_WAIT_L
#undef PG8_BAR
#undef PG8_SCHED
}
}
__device__ __forceinline__ int wrowmap(int kind, int n0) {
    if (kind == 0) { if (n0 < 768) return n0; if (n0 < 1792) return 1280 + (n0 - 768); if (n0 < 2304) return 768 + (n0 - 1792); return n0; }
    if (kind == 2) { if (n0 < DFF) return 256 * (n0 / 128) + (n0 % 128); const int m = n0 - DFF; return 256 * (m / 128) + 128 + (m % 128); }
    return n0;
}
__device__ __forceinline__ void transpose_item(const float* W, int K, int N, bf16_t* WT, int kind, LAS float* scr, int item, int lane) {
    const int nblk = N / 32, kb = item / nblk, nb = item % nblk, k0 = 64 * kb, n0 = 32 * nb, r0 = wrowmap(kind, n0);
#pragma unroll 8
    for (int i = 0; i < 32; ++i) { const int kk = 2 * i + (lane >> 5); scr[kk * 33 + (lane & 31)] = W[(size_t)(k0 + kk) * N + n0 + (lane & 31)]; }
    asm volatile("s_waitcnt lgkmcnt(0)" ::: "memory");
    const int c = lane & 7;
#pragma unroll
    for (int j = 0; j < 4; ++j) { const int n = (lane >> 3) + 8 * j; const LAS float* s = scr + (8 * c) * 33 + n;
        u32x4 o; o.x = pk2(s[0 * 33], s[1 * 33]); o.y = pk2(s[2 * 33], s[3 * 33]); o.z = pk2(s[4 * 33], s[5 * 33]); o.w = pk2(s[6 * 33], s[7 * 33]);
        *(u32x4*)(WT + (size_t)(r0 + n) * K + k0 + 8 * c) = o; }
    asm volatile("s_waitcnt lgkmcnt(0)" ::: "memory");
}
constexpr int WI_IN = (D / 64) * (INW / 32), WI_OUT = (D / 64) * (D / 32), WI_GU = (D / 64) * (2 * DFF / 32), WI_DN = (DFF / 64) * (D / 32), WI_LAYER = WI_IN + WI_OUT + WI_GU + WI_DN;
__device__ __forceinline__ void wconv_item(int it, const float* w_in, const float* w_out, const float* w_gu, const float* w_dn, unsigned char* ws, LAS float* scr, int lane) {
    const int l = it / WI_LAYER; int r = it % WI_LAYER;
    if (r < WI_IN) { transpose_item(w_in + (size_t)l * D * INW, D, INW, (bf16_t*)(ws + WS_WIN) + (size_t)l * INW * D, 0, scr, r, lane); return; } r -= WI_IN;
    if (r < WI_OUT) { transpose_item(w_out + (size_t)l * D * D, D, D, (bf16_t*)(ws + WS_WOUT) + (size_t)l * D * D, 1, scr, r, lane); return; } r -= WI_OUT;
    if (r < WI_GU) { transpose_item(w_gu + (size_t)l * D * 2 * DFF, D, 2 * DFF, (bf16_t*)(ws + WS_WGU) + (size_t)l * 2 * DFF * D, 2, scr, r, lane); return; } r -= WI_GU;
    transpose_item(w_dn + (size_t)l * DFF * D, DFF, D, (bf16_t*)(ws + WS_WDN) + (size_t)l * D * DFF, 1, scr, r, lane);
}
__global__ void __launch_bounds__(256) k_wconv(const float* w_in, const float* w_out, const float* w_gu, const float* w_dn, unsigned char* ws) {
    __shared__ float scr_all[4 * 64 * 33];
    const int wave = threadIdx.x >> 6, lane = threadIdx.x & 63;
    LAS float* scr = (LAS float*)scr_all + wave * 64 * 33;
    for (int it = blockIdx.x * 4 + wave; it < DEPTH * WI_LAYER; it += gridDim.x * 4) wconv_item(it, w_in, w_out, w_gu, w_dn, ws, scr, lane);
}

__global__ void __launch_bounds__(256) k_mod(const float* c, const float* c_ctx, const float* ada_w, const float* ada_b, float* MOD) {
    __shared__ float sc[3][D];
    for (int i = threadIdx.x; i < 3 * D; i += 256) { const int cd = i / D, k = i % D; const float v = cd < 2 ? c[cd * D + k] : c_ctx[k]; sc[cd][k] = v / (1.0f + expf(-v)); }
    __syncthreads();
    const int gid = blockIdx.x * 256 + threadIdx.x; if (gid >= DEPTH * 6 * D) return;
    const int l = gid / (6 * D), n = gid % (6 * D);
    const float* w = ada_w + (size_t)l * D * 6 * D + n;
    float a0 = 0.f, a1 = 0.f, a2 = 0.f;
#pragma unroll 8
    for (int k = 0; k < D; ++k) { const float wv = w[(size_t)k * 6 * D]; a0 += sc[0][k] * wv; a1 += sc[1][k] * wv; a2 += sc[2][k] * wv; }
    const float bv = ada_b[l * 6 * D + n];
    MOD[(l * 3 + 0) * 6 * D + n] = a0 + bv; MOD[(l * 3 + 1) * 6 * D + n] = a1 + bv; MOD[(l * 3 + 2) * 6 * D + n] = a2 + bv;
}

__global__ void __launch_bounds__(256) k_filt_h2(const float* w1, const float* b1, const float* w2, const float* b2, const float* freq, float* H2) {
    __shared__ float z[4][36]; __shared__ float h1[4][64];
    const int l = blockIdx.x / (FPOS / 4), p0 = (blockIdx.x % (FPOS / 4)) * 4, pl = threadIdx.x >> 6, j = threadIdx.x & 63, p = p0 + pl;
    const float t = p < SEQ ? (float)p / (float)SEQ : (float)(p - SEQ) / (float)CTXL;
    if (j < 33) { float v; if (j == 0) v = t; else { const int bnd = j <= 16 ? j : j - 16; float s, c; sincospif(2.0f * t * (float)bnd, &s, &c); v = j <= 16 ? c : s; } z[pl][j] = v; }
    __syncthreads();
    const float* W1 = w1 + l * 33 * 64; float a = b1[l * 64 + j];
#pragma unroll
    for (int i = 0; i < 33; ++i) a += z[pl][i] * W1[i * 64 + j];
    h1[pl][j] = sinf(freq[(l * 2 + 0) * 64 + j] * a);
    __syncthreads();
    const float* W2 = w2 + l * 64 * 64; float a2 = b2[l * 64 + j];
#pragma unroll
    for (int i = 0; i < 64; ++i) a2 += h1[pl][i] * W2[i * 64 + j];
    H2[((size_t)l * FPOS + p) * 64 + j] = sinf(freq[(l * 2 + 1) * 64 + j] * a2);
}
__global__ void __launch_bounds__(256) k_filt_k(const float* H2l, const float* w3l, float* KF, float* KFC) {
    __shared__ float hs[64][65]; __shared__ float wsm[64][65];
    int bx = blockIdx.x; const bool isctx = bx >= (SEQ / 64) * 16; if (isctx) bx -= (SEQ / 64) * 16;
    const int L = isctx ? CTXL : SEQ; const int pt = bx / 16, ct = bx % 16, p0 = pt * 64, c0 = ct * 64;
    const float* Hs = H2l + (size_t)(isctx ? SEQ : 0) * 64;
    for (int i = threadIdx.x; i < 64 * 64; i += 256) { const int r = i >> 6, cc = i & 63; hs[r][cc] = Hs[(size_t)(p0 + r) * 64 + cc]; wsm[r][cc] = w3l[r * 1024 + c0 + cc]; }
    __syncthreads();
    const int tx = threadIdx.x & 15, ty = threadIdx.x >> 4;
    float acc[4][4];
#pragma unroll
    for (int a = 0; a < 4; ++a)
#pragma unroll
        for (int b = 0; b < 4; ++b) acc[a][b] = 0.f;
    for (int j = 0; j < 64; ++j) {
        float hv[4], wv[4];
#pragma unroll
        for (int a = 0; a < 4; ++a) { hv[a] = hs[4 * tx + a][j]; wv[a] = wsm[j][4 * ty + a]; }
#pragma unroll
        for (int a = 0; a < 4; ++a)
#pragma unroll
            for (int b = 0; b < 4; ++b) acc[a][b] += hv[a] * wv[b];
    }
    float* out = isctx ? KFC : KF;
#pragma unroll
    for (int b = 0; b < 4; ++b) { const int col = c0 + 4 * ty + b, ch = col & 255;
        const float d0 = 15.350567286626973f, d1 = 3.0701134573253946f; const float delta = d0 + (d1 - d0) * ((float)ch / 255.0f);
        f32x4 o;
#pragma unroll
        for (int a = 0; a < 4; ++a) { const float t = (float)(p0 + 4 * tx + a) / (float)L; o[a] = acc[a][b] * expf(-t * delta); }
        *(f32x4*)(out + (size_t)col * L + p0 + 4 * tx) = o; }
}
__global__ void __launch_bounds__(256) k_knorm(const float* KF, float* KN) {
    __shared__ float red[4];
    const int oc = blockIdx.x, order = oc >> 8, c = oc & 255;
    const float* kf = KF + (size_t)((order * 2 + 0) * 256 + c) * SEQ; const float* kb = KF + (size_t)((order * 2 + 1) * 256 + c) * SEQ;
    float s = 0.f;
    for (int p = threadIdx.x; p < SEQ; p += 256) s += fabsf(kf[p]) + (p >= 1 ? fabsf(kb[p]) : 0.f);
    s = wave_sum(s); if ((threadIdx.x & 63) == 0) red[threadIdx.x >> 6] = s;
    __syncthreads();
    if (threadIdx.x == 0) KN[oc] = 1.0f / (red[0] + red[1] + red[2] + red[3]);
}

__global__ void __launch_bounds__(256) k_rownorm0(const float* x, const float* ctx, const float* g, const float* MOD0, bf16_t* H, float* XC) {
    const int lane = threadIdx.x & 63, row = blockIdx.x * 4 + (threadIdx.x >> 6); if (row >= MT) return;
    const bool isctx = row >= NLAT; const int cond = isctx ? 2 : row / SEQ;
    const float* xr = isctx ? ctx + (size_t)(row - NLAT) * D : x + (size_t)row * D;
    const float* sh = MOD0 + (size_t)cond * 6 * D; const float* sc = sh + D;
    f32x4 v[4]; float ss = 0.f;
#pragma unroll
    for (int j = 0; j < 4; ++j) { v[j] = *(const f32x4*)(xr + 4 * lane + 256 * j); ss += v[j][0] * v[j][0] + v[j][1] * v[j][1] + v[j][2] * v[j][2] + v[j][3] * v[j][3]; }
    const float rinv = 1.0f / sqrtf(wave_sum(ss) * (1.0f / D) + 1e-6f);
#pragma unroll
    for (int j = 0; j < 4; ++j) { const int col = 4 * lane + 256 * j; const f32x4 gv = *(const f32x4*)(g + col), scv = *(const f32x4*)(sc + col), shv = *(const f32x4*)(sh + col);
        if (isctx) *(f32x4*)(XC + (size_t)(row - NLAT) * D + col) = v[j];
        float o[4];
#pragma unroll
        for (int e = 0; e < 4; ++e) o[e] = v[j][e] * rinv * gv[e] * (1.0f + scv[e]) + shv[e];
        u32x2 w; w.x = pk2(o[0], o[1]); w.y = pk2(o[2], o[3]); *(u32x2*)(H + (size_t)row * D + col) = w; }
}
__global__ void __launch_bounds__(256) k_rowpass(const bf16_t* Y, const float* xin_lat, const float* xin_ctx, float* xout_lat, float* xout_ctx, const float* g_post, const float* modp, int gate_idx,
                                                 const float* g_next, const float* modn, int nidx, bf16_t* H, int nrows) {
    const int lane = threadIdx.x & 63, row = blockIdx.x * 4 + (threadIdx.x >> 6); if (row >= nrows) return;
    const bool isctx = row >= NLAT; const int cond = isctx ? 2 : row / SEQ;
    const float* xi = isctx ? xin_ctx + (size_t)(row - NLAT) * D : xin_lat + (size_t)row * D;
    float* xo = isctx ? xout_ctx + (size_t)(row - NLAT) * D : xout_lat + (size_t)row * D;
    const float* gate = modp + (size_t)cond * 6 * D + gate_idx * D;
    float y[4][4]; float ss = 0.f;
#pragma unroll
    for (int j = 0; j < 4; ++j) { const u32x2 w = *(const u32x2*)(Y + (size_t)row * D + 4 * lane + 256 * j);
        y[j][0] = bf2f(w.x & 0xffffu); y[j][1] = bf2f(w.x >> 16); y[j][2] = bf2f(w.y & 0xffffu); y[j][3] = bf2f(w.y >> 16);
        ss += y[j][0] * y[j][0] + y[j][1] * y[j][1] + y[j][2] * y[j][2] + y[j][3] * y[j][3]; }
    const float rinv = 1.0f / sqrtf(wave_sum(ss) * (1.0f / D) + 1e-6f);
    f32x4 xn[4]; float s2 = 0.f;
#pragma unroll
    for (int j = 0; j < 4; ++j) { const int col = 4 * lane + 256 * j; const f32x4 xv = *(const f32x4*)(xi + col), gp = *(const f32x4*)(g_post + col), gt = *(const f32x4*)(gate + col);
#pragma unroll
        for (int e = 0; e < 4; ++e) { xn[j][e] = xv[e] + gt[e] * (y[j][e] * rinv * gp[e]); s2 += xn[j][e] * xn[j][e]; }
        *(f32x4*)(xo + col) = xn[j]; }
    if (g_next) {
        const float r2 = 1.0f / sqrtf(wave_sum(s2) * (1.0f / D) + 1e-6f);
        const float* sh = modn + (size_t)cond * 6 * D + nidx * D; const float* sc = sh + D;
#pragma unroll
        for (int j = 0; j < 4; ++j) { const int col = 4 * lane + 256 * j; const f32x4 gv = *(const f32x4*)(g_next + col), scv = *(const f32x4*)(sc + col), shv = *(const f32x4*)(sh + col);
            float o[4];
#pragma unroll
            for (int e = 0; e < 4; ++e) o[e] = xn[j][e] * r2 * gv[e] * (1.0f + scv[e]) + shv[e];
            u32x2 w; w.x = pk2(o[0], o[1]); w.y = pk2(o[2], o[3]); *(u32x2*)(H + (size_t)row * D + col) = w; }
    }
}

__global__ void __launch_bounds__(512, 2) k_gemm(pg8::GPhase ph) {
    extern __shared__ __attribute__((aligned(16))) unsigned char lds[];
    pg8::Sched S; S.ph = ph; S.G = gridDim.x; S.c = blockIdx.x;
    pg8::Epi E;
    pg8::gemm_phase((LAS unsigned char*)lds, S, E);
}
__device__ __forceinline__ float conv3_at(const bf16_t* rowp, int s, int Lseq, float w0, float w1, float w2, float bias) {
    float a = bias + w1 * bf2f(rowp[s]);
    if (s > 0) a += w0 * bf2f(rowp[s - 1]);
    if (s + 1 < Lseq) a += w2 * bf2f(rowp[s + 1]);
    return a;
}
template <int ORDER>
__global__ void __launch_bounds__(512) k_hy_naive(const bf16_t* PTV, const float* KF, const float* KN, const float* cw, const float* cb, const float* hbias, float* Z1, bf16_t* YMIX) {
    __shared__ float us[2][2048]; __shared__ float kw[4096];
    const int c = blockIdx.x & 255, tt = blockIdx.x >> 8, T0 = tt * 2048, tid = threadIdx.x;
    const float* kf = KF + (size_t)((ORDER * 2 + 0) * 256 + c) * SEQ; const float* kb = KF + (size_t)((ORDER * 2 + 1) * 256 + c) * SEQ;
    const float w0 = cw[0 * 768 + c], w1 = cw[1 * 768 + c], w2 = cw[2 * 768 + c], wb = cb[c];
    float acc[2][4];
#pragma unroll
    for (int b = 0; b < 2; ++b)
#pragma unroll
        for (int i = 0; i < 4; ++i) acc[b][i] = 0.f;
    for (int st = 0; st < 8; ++st) {
        const int S0 = st * 2048;
        for (int i = tid; i < 4096; i += 512) { const int b = i >> 11, s = S0 + (i & 2047);
            us[b][i & 2047] = ORDER == 0 ? conv3_at(PTV + (size_t)c * MT + (size_t)b * SEQ, s, SEQ, w0, w1, w2, wb) : Z1[((size_t)c * 2 + b) * SEQ + s]; }
        const int dmin = T0 - S0 - 2047;
        for (int i = tid; i < 4095; i += 512) { const int d = dmin + i; kw[i] = d >= 0 ? kf[d] : kb[-d]; }
        __syncthreads();
        for (int s = 0; s < 2048; ++s) {
            const float u0 = us[0][s], u1 = us[1][s];
#pragma unroll
            for (int i = 0; i < 4; ++i) { const float kv = kw[tid + 512 * i - s + 2047]; acc[0][i] += kv * u0; acc[1][i] += kv * u1; }
        }
        __syncthreads();
    }
    const float invn = KN[ORDER * 256 + c], hb = hbias[ORDER * 256 + c];
    const int grow = (ORDER == 0 ? 256 : 512) + c;
    const float g0 = cw[0 * 768 + grow], g1 = cw[1 * 768 + grow], g2 = cw[2 * 768 + grow], gb = cb[grow];
#pragma unroll
    for (int b = 0; b < 2; ++b)
#pragma unroll
        for (int i = 0; i < 4; ++i) { const int t = T0 + tid + 512 * i;
            const float in_t = ORDER == 0 ? conv3_at(PTV + (size_t)c * MT + (size_t)b * SEQ, t, SEQ, w0, w1, w2, wb) : Z1[((size_t)c * 2 + b) * SEQ + t];
            const float gate = conv3_at(PTV + (size_t)grow * MT + (size_t)b * SEQ, t, SEQ, g0, g1, g2, gb);
            const float res = gate * (acc[b][i] * invn + hb * in_t);
            if (ORDER == 0) Z1[((size_t)c * 2 + b) * SEQ + t] = res; else YMIX[((size_t)b * SEQ + t) * D + c] = (bf16_t)f2bf(res); }
}
__global__ void __launch_bounds__(512) k_hy_ctx(const bf16_t* PTV, const float* KFC, const float* cw, const float* cb, const float* hbias, bf16_t* YMIX) {
    __shared__ float zin[2][256]; __shared__ float kc[512]; __shared__ float red[8];
    const int c = blockIdx.x, tid = threadIdx.x, b = tid >> 8, t = tid & 255, lane = tid & 63, wave = tid >> 6;
    const bf16_t* base = PTV + NLAT + b * CTXL;
    float zcur = conv3_at(base + (size_t)c * MT, t, CTXL, cw[c], cw[768 + c], cw[1536 + c], cb[c]);
    for (int order = 0; order < 2; ++order) {
        __syncthreads();
        zin[b][t] = zcur;
        const float* kf = KFC + (size_t)((order * 2 + 0) * 256 + c) * CTXL; const float* kb = KFC + (size_t)((order * 2 + 1) * 256 + c) * CTXL;
        float kv = 0.f; if (tid >= 1) { const int d = tid - 256; kv = d >= 0 ? kf[d] : kb[-d]; } kc[tid] = kv;
        float s = wave_sum(fabsf(kv)); if (lane == 0) red[wave] = s;
        __syncthreads();
        float tot = 0.f;
#pragma unroll
        for (int i = 0; i < 8; ++i) tot += red[i];
        float acc = 0.f;
        for (int s2 = 0; s2 < 256; ++s2) acc += kc[t - s2 + 256] * zin[b][s2];
        const int grow = (order == 0 ? 256 : 512) + c;
        const float gate = conv3_at(base + (size_t)grow * MT, t, CTXL, cw[grow], cw[768 + grow], cw[1536 + grow], cb[grow]);
        zcur = gate * (acc / tot + hbias[order * 256 + c] * zcur);
    }
    YMIX[(size_t)(NLAT + b * CTXL + t) * D + c] = (bf16_t)f2bf(zcur);
}

__global__ void __launch_bounds__(256) k_na_naive(const bf16_t* QKL, const bf16_t* PTV, const float* rpb, bf16_t* YMIX, int nrows) {
    __shared__ float qs[4][64];
    const int wave = threadIdx.x >> 6, lane = threadIdx.x & 63;
    const int item = blockIdx.x * 4 + wave; const int row = item >> 3, h = item & 7;
    if (row >= nrows) return;
    const bool isctx = row >= NLAT; const int b = isctx ? (row - NLAT) / CTXL : row / SEQ;
    qs[wave][lane] = bf2f(QKL[(size_t)row * NQKL + h * 64 + lane]) * 0.125f;
    asm volatile("s_waitcnt lgkmcnt(0)" ::: "memory");
    const bf16_t* VT = PTV + (size_t)768 * MT;
    int tok[6]; float sc[6];
    int r = 0, cq = 0, rs = 0, start = 0;
    if (!isctx) { const int t = row % SEQ; r = t / GRIDW; cq = t % GRIDW; rs = min(max(r - 4, 0), GROWS - 8); start = min(max(cq - 8, 0), GRIDW - 16); }
#pragma unroll
    for (int g = 0; g < 6; ++g) {
        float bias = 0.f; bool valid = true;
        if (g < 2) { const int kr = (lane >> 4) + 4 * g, kcol = start + (lane & 15); tok[g] = b * SEQ + (rs + kr) * GRIDW + kcol; valid = !isctx;
            if (valid) bias = rpb[(h * 15 + (rs + kr - r + 7)) * 31 + (kcol - cq + 15)]; else tok[g] = 0; }
        else tok[g] = NLAT + b * CTXL + (g - 2) * 64 + lane;
        const bf16_t* kp = QKL + (size_t)tok[g] * NQKL + 512 + h * 64;
        float dot = 0.f;
#pragma unroll
        for (int d8 = 0; d8 < 8; ++d8) { const u32x4 w = *(const u32x4*)(kp + 8 * d8);
            dot += qs[wave][8 * d8 + 0] * bf2f(w.x & 0xffffu) + qs[wave][8 * d8 + 1] * bf2f(w.x >> 16) + qs[wave][8 * d8 + 2] * bf2f(w.y & 0xffffu) + qs[wave][8 * d8 + 3] * bf2f(w.y >> 16)
                 + qs[wave][8 * d8 + 4] * bf2f(w.z & 0xffffu) + qs[wave][8 * d8 + 5] * bf2f(w.z >> 16) + qs[wave][8 * d8 + 6] * bf2f(w.w & 0xffffu) + qs[wave][8 * d8 + 7] * bf2f(w.w >> 16); }
        sc[g] = valid ? dot + bias : -1e30f;
    }
    float m = sc[0];
#pragma unroll
    for (int g = 1; g < 6; ++g) m = fmaxf(m, sc[g]);
    m = wave_max(m);
    float sum = 0.f;
#pragma unroll
    for (int g = 0; g < 6; ++g) { sc[g] = expf(sc[g] - m); sum += sc[g]; }
    sum = wave_sum(sum);
    float o = 0.f;
    for (int d = 0; d < 64; ++d) {
        const bf16_t* vp = VT + (size_t)(h * 64 + d) * MT;
        float part = 0.f;
#pragma unroll
        for (int g = 0; g < 6; ++g) part += sc[g] * bf2f(vp[tok[g]]);
        part = wave_sum(part);
        if (lane == d) o = part;
    }
    YMIX[(size_t)row * D + 256 + h * 64 + lane] = (bf16_t)f2bf(o / sum);
}

__global__ void __launch_bounds__(64) k_lru_naive(const bf16_t* QKL, const float* cw, const float* cb, const float* wa, const float* ba, const float* wi, const float* bi, const float* lam, float* HS) {
    __shared__ float us[64];
    const int lane = threadIdx.x, dir = blockIdx.x & 1, blk = (blockIdx.x >> 1) & 3, b = blockIdx.x >> 3, ch = blk * 64 + lane;
    float war[64], wir[64];
#pragma unroll
    for (int j = 0; j < 64; ++j) { war[j] = wa[((dir * 4 + blk) * 64 + j) * 64 + lane]; wir[j] = wi[((dir * 4 + blk) * 64 + j) * 64 + lane]; }
    const float bav = ba[dir * 256 + ch], biv = bi[dir * 256 + ch];
    const float lm = lam[dir * 256 + ch]; const float sp = log1pf(expf(-lm));
    const float c0 = cw[0 * 256 + ch], c1 = cw[1 * 256 + ch], c2 = cw[2 * 256 + ch], c3 = cw[3 * 256 + ch], cbv = cb[ch];
    float h = 0.f;
    for (int seg = 0; seg < 2; ++seg) {
        const int Ls = seg == 0 ? CTXL : SEQ; const int row0 = seg == 0 ? NLAT + b * CTXL : b * SEQ;
        for (int i = 0; i < Ls; ++i) {
            const int t = dir == 0 ? i : Ls - 1 - i;
            const bf16_t* xp = QKL + (size_t)(row0 + t) * NQKL + 1024 + ch;
            float u = cbv + c2 * bf2f(xp[0]);
            if (t >= 2) u += c0 * bf2f(xp[-2 * NQKL]);
            if (t >= 1) u += c1 * bf2f(xp[-1 * NQKL]);
            if (t + 1 < Ls) u += c3 * bf2f(xp[NQKL]);
            __syncthreads();
            us[lane] = u;
            __syncthreads();
            float ra = bav, ri = biv;
#pragma unroll
            for (int j = 0; j < 64; ++j) { const float uj = us[j]; ra += uj * war[j]; ri += uj * wir[j]; }
            const float rg = sigmoid_f(ra), ig = sigmoid_f(ri);
            const float log_a = -8.0f * rg * sp; const float a = expf(log_a); const float bb = sqrtf(-expm1f(2.0f * log_a)) * (ig * u);
            h = a * h + bb;
            HS[((size_t)dir * MT + row0 + t) * LRW + ch] = h;
        }
    }
}
__global__ void __launch_bounds__(256) k_lru_comb(const float* HS, const bf16_t* QKL, bf16_t* YMIX, int nrows) {
    const int row = blockIdx.x, ch = threadIdx.x; if (row >= nrows) return;
    const float hsum = HS[(size_t)row * LRW + ch] + HS[((size_t)MT + row) * LRW + ch];
    const float xg = bf2f(QKL[(size_t)row * NQKL + 1280 + ch]);
    YMIX[(size_t)row * D + 768 + ch] = (bf16_t)f2bf(hsum * gelu_tanh(xg));
}
static __device__ constexpr float C32T[16] = {1.000000000e+00f, 9.807852804e-01f, 9.238795325e-01f, 8.314696123e-01f, 7.071067812e-01f, 5.555702330e-01f, 3.826834324e-01f, 1.950903220e-01f, 0.0f, -1.950903220e-01f, -3.826834324e-01f, -5.555702330e-01f, -7.071067812e-01f, -8.314696123e-01f, -9.238795325e-01f, -9.807852804e-01f};
static __device__ constexpr float S32T[16] = {0.000000000e+00f, 1.950903220e-01f, 3.826834324e-01f, 5.555702330e-01f, 7.071067812e-01f, 8.314696123e-01f, 9.238795325e-01f, 9.807852804e-01f, 1.000000000e+00f, 9.807852804e-01f, 9.238795325e-01f, 8.314696123e-01f, 7.071067812e-01f, 5.555702330e-01f, 3.826834324e-01f, 1.950903220e-01f};
static __device__ constexpr float C64T[32] = {1.000000000e+00f, 9.951847267e-01f, 9.807852804e-01f, 9.569403357e-01f, 9.238795325e-01f, 8.819212643e-01f, 8.314696123e-01f, 7.730104534e-01f, 7.071067812e-01f, 6.343932842e-01f, 5.555702330e-01f, 4.713967368e-01f, 3.826834324e-01f, 2.902846773e-01f, 1.950903220e-01f, 9.801714033e-02f, 0.0f, -9.801714033e-02f, -1.950903220e-01f, -2.902846773e-01f, -3.826834324e-01f, -4.713967368e-01f, -5.555702330e-01f, -6.343932842e-01f, -7.071067812e-01f, -7.730104534e-01f, -8.314696123e-01f, -8.819212643e-01f, -9.238795325e-01f, -9.569403357e-01f, -9.807852804e-01f, -9.951847267e-01f};
static __device__ constexpr float S64T[32] = {0.000000000e+00f, 9.801714033e-02f, 1.950903220e-01f, 2.902846773e-01f, 3.826834324e-01f, 4.713967368e-01f, 5.555702330e-01f, 6.343932842e-01f, 7.071067812e-01f, 7.730104534e-01f, 8.314696123e-01f, 8.819212643e-01f, 9.238795325e-01f, 9.569403357e-01f, 9.807852804e-01f, 9.951847267e-01f, 1.000000000e+00f, 9.951847267e-01f, 9.807852804e-01f, 9.569403357e-01f, 9.238795325e-01f, 8.819212643e-01f, 8.314696123e-01f, 7.730104534e-01f, 7.071067812e-01f, 6.343932842e-01f, 5.555702330e-01f, 4.713967368e-01f, 3.826834324e-01f, 2.902846773e-01f, 1.950903220e-01f, 9.801714033e-02f};

namespace fft {
constexpr int L = SEQ, N2 = 2 * SEQ;
constexpr int XSLOTS = 17904;
constexpr int LDS_X_BYTES = XSLOTS * 8;
constexpr int LDS_RED = LDS_X_BYTES;
typedef LAS f32x2* xptr;
__device__ __forceinline__ f32x2 cmul(f32x2 a, f32x2 b) { return (f32x2){a.x * b.x - a.y * b.y, a.x * b.y + a.y * b.x}; }
__device__ __forceinline__ f32x2 cmulc(f32x2 a, f32x2 b) { return (f32x2){a.x * b.x + a.y * b.y, a.y * b.x - a.x * b.y}; }
__device__ __forceinline__ f32x2 expi(float x) { float s, c; sincospif(x, &s, &c); return (f32x2){c, s}; }
constexpr __host__ __device__ int bitrev(int j, int R) { int r = 0; for (int b = 1; b < R; b <<= 1) { r = (r << 1) | (j & 1); j >>= 1; } return r; }

template <int R, int S, bool INV> struct Stage {
    static __device__ __forceinline__ void run(f32x2 (&a)[R]) {
#pragma unroll
        for (int base = 0; base < R; base += 2 * S)
#pragma unroll
            for (int k = 0; k < S; ++k) {
                const int i0 = base + k, i1 = i0 + S, ti = k * (16 / S);
                const f32x2 u = a[i0], v = a[i1]; a[i0] = u + v; const f32x2 d = u - v;
                if (ti == 0) a[i1] = d;
                else if (ti == 8) a[i1] = INV ? (f32x2){-d.y, d.x} : (f32x2){d.y, -d.x};
                else { const float c = C32T[ti], s = S32T[ti]; a[i1] = INV ? (f32x2){d.x * c - d.y * s, d.x * s + d.y * c} : (f32x2){d.x * c + d.y * s, d.y * c - d.x * s}; }
            }
        if constexpr (S > 1) Stage<R, S / 2, INV>::run(a);
    }
};
template <int R, bool INV> __device__ __forceinline__ void dft(f32x2 (&a)[R]) {
    Stage<R, R / 2, INV>::run(a);
    f32x2 t[R];
#pragma unroll
    for (int j = 0; j < R; ++j) t[j] = a[bitrev(j, R)];
#pragma unroll
    for (int j = 0; j < R; ++j) a[j] = t[j];
}
template <int R, bool CONJ> __device__ __forceinline__ void twiddle(f32x2 (&a)[R], f32x2 w) {
    f32x2 tw[R]; tw[0] = (f32x2){1.f, 0.f}; tw[1] = w;
#pragma unroll
    for (int j = 2; j < R; ++j) tw[j] = cmul(tw[j >> 1], tw[j - (j >> 1)]);
#pragma unroll
    for (int j = 1; j < R; ++j) a[j] = CONJ ? cmulc(a[j], tw[j]) : cmul(a[j], tw[j]);
}
__device__ __forceinline__ void bar() { __syncthreads(); }
__device__ __forceinline__ int opaque(int v) { asm volatile("" : "+v"(v)); return v; }

__device__ __forceinline__ void fwd12(xptr X, int tid) {
    f32x2 a[32];
    { const int p0 = tid + (tid >> 4);
#pragma unroll
      for (int q = 0; q < 32; ++q) a[q] = X[p0 + 560 * q];
      dft<32, false>(a); twiddle<32, false>(a, expi(-(float)opaque(tid) * (1.0f / 8192.0f)));
#pragma unroll
      for (int q = 0; q < 32; ++q) X[p0 + 560 * q] = a[q]; }
    bar();
    { const int blk = tid >> 4, np = tid & 15, p0 = 560 * blk + np;
#pragma unroll
      for (int q = 0; q < 32; ++q) a[q] = X[p0 + 17 * q];
      dft<32, false>(a); twiddle<32, false>(a, expi(-(float)opaque(np) * (1.0f / 256.0f)));
#pragma unroll
      for (int q = 0; q < 32; ++q) X[p0 + 17 * q] = a[q]; }
    bar();
}
__device__ __forceinline__ void inv21(xptr X, int tid, f32x2 (&a)[32]) {
    { const int blk = tid >> 4, np = tid & 15, p0 = 560 * blk + np;
#pragma unroll
      for (int q = 0; q < 32; ++q) a[q] = X[p0 + 17 * q];
      twiddle<32, true>(a, expi(-(float)opaque(np) * (1.0f / 256.0f))); dft<32, true>(a);
#pragma unroll
      for (int q = 0; q < 32; ++q) X[p0 + 17 * q] = a[q]; }
    bar();
    { const int p0 = tid + (tid >> 4);
#pragma unroll
      for (int q = 0; q < 32; ++q) a[q] = X[p0 + 560 * q];
      twiddle<32, true>(a, expi(-(float)opaque(tid) * (1.0f / 8192.0f))); dft<32, true>(a); }
}
template <int MODE> __device__ __forceinline__ void pass3(xptr X, int tid, f32x2* G, float scale) {
#pragma unroll 1
    for (int gi = 0; gi < 2; ++gi) {
        const int g = tid + 512 * gi, p0 = 17 * g + 16 * (g >> 5);
        f32x2 a[16];
#pragma unroll
        for (int q = 0; q < 16; ++q) a[q] = X[p0 + q];
        dft<16, false>(a);
        if (MODE == 0) {
#pragma unroll
            for (int j = 0; j < 16; j += 2) { f32x4 o = (f32x4){a[j].x * scale, a[j].y * scale, a[j + 1].x * scale, a[j + 1].y * scale}; *(f32x4*)(G + 16 * g + j) = o; }
        } else {
#pragma unroll
            for (int j = 0; j < 16; j += 2) { const f32x4 kv = *(const f32x4*)(G + 16 * g + j); a[j] = cmul(a[j], (f32x2){kv.x, kv.y}); a[j + 1] = cmul(a[j + 1], (f32x2){kv.z, kv.w}); }
            dft<16, true>(a);
#pragma unroll
            for (int q = 0; q < 16; ++q) X[p0 + q] = a[q];
        }
    }
    if (MODE == 1) bar();
}
__device__ __forceinline__ f32x2 wN(f32x2 base, int q) { return cmul(base, (f32x2){C64T[q], -S64T[q]}); }

__device__ __forceinline__ void filter_unit(LAS unsigned char* lds, const float* kf, const float* kb, f32x2* KFo) {
    xptr X = (xptr)lds; LAS float* red = (LAS float*)(lds + LDS_RED);
    const int tid = threadIdx.x, p0 = tid + (tid >> 4);
    const f32x2 base = expi(-(float)tid * (1.0f / 16384.0f));
    float nrm = 0.f;
#pragma unroll 4
    for (int q = 0; q < 32; ++q) { const int n = tid + 512 * q; const float f = kf[n], b = n >= 1 ? kb[L - n] : 0.f; nrm += fabsf(f) + fabsf(b); X[p0 + 560 * q] = (f32x2){f + b, 0.f}; }
    nrm = wave_sum(nrm); if ((tid & 63) == 0) red[tid >> 6] = nrm;
    bar();
    float tot = 0.f;
#pragma unroll
    for (int i = 0; i < 8; ++i) tot += red[i];
    const float scale = 1.0f / (tot * (float)N2);
    fwd12(X, tid); pass3<0>(X, tid, KFo, scale);
    bar();
    asm volatile("" ::: "memory");
#pragma unroll 4
    for (int q = 0; q < 32; ++q) { const int n = tid + 512 * q; const float f = kf[n], b = n >= 1 ? kb[L - n] : 0.f; const f32x2 w = wN(base, q); const float d = f - b; X[p0 + 560 * q] = (f32x2){d * w.x, d * w.y}; asm volatile("" ::: "memory"); }
    bar();
    fwd12(X, tid); pass3<0>(X, tid, KFo + L, scale);
    bar();
}

__device__ __forceinline__ f32x2 conv3_pair(const bf16_t* row, int n, float w0, float w1, float w2, float wb) {
    const int nm = n > 0 ? n - 1 : 0, np = n + 1 < SEQ ? n + 1 : SEQ - 1; const float wm = n > 0 ? w0 : 0.f, wp = n + 1 < SEQ ? w2 : 0.f;
    const float a0 = wb + w1 * bf2f(row[n]) + wm * bf2f(row[nm]) + wp * bf2f(row[np]);
    const float a1 = wb + w1 * bf2f(row[SEQ + n]) + wm * bf2f(row[SEQ + nm]) + wp * bf2f(row[SEQ + np]);
    return (f32x2){a0, a1};
}
__device__ __forceinline__ void hyena_unit(LAS unsigned char* lds, int c, const bf16_t* PTV, const f32x2* KFc, size_t ostride, const float* cw, const float* cb, const float* hbias,
                                           f32x2* Zs, f32x2* Rs, bf16_t* YMIX) {
    xptr X = (xptr)lds;
    const int tid = threadIdx.x, p0 = tid + (tid >> 4);
    f32x2 a[32];
    { const int t0 = opaque(tid); const bf16_t* row = PTV + (size_t)c * MT; const float w0 = cw[c], w1 = cw[768 + c], w2 = cw[1536 + c], wb = cb[c];
#pragma unroll
      for (int q0 = 0; q0 < 32; q0 += 4) {
#pragma unroll
          for (int q = q0; q < q0 + 4; ++q) a[q] = conv3_pair(row, t0 + 512 * q, w0, w1, w2, wb);
          asm volatile("" ::: "memory"); } }
#pragma unroll 1
    for (int order = 0; order < 2; ++order) {
        const f32x2* Ke = KFc + (size_t)order * ostride; const f32x2* Ko = Ke + L;
        { const int t1 = opaque(tid);
#pragma unroll
          for (int q = 0; q < 32; ++q) { X[p0 + 560 * q] = a[q]; Zs[t1 + 512 * q] = a[q]; } }
        bar();
        fwd12(X, tid); pass3<1>(X, tid, const_cast<f32x2*>(Ke), 1.f); inv21(X, tid, a);
        { const int t2 = opaque(tid);
#pragma unroll
          for (int q = 0; q < 32; ++q) Rs[t2 + 512 * q] = a[q]; }
        asm volatile("" ::: "memory");
        const int t3 = opaque(tid); const f32x2 base1 = expi(-(float)t3 * (1.0f / 16384.0f));
#pragma unroll
        for (int q0 = 0; q0 < 32; q0 += 8) {
#pragma unroll
            for (int q = q0; q < q0 + 8; ++q) X[p0 + 560 * q] = cmul(Zs[t3 + 512 * q], wN(base1, q));
            asm volatile("" ::: "memory"); }
        bar();
        fwd12(X, tid); pass3<1>(X, tid, const_cast<f32x2*>(Ko), 1.f); inv21(X, tid, a);
        const int grow = (order == 0 ? 256 : 512) + c; const bf16_t* rowg = PTV + (size_t)grow * MT;
        const float g0 = cw[grow], g1 = cw[768 + grow], g2 = cw[1536 + grow], gb = cb[grow], hb = hbias[order * 256 + c];
        asm volatile("" ::: "memory");
        const int t4 = opaque(tid); const f32x2 base2 = expi(-(float)t4 * (1.0f / 16384.0f));
#pragma unroll
        for (int q0 = 0; q0 < 32; q0 += 4) {
#pragma unroll
            for (int q = q0; q < q0 + 4; ++q) { const int n = t4 + 512 * q;
                const f32x2 y = Rs[n] + cmulc(a[q], wN(base2, q)); const f32x2 zq = Zs[n]; const f32x2 gt = conv3_pair(rowg, n, g0, g1, g2, gb);
                a[q] = (f32x2){gt.x * (y.x + hb * zq.x), gt.y * (y.y + hb * zq.y)}; }
            asm volatile("" ::: "memory"); }
        bar();
    }
    { bf16_t* yp = YMIX + (size_t)tid * D + c;
#pragma unroll
      for (int q = 0; q < 32; ++q) { yp[0] = (bf16_t)f2bf(a[q].x); yp[(size_t)SEQ * D] = (bf16_t)f2bf(a[q].y); yp += (size_t)512 * D; asm volatile("" : "+v"(yp)); } }
}
}

constexpr int MK_LDS_BYTES = 147456;
static_assert(fft::LDS_RED + 64 <= MK_LDS_BYTES, "LDS map");
__global__ void __launch_bounds__(512, 2) k_filt_fft(const float* KF, f32x2* KFS) {
    extern __shared__ __attribute__((aligned(16))) unsigned char lds[];
    for (int u = blockIdx.x; u < 512; u += gridDim.x) { const int order = u >> 8, c = u & 255;
        fft::filter_unit((LAS unsigned char*)lds, KF + (size_t)((order * 2 + 0) * 256 + c) * SEQ, KF + (size_t)((order * 2 + 1) * 256 + c) * SEQ, KFS + ((size_t)order * 256 + c) * 2 * SEQ); }
}
__global__ void __launch_bounds__(512, 2) k_hy_fft(const bf16_t* PTV, const f32x2* KFS, const float* cw, const float* cb, const float* hbias, f32x2* scratch, bf16_t* YMIX) {
    extern __shared__ __attribute__((aligned(16))) unsigned char lds[];
    const int bx = blockIdx.x; f32x2* Zs = scratch + (size_t)bx * SEQ; f32x2* Rs = scratch + (size_t)(gridDim.x + bx) * SEQ;
    for (int u = bx; u < 256; u += gridDim.x) { const int c = (gridDim.x == 256) ? (u & 7) * 32 + (u >> 3) : u;
        fft::hyena_unit((LAS unsigned char*)lds, c, PTV, KFS + (size_t)c * 2 * SEQ, (size_t)256 * 2 * SEQ, cw, cb, hbias, Zs, Rs, YMIX); }
}
static void launch_gemm(const pg8::GPhase& ph, hipStream_t stream) { hipLaunchKernelGGL(k_gemm, dim3(256), dim3(512), pg8::STAGE_BYTES, stream, ph); }
static pg8::GPhase one_seg(const bf16_t* A, const bf16_t* B, bf16_t* C, int nM, int nN, int ldc, int epi, int K) {
    pg8::GPhase ph{}; ph.s0 = pg8::GSeg{A, B, C, nM, nN, ldc, epi}; ph.s1 = ph.s0; ph.n0 = nM * nN; ph.total = nM * nN; ph.K = K; ph.pad = 0; return ph;
}
extern "C" void kernel_launch(void* const* d_in, const int* in_sizes, int n_in, void* d_out, int out_size, void* d_ws, size_t ws_size, hipStream_t stream) {
    static int inited = 0;
    if (!inited) {
        if (n_in != 31 || in_sizes[0] != NLAT * D || out_size != NLAT * D || ws_size < WS_END) { fprintf(stderr, "kernel_launch: unexpected shapes (n_in %d, in0 %d, out %d, ws %zu)\n", n_in, n_in > 0 ? in_sizes[0] : -1, out_size, ws_size); inited = -1; return; }
        if (hipFuncSetAttribute((const void*)k_gemm, hipFuncAttributeMaxDynamicSharedMemorySize, pg8::STAGE_BYTES) != hipSuccess ||
            hipFuncSetAttribute((const void*)k_filt_fft, hipFuncAttributeMaxDynamicSharedMemorySize, MK_LDS_BYTES) != hipSuccess ||
            hipFuncSetAttribute((const void*)k_hy_fft, hipFuncAttributeMaxDynamicSharedMemorySize, MK_LDS_BYTES) != hipSuccess) { fprintf(stderr, "kernel_launch: hipFuncSetAttribute failed\n"); inited = -1; return; }
        inited = 1;
    }
    if (inited < 0) return;
    const float* x = (const float*)d_in[0]; const float* c = (const float*)d_in[1]; const float* ctx = (const float*)d_in[2]; const float* c_ctx = (const float*)d_in[3];
    const float* ada_w = (const float*)d_in[4]; const float* ada_b = (const float*)d_in[5];
    const float* g_mix_pre = (const float*)d_in[6]; const float* g_mix_post = (const float*)d_in[7]; const float* g_ffn_pre = (const float*)d_in[8]; const float* g_ffn_post = (const float*)d_in[9];
    const float* w_in = (const float*)d_in[10]; const float* w_out = (const float*)d_in[11];
    const float* hy_conv_w = (const float*)d_in[12]; const float* hy_conv_b = (const float*)d_in[13];
    const float* hy_f_w1 = (const float*)d_in[14]; const float* hy_f_b1 = (const float*)d_in[15]; const float* hy_f_w2 = (const float*)d_in[16]; const float* hy_f_b2 = (const float*)d_in[17];
    const float* hy_f_w3 = (const float*)d_in[18]; const float* hy_f_freq = (const float*)d_in[19]; const float* hy_bias = (const float*)d_in[20];
    const float* na_rpb = (const float*)d_in[21];
    const float* lru_conv_w = (const float*)d_in[22]; const float* lru_conv_b = (const float*)d_in[23]; const float* lru_wa = (const float*)d_in[24]; const float* lru_ba = (const float*)d_in[25];
    const float* lru_wi = (const float*)d_in[26]; const float* lru_bi = (const float*)d_in[27]; const float* lru_lam = (const float*)d_in[28];
    const float* w_gu = (const float*)d_in[29]; const float* w_dn = (const float*)d_in[30];
    unsigned char* ws = (unsigned char*)d_ws; float* out = (float*)d_out;
    bf16_t* Win_t = (bf16_t*)(ws + WS_WIN); bf16_t* Wout_t = (bf16_t*)(ws + WS_WOUT); bf16_t* Wgu_t = (bf16_t*)(ws + WS_WGU); bf16_t* Wdn_t = (bf16_t*)(ws + WS_WDN);
    float* MOD = (float*)(ws + WS_MOD); float* XC = (float*)(ws + WS_XC); float* H2 = (float*)(ws + WS_H2); float* KN = (float*)(ws + WS_KN);
    bf16_t* H = (bf16_t*)(ws + WS_H); bf16_t* Y = (bf16_t*)(ws + WS_Y); bf16_t* PTV = (bf16_t*)(ws + WS_PTV); bf16_t* QKL = (bf16_t*)(ws + WS_QKL); bf16_t* ACT = (bf16_t*)(ws + WS_ACT);
    bf16_t* YMIX = (bf16_t*)(ws + WS_YMIX); float* KF = (float*)(ws + WS_KF); float* KFC = (float*)(ws + WS_KFC);
    float* HS = (float*)(ws + WS_HF); float* Z1 = (float*)(ws + WS_Z1);

    hipLaunchKernelGGL(k_wconv, dim3(1024), dim3(256), 0, stream, w_in, w_out, w_gu, w_dn, ws);
    hipLaunchKernelGGL(k_mod, dim3(DEPTH * 6 * D / 256), dim3(256), 0, stream, c, c_ctx, ada_w, ada_b, MOD);
    hipLaunchKernelGGL(k_filt_h2, dim3(DEPTH * FPOS / 4), dim3(256), 0, stream, hy_f_w1, hy_f_b1, hy_f_w2, hy_f_b2, hy_f_freq, H2);
    hipLaunchKernelGGL(k_rownorm0, dim3(MT / 4), dim3(256), 0, stream, x, ctx, g_mix_pre, MOD, H, XC);
    for (int l = 0; l < DEPTH; ++l) {
        const float* modl = MOD + (size_t)l * 3 * 6 * D;
        hipLaunchKernelGGL(k_filt_k, dim3((SEQ / 64) * 16 + (CTXL / 64) * 16), dim3(256), 0, stream, H2 + (size_t)l * FPOS * 64, hy_f_w3 + (size_t)l * 64 * 1024, KF, KFC);
        {
            pg8::GPhase ph{}; const bf16_t* W = Win_t + (size_t)l * INW * D;
            ph.s0 = pg8::GSeg{W, H, PTV, NPTV / 256, MT / 256, MT, 0}; ph.s1 = pg8::GSeg{H, W + (size_t)NPTV * D, QKL, MT / 256, NQKL / 256, NQKL, 0};
            ph.n0 = (NPTV / 256) * (MT / 256); ph.total = ph.n0 + (MT / 256) * (NQKL / 256); ph.K = D; ph.pad = 0;
            launch_gemm(ph, stream);
        }
        const float* hcw = hy_conv_w + (size_t)l * 3 * 768; const float* hcb = hy_conv_b + (size_t)l * 768; const float* hb = hy_bias + (size_t)l * 2 * 256;
        hipLaunchKernelGGL(k_filt_fft, dim3(256), dim3(512), MK_LDS_BYTES, stream, KF, (f32x2*)(ws + WS_H));
        hipLaunchKernelGGL(k_hy_fft, dim3(256), dim3(512), MK_LDS_BYTES, stream, PTV, (const f32x2*)(ws + WS_H), hcw, hcb, hb, (f32x2*)(ws + WS_KF), YMIX);
        const int nrows = (l == 0) ? MT : NLAT;
        if (l == 0) hipLaunchKernelGGL(k_hy_ctx, dim3(256), dim3(512), 0, stream, PTV, KFC, hcw, hcb, hb, YMIX);
        hipLaunchKernelGGL(k_na_naive, dim3(nrows * 8 / 4), dim3(256), 0, stream, QKL, PTV, na_rpb + (size_t)l * 8 * 15 * 31, YMIX, nrows);
        hipLaunchKernelGGL(k_lru_naive, dim3(16), dim3(64), 0, stream, QKL, lru_conv_w + (size_t)l * 4 * 256, lru_conv_b + (size_t)l * 256, lru_wa + (size_t)l * 2 * 4 * 64 * 64, lru_ba + (size_t)l * 512,
                           lru_wi + (size_t)l * 2 * 4 * 64 * 64, lru_bi + (size_t)l * 512, lru_lam + (size_t)l * 512, HS);
        hipLaunchKernelGGL(k_lru_comb, dim3(nrows), dim3(256), 0, stream, HS, QKL, YMIX, nrows);
        launch_gemm(one_seg(YMIX, Wout_t + (size_t)l * D * D, Y, MT / 256, D / 256, D, 0, D), stream);
        hipLaunchKernelGGL(k_rowpass, dim3(MT / 4), dim3(256), 0, stream, Y, l == 0 ? x : out, l == 0 ? ctx : XC, out, XC, g_mix_post + (size_t)l * D, modl, 2,
                           g_ffn_pre + (size_t)l * D, modl, 3, H, nrows);
        launch_gemm(one_seg(H, Wgu_t + (size_t)l * 2 * DFF * D, ACT, MT / 256, 2 * DFF / 256, DFF, 1, D), stream);
        launch_gemm(one_seg(ACT, Wdn_t + (size_t)l * D * DFF, Y, MT / 256, D / 256, D, 0, DFF), stream);
        const bool lastl = (l == DEPTH - 1);
        hipLaunchKernelGGL(k_rowpass, dim3(MT / 4), dim3(256), 0, stream, Y, out, XC, out, XC, g_ffn_post + (size_t)l * D, modl, 5,
                           lastl ? (const float*)nullptr : g_mix_pre + (size_t)(l + 1) * D, lastl ? modl : modl + 3 * 6 * D, 0, H, nrows);
    }
}
```

```cpp
#include <hip/hip_runtime.h>
#include <cstdio>
#include <cstdint>
#include <cmath>

#define LAS __attribute__((address_space(3)))
typedef unsigned short bf16_t;
typedef short bf16x8 __attribute__((ext_vector_type(8)));
typedef float f32x4 __attribute__((ext_vector_type(4)));
typedef float f32x2 __attribute__((ext_vector_type(2)));
typedef unsigned u32x4 __attribute__((ext_vector_type(4)));
typedef unsigned u32x2 __attribute__((ext_vector_type(2)));

constexpr int D = 1024, NB = 2, SEQ = 16384, DEPTH = 2, GRIDW = 64, GROWS = 256, CTXL = 256;
constexpr int NLAT = NB * SEQ, NCTX = NB * CTXL, MT = NLAT + NCTX;
constexpr int HYW = 256, NAW = 512, NHEAD = 8, DH = 64, LRW = 256, INW = 2816, DFF = 2816;
constexpr int NPTV = 1280;
constexpr int NQKL = 1536;
constexpr int FPOS = SEQ + CTXL;

constexpr size_t MiB = 1u << 20;
constexpr size_t WS_CTL = 0;
constexpr size_t WS_WIN = 1 * MiB, WS_WOUT = 12 * MiB, WS_WGU = 16 * MiB, WS_WDN = 38 * MiB;
constexpr size_t WS_MOD = 49 * MiB;
constexpr size_t WS_XC = 50 * MiB;
constexpr size_t WS_H2 = 52 * MiB;
constexpr size_t WS_KN = 61 * MiB;
constexpr size_t WS_H = 64 * MiB;
constexpr size_t WS_Y = 129 * MiB;
constexpr size_t WS_PTV = 194 * MiB;
constexpr size_t WS_QKL = WS_PTV + (size_t)NPTV * MT * 2;
constexpr size_t WS_ACT = WS_PTV;
constexpr size_t WS_YMIX = 373 * MiB;
constexpr size_t WS_KF = 438 * MiB;
constexpr size_t WS_KFC = 502 * MiB;
constexpr size_t WS_AGG = 504 * MiB;
constexpr size_t WS_LW = 62 * MiB;
constexpr size_t WS_END = 508 * MiB;
constexpr size_t WS_HF = WS_H, WS_HR = WS_H + (size_t)MT * LRW * 4;
constexpr size_t WS_Z1 = WS_Y;
static_assert(WS_QKL + (size_t)MT * NQKL * 2 <= WS_YMIX && WS_ACT + (size_t)MT * DFF * 2 <= WS_YMIX, "ws map");
static_assert(WS_HR + (size_t)MT * LRW * 4 <= WS_Y && WS_Z1 + (size_t)256 * 2 * SEQ * 4 <= WS_PTV, "ws map");

__device__ __forceinline__ unsigned f2bf(float f) { unsigned u = __float_as_uint(f); return (u + 0x7fffu + ((u >> 16) & 1u)) >> 16; }
__device__ __forceinline__ unsigned pk2(float lo, float hi) { return f2bf(lo) | (f2bf(hi) << 16); }
__device__ __forceinline__ float bf2f(unsigned h) { return __uint_as_float(h << 16); }
__device__ __forceinline__ float wave_sum(float v) {
#pragma unroll
    for (int o = 1; o < 64; o <<= 1) v += __shfl_xor(v, o);
    return v;
}
__device__ __forceinline__ float wave_max(float v) {
#pragma unroll
    for (int o = 1; o < 64; o <<= 1) v = fmaxf(v, __shfl_xor(v, o));
    return v;
}
__device__ __forceinline__ float silu_f(float g) { return g * __builtin_amdgcn_rcpf(1.0f + __builtin_amdgcn_exp2f(-1.44269504089f * g)); }
__device__ __forceinline__ float sigmoid_f(float g) { return 1.0f / (1.0f + expf(-g)); }
__device__ __forceinline__ float gelu_tanh(float x) { const float u = 0.7978845608028654f * (x + 0.044715f * x * x * x); return 0.5f * x * (1.0f + tanhf(u)); }

namespace pg8 {
constexpr int BM = 256, BK = 64, HALF = 128, HTB = HALF * BK * 2, STAGE_BYTES = 8 * HTB;
__host__ __device__ __forceinline__ int lds_byte(int r, int c) { const int st = (r >> 4) * 2 + (c >> 5), rr = r & 15, cc = c & 31, ob = rr * 64 + cc * 2; return st * 1024 + (ob ^ (((ob >> 9) & 1) << 5)); }
__host__ __device__ __forceinline__ void stage_rc(int b, int& R, int& C) { const int st = b / 1024, sb = b % 1024, swz = sb ^ (((sb >> 9) & 1) << 5); R = (st >> 1) * 16 + swz / 64; C = (st & 1) * 32 + (swz % 64) / 2; }
__host__ __device__ __forceinline__ int perm32(int rho) { const int n = rho >> 4, i = rho & 15; return 8 * (i >> 2) + 4 * n + (i & 3); }

struct GSeg { const bf16_t* A; const bf16_t* B; bf16_t* C; int nM, nN, ldc, epi; };
struct GPhase { GSeg s0, s1; int n0, total, K, pad; };
struct Unit { const char* a; const char* b; bf16_t* C; int ldc, epi, pm, pn; };

struct Sched {
    GPhase ph; int G, c;
    __device__ __forceinline__ bool next(int i, Unit& u) const {
        const long L = (long)i * G + c; if (L >= ph.total) return false;
        int wgid = (int)L; { const int nwg = ph.total, q = nwg / 8, r = nwg % 8, xcd = wgid % 8, off = wgid / 8; wgid = (xcd < r ? xcd * (q + 1) : r * (q + 1) + (xcd - r) * q) + off; }
        const bool first = wgid < ph.n0; if (!first) wgid -= ph.n0;
        const bf16_t* A = first ? ph.s0.A : ph.s1.A; const bf16_t* B = first ? ph.s0.B : ph.s1.B; bf16_t* C = first ? ph.s0.C : ph.s1.C;
        const int nM = first ? ph.s0.nM : ph.s1.nM, nN = first ? ph.s0.nN : ph.s1.nN;
        u.ldc = first ? ph.s0.ldc : ph.s1.ldc; u.epi = first ? ph.s0.epi : ph.s1.epi; u.C = C;
        const int nig = 8 * nN, gid = wgid / nig, fm = gid * 8, gsz = (nM - fm) < 8 ? (nM - fm) : 8;
        u.pm = fm + ((wgid % nig) % gsz); u.pn = (wgid % nig) / gsz;
        u.a = (const char*)A + (size_t)u.pm * BM * ph.K * 2; u.b = (const char*)B + (size_t)u.pn * BM * ph.K * 2;
        return true;
    }
};

__device__ __forceinline__ unsigned cvt_pk_bf16(float lo, float hi) { unsigned r; asm volatile("v_cvt_pk_bf16_f32 %0, %1, %2" : "=v"(r) : "v"(lo), "v"(hi)); return r; }

struct Epi {
    __device__ __forceinline__ void operator()(const f32x4 (&acc)[2][2][4][2], const Unit& u, int wr, int wc, int fr, int fq) const {
        const int row0 = u.pm * BM + wr * 64 + fr;
        if (u.epi == 0) {
            const int col0 = u.pn * BM + wc * 32 + 8 * fq;
#pragma unroll
            for (int ai = 0; ai < 2; ++ai)
#pragma unroll
                for (int m = 0; m < 4; ++m) { bf16_t* rowp = u.C + (size_t)(row0 + ai * HALF + m * 16) * u.ldc + col0;
#pragma unroll
                    for (int bj = 0; bj < 2; ++bj) { const f32x4 v0 = acc[ai][bj][m][0], v1 = acc[ai][bj][m][1];
                        u32x4 w; w.x = cvt_pk_bf16(v0[0], v0[1]); w.y = cvt_pk_bf16(v0[2], v0[3]); w.z = cvt_pk_bf16(v1[0], v1[1]); w.w = cvt_pk_bf16(v1[2], v1[3]);
                        *(u32x4*)(rowp + bj * HALF) = w; } }
        } else {
            const int col0 = u.pn * HALF + wc * 32 + 8 * fq;
#pragma unroll
            for (int ai = 0; ai < 2; ++ai)
#pragma unroll
                for (int m = 0; m < 4; ++m) { bf16_t* rowp = u.C + (size_t)(row0 + ai * HALF + m * 16) * u.ldc + col0;
                    const f32x4 g0 = acc[ai][0][m][0], g1 = acc[ai][0][m][1], u0 = acc[ai][1][m][0], u1 = acc[ai][1][m][1];
                    u32x4 w; w.x = cvt_pk_bf16(silu_f(g0[0]) * u0[0], silu_f(g0[1]) * u0[1]); w.y = cvt_pk_bf16(silu_f(g0[2]) * u0[2], silu_f(g0[3]) * u0[3]);
                    w.z = cvt_pk_bf16(silu_f(g1[0]) * u1[0], silu_f(g1[1]) * u1[1]); w.w = cvt_pk_bf16(silu_f(g1[2]) * u1[2], silu_f(g1[3]) * u1[3]);
                    *(u32x4*)rowp = w; }
        }
    }
};

__device__ __forceinline__ void gemm_phase(LAS unsigned char* lds, const Sched& S, const Epi& E) {
    const int tid = threadIdx.x, wid = __builtin_amdgcn_readfirstlane(tid >> 6), lane = tid & 63, wr = wid >> 2, wc = wid & 3, fr = lane & 15, fq = lane >> 4;
    const int K = S.ph.K, nt = K / BK;
    unsigned voffA[2], voffB[2];
#pragma unroll
    for (int i = 0; i < 2; ++i) { int R, C; stage_rc(tid * 16 + i * 8192, R, C); const int Rb = (R & ~31) + perm32(R & 31);
        voffA[i] = (unsigned)(R * K + C) * 2u; voffB[i] = (unsigned)(Rb * K + C) * 2u; }
    const size_t kstep = (size_t)(BK * 2);
    const size_t hstep = (size_t)HALF * K * 2;
    const unsigned ldsw = (unsigned)wid * 1024u;
    const int aoff = lds_byte(wr * 64 + fr, fq * 8), boff = lds_byte(wc * 32 + fr, fq * 8);
#define PG8_SA(b, h) (((b) * 2 + (h)) * HTB)
#define PG8_SB(b, h) ((4 + (b) * 2 + (h)) * HTB)
#define PG8_STAGE(bufoff, gbase, voff) do { _Pragma("unroll") for (int _i = 0; _i < 2; ++_i) \
        __builtin_amdgcn_global_load_lds((const unsigned*)((const char*)(gbase) + (voff)[_i]), (LAS unsigned*)(lds + (bufoff) + ldsw + _i * 8192), 16, 0, 0); } while (0)
#define PG8_LDA(dst, b, h) do { _Pragma("unroll") for (int m = 0; m < 4; ++m) _Pragma("unroll") for (int k = 0; k < 2; ++k) dst[m][k] = *(const LAS bf16x8*)(lds + PG8_SA(b, h) + aoff + m * 2048 + k * 1024); } while (0)
#define PG8_LDB(dst, b, h) do { _Pragma("unroll") for (int n = 0; n < 2; ++n) _Pragma("unroll") for (int k = 0; k < 2; ++k) dst[n][k] = *(const LAS bf16x8*)(lds + PG8_SB(b, h) + boff + n * 2048 + k * 1024); } while (0)
#define PG8_MMA(ai, bj, At, Bt) do { __builtin_amdgcn_s_setprio(1); _Pragma("unroll") for (int m = 0; m < 4; ++m) _Pragma("unroll") for (int n = 0; n < 2; ++n) _Pragma("unroll") for (int k = 0; k < 2; ++k) \
        acc[ai][bj][m][n] = __builtin_amdgcn_mfma_f32_16x16x32_bf16(Bt[n][k], At[m][k], acc[ai][bj][m][n], 0, 0, 0); __builtin_amdgcn_s_setprio(0); } while (0)
#define PG8_WAIT_V(n) asm volatile("s_waitcnt vmcnt(" #n ")" ::: "memory")
#define PG8_WAIT_L(n) asm volatile("s_waitcnt lgkmcnt(" #n ")" ::: "memory")
#define PG8_BAR __builtin_amdgcn_s_barrier()
#define PG8_SCHED __builtin_amdgcn_sched_barrier(0)
    Unit cur, nxt; int ui = 0;
    if (!S.next(0, cur)) return;
    f32x4 acc[2][2][4][2];
#pragma unroll
    for (int a = 0; a < 2; ++a)
#pragma unroll
        for (int b = 0; b < 2; ++b)
#pragma unroll
            for (int m = 0; m < 4; ++m)
#pragma unroll
                for (int n = 0; n < 2; ++n) acc[a][b][m][n] = (f32x4){0.f, 0.f, 0.f, 0.f};
    bf16x8 At[4][2], B0[2][2], B1[2][2];
    const char* cA = cur.a; const char* cB = cur.b;
    PG8_STAGE(PG8_SB(0, 0), cB, voffB); PG8_STAGE(PG8_SB(0, 1), cB + hstep, voffB); PG8_STAGE(PG8_SA(0, 0), cA, voffA); PG8_STAGE(PG8_SA(0, 1), cA + hstep, voffA);
    if (wr == 1) PG8_BAR;
    PG8_WAIT_V(2); PG8_BAR;
    PG8_STAGE(PG8_SB(1, 0), cB + kstep, voffB); PG8_STAGE(PG8_SA(1, 0), cA + kstep, voffA); PG8_STAGE(PG8_SB(1, 1), cB + hstep + kstep, voffB);
    PG8_WAIT_V(6); PG8_BAR;
    for (;;) {
        const bool has_next = S.next(ui + 1, nxt);
        const char* nA = has_next ? nxt.a : cA; const char* nB = has_next ? nxt.b : cB;
        for (int t = 0; t < nt; t += 2) {
            const bool last = (t == nt - 2);
            const char* a1 = cA + (size_t)(t + 1) * kstep;
            const char* a2 = last ? nA : cA + (size_t)(t + 2) * kstep; const char* b2 = last ? nB : cB + (size_t)(t + 2) * kstep;
            const char* a3 = a2 + kstep; const char* b3 = b2 + kstep;
            PG8_LDB(B0, 0, 0); PG8_LDB(B1, 0, 1); PG8_SCHED; PG8_LDA(At, 0, 0); PG8_STAGE(PG8_SA(1, 1), a1 + hstep, voffA);
            PG8_WAIT_V(8); PG8_WAIT_L(0); PG8_BAR; PG8_MMA(0, 0, At, B0); PG8_MMA(0, 1, At, B1); PG8_BAR; PG8_SCHED;
            PG8_LDA(At, 0, 1); PG8_STAGE(PG8_SB(0, 0), b2, voffB); PG8_STAGE(PG8_SB(0, 1), b2 + hstep, voffB); PG8_STAGE(PG8_SA(0, 0), a2, voffA);
            PG8_WAIT_V(8); PG8_WAIT_L(0); PG8_BAR; PG8_MMA(1, 0, At, B0); PG8_MMA(1, 1, At, B1); PG8_BAR; PG8_SCHED;
            PG8_LDB(B0, 1, 0); PG8_LDB(B1, 1, 1); PG8_SCHED; PG8_LDA(At, 1, 0); PG8_STAGE(PG8_SA(0, 1), a2 + hstep, voffA);
            PG8_WAIT_V(8); PG8_WAIT_L(0); PG8_BAR; PG8_MMA(0, 0, At, B0); PG8_MMA(0, 1, At, B1); PG8_BAR; PG8_SCHED;
            PG8_LDA(At, 1, 1); PG8_STAGE(PG8_SB(1, 0), b3, voffB); PG8_STAGE(PG8_SB(1, 1), b3 + hstep, voffB); PG8_STAGE(PG8_SA(1, 0), a3, voffA);
            PG8_WAIT_V(8); PG8_WAIT_L(0); PG8_BAR; PG8_MMA(1, 0, At, B0); PG8_MMA(1, 1, At, B1); PG8_BAR; PG8_SCHED;
        }
        if (wr == 0) PG8_BAR;
        E(acc, cur, wr, wc, fr, fq);
        if (!has_next) break;
#pragma unroll
        for (int a = 0; a < 2; ++a)
#pragma unroll
            for (int b = 0; b < 2; ++b)
#pragma unroll
                for (int m = 0; m < 4; ++m)
#pragma unroll
                    for (int n = 0; n < 2; ++n) acc[a][b][m][n] = (f32x4){0.f, 0.f, 0.f, 0.f};
        cur = nxt; cA = nA; cB = nB; ++ui;
        if (wr == 1) PG8_BAR;
    }
    PG8_WAIT_V(0);
    PG8_BAR;
#undef PG8_SA
#undef PG8_SB
#undef PG8_STAGE
#undef PG8_LDA
#undef PG8_LDB
#undef PG8_MMA
#undef PG8_WAIT_V
#undef PG8_WAIT_L
#undef PG8_BAR
#undef PG8_SCHED
}
}
__device__ __forceinline__ int wrowmap(int kind, int n0) {
    if (kind == 0) { if (n0 < 768) return n0; if (n0 < 1792) return 1280 + (n0 - 768); if (n0 < 2304) return 768 + (n0 - 1792); return n0; }
    if (kind == 2) { if (n0 < DFF) return 256 * (n0 / 128) + (n0 % 128); const int m = n0 - DFF; return 256 * (m / 128) + 128 + (m % 128); }
    return n0;
}
__device__ __forceinline__ void transpose_item(const float* W, int K, int N, bf16_t* WT, int kind, LAS float* scr, int item, int lane) {
    const int nblk = N / 32, kb = item / nblk, nb = item % nblk, k0 = 64 * kb, n0 = 32 * nb, r0 = wrowmap(kind, n0);
#pragma unroll 8
    for (int i = 0; i < 32; ++i) { const int kk = 2 * i + (lane >> 5); scr[kk * 33 + (lane & 31)] = W[(size_t)(k0 + kk) * N + n0 + (lane & 31)]; }
    asm volatile("s_waitcnt lgkmcnt(0)" ::: "memory");
    const int c = lane & 7;
#pragma unroll
    for (int j = 0; j < 4; ++j) { const int n = (lane >> 3) + 8 * j; const LAS float* s = scr + (8 * c) * 33 + n;
        u32x4 o; o.x = pk2(s[0 * 33], s[1 * 33]); o.y = pk2(s[2 * 33], s[3 * 33]); o.z = pk2(s[4 * 33], s[5 * 33]); o.w = pk2(s[6 * 33], s[7 * 33]);
        *(u32x4*)(WT + (size_t)(r0 + n) * K + k0 + 8 * c) = o; }
    asm volatile("s_waitcnt lgkmcnt(0)" ::: "memory");
}
constexpr int WI_IN = (D / 64) * (INW / 32), WI_OUT = (D / 64) * (D / 32), WI_GU = (D / 64) * (2 * DFF / 32), WI_DN = (DFF / 64) * (D / 32), WI_LAYER = WI_IN + WI_OUT + WI_GU + WI_DN;
__device__ __forceinline__ void wconv_item(int it, const float* w_in, const float* w_out, const float* w_gu, const float* w_dn, unsigned char* ws, LAS float* scr, int lane) {
    const int l = it / WI_LAYER; int r = it % WI_LAYER;
    if (r < WI_IN) { transpose_item(w_in + (size_t)l * D * INW, D, INW, (bf16_t*)(ws + WS_WIN) + (size_t)l * INW * D, 0, scr, r, lane); return; } r -= WI_IN;
    if (r < WI_OUT) { transpose_item(w_out + (size_t)l * D * D, D, D, (bf16_t*)(ws + WS_WOUT) + (size_t)l * D * D, 1, scr, r, lane); return; } r -= WI_OUT;
    if (r < WI_GU) { transpose_item(w_gu + (size_t)l * D * 2 * DFF, D, 2 * DFF, (bf16_t*)(ws + WS_WGU) + (size_t)l * 2 * DFF * D, 2, scr, r, lane); return; } r -= WI_GU;
    transpose_item(w_dn + (size_t)l * DFF * D, DFF, D, (bf16_t*)(ws + WS_WDN) + (size_t)l * D * DFF, 1, scr, r, lane);
}
__global__ void __launch_bounds__(256) k_wconv(const float* w_in, const float* w_out, const float* w_gu, const float* w_dn, unsigned char* ws) {
    __shared__ float scr_all[4 * 64 * 33];
    const int wave = threadIdx.x >> 6, lane = threadIdx.x & 63;
    LAS float* scr = (LAS float*)scr_all + wave * 64 * 33;
    for (int it = blockIdx.x * 4 + wave; it < DEPTH * WI_LAYER; it += gridDim.x * 4) wconv_item(it, w_in, w_out, w_gu, w_dn, ws, scr, lane);
}

__global__ void __launch_bounds__(256) k_mod(const float* c, const float* c_ctx, const float* ada_w, const float* ada_b, float* MOD) {
    __shared__ float sc[3][D];
    for (int i = threadIdx.x; i < 3 * D; i += 256) { const int cd = i / D, k = i % D; const float v = cd < 2 ? c[cd * D + k] : c_ctx[k]; sc[cd][k] = v / (1.0f + expf(-v)); }
    __syncthreads();
    const int gid = blockIdx.x * 256 + threadIdx.x; if (gid >= DEPTH * 6 * D) return;
    const int l = gid / (6 * D), n = gid % (6 * D);
    const float* w = ada_w + (size_t)l * D * 6 * D + n;
    float a0 = 0.f, a1 = 0.f, a2 = 0.f;
#pragma unroll 8
    for (int k = 0; k < D; ++k) { const float wv = w[(size_t)k * 6 * D]; a0 += sc[0][k] * wv; a1 += sc[1][k] * wv; a2 += sc[2][k] * wv; }
    const float bv = ada_b[l * 6 * D + n];
    MOD[(l * 3 + 0) * 6 * D + n] = a0 + bv; MOD[(l * 3 + 1) * 6 * D + n] = a1 + bv; MOD[(l * 3 + 2) * 6 * D + n] = a2 + bv;
}

__global__ void __launch_bounds__(256) k_filt_h2(const float* w1, const float* b1, const float* w2, const float* b2, const float* freq, float* H2) {
    __shared__ float z[4][36]; __shared__ float h1[4][64];
    const int l = blockIdx.x / (FPOS / 4), p0 = (blockIdx.x % (FPOS / 4)) * 4, pl = threadIdx.x >> 6, j = threadIdx.x & 63, p = p0 + pl;
    const float t = p < SEQ ? (float)p / (float)SEQ : (float)(p - SEQ) / (float)CTXL;
    if (j < 33) { float v; if (j == 0) v = t; else { const int bnd = j <= 16 ? j : j - 16; float s, c; sincospif(2.0f * t * (float)bnd, &s, &c); v = j <= 16 ? c : s; } z[pl][j] = v; }
    __syncthreads();
    const float* W1 = w1 + l * 33 * 64; float a = b1[l * 64 + j];
#pragma unroll
    for (int i = 0; i < 33; ++i) a += z[pl][i] * W1[i * 64 + j];
    h1[pl][j] = sinf(freq[(l * 2 + 0) * 64 + j] * a);
    __syncthreads();
    const float* W2 = w2 + l * 64 * 64; float a2 = b2[l * 64 + j];
#pragma unroll
    for (int i = 0; i < 64; ++i) a2 += h1[pl][i] * W2[i * 64 + j];
    H2[((size_t)l * FPOS + p) * 64 + j] = sinf(freq[(l * 2 + 1) * 64 + j] * a2);
}
__global__ void __launch_bounds__(256) k_filt_k(const float* H2l, const float* w3l, float* KF, float* KFC) {
    __shared__ float hs[64][65]; __shared__ float wsm[64][65];
    int bx = blockIdx.x; const bool isctx = bx >= (SEQ / 64) * 16; if (isctx) bx -= (SEQ / 64) * 16;
    const int L = isctx ? CTXL : SEQ; const int pt = bx / 16, ct = bx % 16, p0 = pt * 64, c0 = ct * 64;
    const float* Hs = H2l + (size_t)(isctx ? SEQ : 0) * 64;
    for (int i = threadIdx.x; i < 64 * 64; i += 256) { const int r = i >> 6, cc = i & 63; hs[r][cc] = Hs[(size_t)(p0 + r) * 64 + cc]; wsm[r][cc] = w3l[r * 1024 + c0 + cc]; }
    __syncthreads();
    const int tx = threadIdx.x & 15, ty = threadIdx.x >> 4;
    float acc[4][4];
#pragma unroll
    for (int a = 0; a < 4; ++a)
#pragma unroll
        for (int b = 0; b < 4; ++b) acc[a][b] = 0.f;
    for (int j = 0; j < 64; ++j) {
        float hv[4], wv[4];
#pragma unroll
        for (int a = 0; a < 4; ++a) { hv[a] = hs[4 * tx + a][j]; wv[a] = wsm[j][4 * ty + a]; }
#pragma unroll
        for (int a = 0; a < 4; ++a)
#pragma unroll
            for (int b = 0; b < 4; ++b) acc[a][b] += hv[a] * wv[b];
    }
    float* out = isctx ? KFC : KF;
#pragma unroll
    for (int b = 0; b < 4; ++b) { const int col = c0 + 4 * ty + b, ch = col & 255;
        const float d0 = 15.350567286626973f, d1 = 3.0701134573253946f; const float delta = d0 + (d1 - d0) * ((float)ch / 255.0f);
        f32x4 o;
#pragma unroll
        for (int a = 0; a < 4; ++a) { const float t = (float)(p0 + 4 * tx + a) / (float)L; o[a] = acc[a][b] * expf(-t * delta); }
        *(f32x4*)(out + (size_t)col * L + p0 + 4 * tx) = o; }
}
__global__ void __launch_bounds__(256) k_knorm(const float* KF, float* KN) {
    __shared__ float red[4];
    const int oc = blockIdx.x, order = oc >> 8, c = oc & 255;
    const float* kf = KF + (size_t)((order * 2 + 0) * 256 + c) * SEQ; const float* kb = KF + (size_t)((order * 2 + 1) * 256 + c) * SEQ;
    float s = 0.f;
    for (int p = threadIdx.x; p < SEQ; p += 256) s += fabsf(kf[p]) + (p >= 1 ? fabsf(kb[p]) : 0.f);
    s = wave_sum(s); if ((threadIdx.x & 63) == 0) red[threadIdx.x >> 6] = s;
    __syncthreads();
    if (threadIdx.x == 0) KN[oc] = 1.0f / (red[0] + red[1] + red[2] + red[3]);
}

__global__ void __launch_bounds__(256) k_rownorm0(const float* x, const float* ctx, const float* g, const float* MOD0, bf16_t* H, float* XC) {
    const int lane = threadIdx.x & 63, row = blockIdx.x * 4 + (threadIdx.x >> 6); if (row >= MT) return;
    const bool isctx = row >= NLAT; const int cond = isctx ? 2 : row / SEQ;
    const float* xr = isctx ? ctx + (size_t)(row - NLAT) * D : x + (size_t)row * D;
    const float* sh = MOD0 + (size_t)cond * 6 * D; const float* sc = sh + D;
    f32x4 v[4]; float ss = 0.f;
#pragma unroll
    for (int j = 0; j < 4; ++j) { v[j] = *(const f32x4*)(xr + 4 * lane + 256 * j); ss += v[j][0] * v[j][0] + v[j][1] * v[j][1] + v[j][2] * v[j][2] + v[j][3] * v[j][3]; }
    const float rinv = 1.0f / sqrtf(wave_sum(ss) * (1.0f / D) + 1e-6f);
#pragma unroll
    for (int j = 0; j < 4; ++j) { const int col = 4 * lane + 256 * j; const f32x4 gv = *(const f32x4*)(g + col), scv = *(const f32x4*)(sc + col), shv = *(const f32x4*)(sh + col);
        if (isctx) *(f32x4*)(XC + (size_t)(row - NLAT) * D + col) = v[j];
        float o[4];
#pragma unroll
        for (int e = 0; e < 4; ++e) o[e] = v[j][e] * rinv * gv[e] * (1.0f + scv[e]) + shv[e];
        u32x2 w; w.x = pk2(o[0], o[1]); w.y = pk2(o[2], o[3]); *(u32x2*)(H + (size_t)row * D + col) = w; }
}
__global__ void __launch_bounds__(256) k_rowpass(const bf16_t* Y, const float* xin_lat, const float* xin_ctx, float* xout_lat, float* xout_ctx, const float* g_post, const float* modp, int gate_idx,
                                                 const float* g_next, const float* modn, int nidx, bf16_t* H, int nrows) {
    const int lane = threadIdx.x & 63, row = blockIdx.x * 4 + (threadIdx.x >> 6); if (row >= nrows) return;
    const bool isctx = row >= NLAT; const int cond = isctx ? 2 : row / SEQ;
    const float* xi = isctx ? xin_ctx + (size_t)(row - NLAT) * D : xin_lat + (size_t)row * D;
    float* xo = isctx ? xout_ctx + (size_t)(row - NLAT) * D : xout_lat + (size_t)row * D;
    const float* gate = modp + (size_t)cond * 6 * D + gate_idx * D;
    float y[4][4]; float ss = 0.f;
#pragma unroll
    for (int j = 0; j < 4; ++j) { const u32x2 w = *(const u32x2*)(Y + (size_t)row * D + 4 * lane + 256 * j);
        y[j][0] = bf2f(w.x & 0xffffu); y[j][1] = bf2f(w.x >> 16); y[j][2] = bf2f(w.y & 0xffffu); y[j][3] = bf2f(w.y >> 16);
        ss += y[j][0] * y[j][0] + y[j][1] * y[j][1] + y[j][2] * y[j][2] + y[j][3] * y[j][3]; }
    const float rinv = 1.0f / sqrtf(wave_sum(ss) * (1.0f / D) + 1e-6f);
    f32x4 xn[4]; float s2 = 0.f;
#pragma unroll
    for (int j = 0; j < 4; ++j) { const int col = 4 * lane + 256 * j; const f32x4 xv = *(const f32x4*)(xi + col), gp = *(const f32x4*)(g_post + col), gt = *(const f32x4*)(gate + col);
#pragma unroll
        for (int e = 0; e < 4; ++e) { xn[j][e] = xv[e] + gt[e] * (y[j][e] * rinv * gp[e]); s2 += xn[j][e] * xn[j][e]; }
        *(f32x4*)(xo + col) = xn[j]; }
    if (g_next) {
        const float r2 = 1.0f / sqrtf(wave_sum(s2) * (1.0f / D) + 1e-6f);
        const float* sh = modn + (size_t)cond * 6 * D + nidx * D; const float* sc = sh + D;
#pragma unroll
        for (int j = 0; j < 4; ++j) { const int col = 4 * lane + 256 * j; const f32x4 gv = *(const f32x4*)(g_next + col), scv = *(const f32x4*)(sc + col), shv = *(const f32x4*)(sh + col);
            float o[4];
#pragma unroll
            for (int e = 0; e < 4; ++e) o[e] = xn[j][e] * r2 * gv[e] * (1.0f + scv[e]) + shv[e];
            u32x2 w; w.x = pk2(o[0], o[1]); w.y = pk2(o[2], o[3]); *(u32x2*)(H + (size_t)row * D + col) = w; }
    }
}

__global__ void __launch_bounds__(512, 2) k_gemm(pg8::GPhase ph) {
    extern __shared__ __attribute__((aligned(16))) unsigned char lds[];
    pg8::Sched S; S.ph = ph; S.G = gridDim.x; S.c = blockIdx.x;
    pg8::Epi E;
    pg8::gemm_phase((LAS unsigned char*)lds, S, E);
}
__device__ __forceinline__ float conv3_at(const bf16_t* rowp, int s, int Lseq, float w0, float w1, float w2, float bias) {
    float a = bias + w1 * bf2f(rowp[s]);
    if (s > 0) a += w0 * bf2f(rowp[s - 1]);
    if (s + 1 < Lseq) a += w2 * bf2f(rowp[s + 1]);
    return a;
}
template <int ORDER>
__global__ void __launch_bounds__(512) k_hy_naive(const bf16_t* PTV, const float* KF, const float* KN, const float* cw, const float* cb, const float* hbias, float* Z1, bf16_t* YMIX) {
    __shared__ float us[2][2048]; __shared__ float kw[4096];
    const int c = blockIdx.x & 255, tt = blockIdx.x >> 8, T0 = tt * 2048, tid = threadIdx.x;
    const float* kf = KF + (size_t)((ORDER * 2 + 0) * 256 + c) * SEQ; const float* kb = KF + (size_t)((ORDER * 2 + 1) * 256 + c) * SEQ;
    const float w0 = cw[0 * 768 + c], w1 = cw[1 * 768 + c], w2 = cw[2 * 768 + c], wb = cb[c];
    float acc[2][4];
#pragma unroll
    for (int b = 0; b < 2; ++b)
#pragma unroll
        for (int i = 0; i < 4; ++i) acc[b][i] = 0.f;
    for (int st = 0; st < 8; ++st) {
        const int S0 = st * 2048;
        for (int i = tid; i < 4096; i += 512) { const int b = i >> 11, s = S0 + (i & 2047);
            us[b][i & 2047] = ORDER == 0 ? conv3_at(PTV + (size_t)c * MT + (size_t)b * SEQ, s, SEQ, w0, w1, w2, wb) : Z1[((size_t)c * 2 + b) * SEQ + s]; }
        const int dmin = T0 - S0 - 2047;
        for (int i = tid; i < 4095; i += 512) { const int d = dmin + i; kw[i] = d >= 0 ? kf[d] : kb[-d]; }
        __syncthreads();
        for (int s = 0; s < 2048; ++s) {
            const float u0 = us[0][s], u1 = us[1][s];
#pragma unroll
            for (int i = 0; i < 4; ++i) { const float kv = kw[tid + 512 * i - s + 2047]; acc[0][i] += kv * u0; acc[1][i] += kv * u1; }
        }
        __syncthreads();
    }
    const float invn = KN[ORDER * 256 + c], hb = hbias[ORDER * 256 + c];
    const int grow = (ORDER == 0 ? 256 : 512) + c;
    const float g0 = cw[0 * 768 + grow], g1 = cw[1 * 768 + grow], g2 = cw[2 * 768 + grow], gb = cb[grow];
#pragma unroll
    for (int b = 0; b < 2; ++b)
#pragma unroll
        for (int i = 0; i < 4; ++i) { const int t = T0 + tid + 512 * i;
            const float in_t = ORDER == 0 ? conv3_at(PTV + (size_t)c * MT + (size_t)b * SEQ, t, SEQ, w0, w1, w2, wb) : Z1[((size_t)c * 2 + b) * SEQ + t];
            const float gate = conv3_at(PTV + (size_t)grow * MT + (size_t)b * SEQ, t, SEQ, g0, g1, g2, gb);
            const float res = gate * (acc[b][i] * invn + hb * in_t);
            if (ORDER == 0) Z1[((size_t)c * 2 + b) * SEQ + t] = res; else YMIX[((size_t)b * SEQ + t) * D + c] = (bf16_t)f2bf(res); }
}
__global__ void __launch_bounds__(512) k_hy_ctx(const bf16_t* PTV, const float* KFC, const float* cw, const float* cb, const float* hbias, bf16_t* YMIX) {
    __shared__ float zin[2][256]; __shared__ float kc[512]; __shared__ float red[8];
    const int c = blockIdx.x, tid = threadIdx.x, b = tid >> 8, t = tid & 255, lane = tid & 63, wave = tid >> 6;
    const bf16_t* base = PTV + NLAT + b * CTXL;
    float zcur = conv3_at(base + (size_t)c * MT, t, CTXL, cw[c], cw[768 + c], cw[1536 + c], cb[c]);
    for (int order = 0; order < 2; ++order) {
        __syncthreads();
        zin[b][t] = zcur;
        const float* kf = KFC + (size_t)((order * 2 + 0) * 256 + c) * CTXL; const float* kb = KFC + (size_t)((order * 2 + 1) * 256 + c) * CTXL;
        float kv = 0.f; if (tid >= 1) { const int d = tid - 256; kv = d >= 0 ? kf[d] : kb[-d]; } kc[tid] = kv;
        float s = wave_sum(fabsf(kv)); if (lane == 0) red[wave] = s;
        __syncthreads();
        float tot = 0.f;
#pragma unroll
        for (int i = 0; i < 8; ++i) tot += red[i];
        float acc = 0.f;
        for (int s2 = 0; s2 < 256; ++s2) acc += kc[t - s2 + 256] * zin[b][s2];
        const int grow = (order == 0 ? 256 : 512) + c;
        const float gate = conv3_at(base + (size_t)grow * MT, t, CTXL, cw[grow], cw[768 + grow], cw[1536 + grow], cb[grow]);
        zcur = gate * (acc / tot + hbias[order * 256 + c] * zcur);
    }
    YMIX[(size_t)(NLAT + b * CTXL + t) * D + c] = (bf16_t)f2bf(zcur);
}

__global__ void __launch_bounds__(256) k_na_naive(const bf16_t* QKL, const bf16_t* PTV, const float* rpb, bf16_t* YMIX, int nrows) {
    __shared__ float qs[4][64];
    const int wave = threadIdx.x >> 6, lane = threadIdx.x & 63;
    const int item = blockIdx.x * 4 + wave; const int row = item >> 3, h = item & 7;
    if (row >= nrows) return;
    const bool isctx = row >= NLAT; const int b = isctx ? (row - NLAT) / CTXL : row / SEQ;
    qs[wave][lane] = bf2f(QKL[(size_t)row * NQKL + h * 64 + lane]) * 0.125f;
    asm volatile("s_waitcnt lgkmcnt(0)" ::: "memory");
    const bf16_t* VT = PTV + (size_t)768 * MT;
    int tok[6]; float sc[6];
    int r = 0, cq = 0, rs = 0, start = 0;
    if (!isctx) { const int t = row % SEQ; r = t / GRIDW; cq = t % GRIDW; rs = min(max(r - 4, 0), GROWS - 8); start = min(max(cq - 8, 0), GRIDW - 16); }
#pragma unroll
    for (int g = 0; g < 6; ++g) {
        float bias = 0.f; bool valid = true;
        if (g < 2) { const int kr = (lane >> 4) + 4 * g, kcol = start + (lane & 15); tok[g] = b * SEQ + (rs + kr) * GRIDW + kcol; valid = !isctx;
            if (valid) bias = rpb[(h * 15 + (rs + kr - r + 7)) * 31 + (kcol - cq + 15)]; else tok[g] = 0; }
        else tok[g] = NLAT + b * CTXL + (g - 2) * 64 + lane;
        const bf16_t* kp = QKL + (size_t)tok[g] * NQKL + 512 + h * 64;
        float dot = 0.f;
#pragma unroll
        for (int d8 = 0; d8 < 8; ++d8) { const u32x4 w = *(const u32x4*)(kp + 8 * d8);
            dot += qs[wave][8 * d8 + 0] * bf2f(w.x & 0xffffu) + qs[wave][8 * d8 + 1] * bf2f(w.x >> 16) + qs[wave][8 * d8 + 2] * bf2f(w.y & 0xffffu) + qs[wave][8 * d8 + 3] * bf2f(w.y >> 16)
                 + qs[wave][8 * d8 + 4] * bf2f(w.z & 0xffffu) + qs[wave][8 * d8 + 5] * bf2f(w.z >> 16) + qs[wave][8 * d8 + 6] * bf2f(w.w & 0xffffu) + qs[wave][8 * d8 + 7] * bf2f(w.w >> 16); }
        sc[g] = valid ? dot + bias : -1e30f;
    }
    float m = sc[0];
#pragma unroll
    for (int g = 1; g < 6; ++g) m = fmaxf(m, sc[g]);
    m = wave_max(m);
    float sum = 0.f;
#pragma unroll
    for (int g = 0; g < 6; ++g) { sc[g] = expf(sc[g] - m); sum += sc[g]; }
    sum = wave_sum(sum);
    float o = 0.f;
    for (int d = 0; d < 64; ++d) {
        const bf16_t* vp = VT + (size_t)(h * 64 + d) * MT;
        float part = 0.f;
#pragma unroll
        for (int g = 0; g < 6; ++g) part += sc[g] * bf2f(vp[tok[g]]);
        part = wave_sum(part);
        if (lane == d) o = part;
    }
    YMIX[(size_t)row * D + 256 + h * 64 + lane] = (bf16_t)f2bf(o / sum);
}

__global__ void __launch_bounds__(64) k_lru_naive(const bf16_t* QKL, const float* cw, const float* cb, const float* wa, const float* ba, const float* wi, const float* bi, const float* lam, float* HS) {
    __shared__ float us[64];
    const int lane = threadIdx.x, dir = blockIdx.x & 1, blk = (blockIdx.x >> 1) & 3, b = blockIdx.x >> 3, ch = blk * 64 + lane;
    float war[64], wir[64];
#pragma unroll
    for (int j = 0; j < 64; ++j) { war[j] = wa[((dir * 4 + blk) * 64 + j) * 64 + lane]; wir[j] = wi[((dir * 4 + blk) * 64 + j) * 64 + lane]; }
    const float bav = ba[dir * 256 + ch], biv = bi[dir * 256 + ch];
    const float lm = lam[dir * 256 + ch]; const float sp = log1pf(expf(-lm));
    const float c0 = cw[0 * 256 + ch], c1 = cw[1 * 256 + ch], c2 = cw[2 * 256 + ch], c3 = cw[3 * 256 + ch], cbv = cb[ch];
    float h = 0.f;
    for (int seg = 0; seg < 2; ++seg) {
        const int Ls = seg == 0 ? CTXL : SEQ; const int row0 = seg == 0 ? NLAT + b * CTXL : b * SEQ;
        for (int i = 0; i < Ls; ++i) {
            const int t = dir == 0 ? i : Ls - 1 - i;
            const bf16_t* xp = QKL + (size_t)(row0 + t) * NQKL + 1024 + ch;
            float u = cbv + c2 * bf2f(xp[0]);
            if (t >= 2) u += c0 * bf2f(xp[-2 * NQKL]);
            if (t >= 1) u += c1 * bf2f(xp[-1 * NQKL]);
            if (t + 1 < Ls) u += c3 * bf2f(xp[NQKL]);
            __syncthreads();
            us[lane] = u;
            __syncthreads();
            float ra = bav, ri = biv;
#pragma unroll
            for (int j = 0; j < 64; ++j) { const float uj = us[j]; ra += uj * war[j]; ri += uj * wir[j]; }
            const float rg = sigmoid_f(ra), ig = sigmoid_f(ri);
            const float log_a = -8.0f * rg * sp; const float a = expf(log_a); const float bb = sqrtf(-expm1f(2.0f * log_a)) * (ig * u);
            h = a * h + bb;
            HS[((size_t)dir * MT + row0 + t) * LRW + ch] = h;
        }
    }
}
__global__ void __launch_bounds__(256) k_lru_comb(const float* HS, const bf16_t* QKL, bf16_t* YMIX, int nrows) {
    const int row = blockIdx.x, ch = threadIdx.x; if (row >= nrows) return;
    const float hsum = HS[(size_t)row * LRW + ch] + HS[((size_t)MT + row) * LRW + ch];
    const float xg = bf2f(QKL[(size_t)row * NQKL + 1280 + ch]);
    YMIX[(size_t)row * D + 768 + ch] = (bf16_t)f2bf(hsum * gelu_tanh(xg));
}
static __device__ constexpr float C32T[16] = {1.000000000e+00f, 9.807852804e-01f, 9.238795325e-01f, 8.314696123e-01f, 7.071067812e-01f, 5.555702330e-01f, 3.826834324e-01f, 1.950903220e-01f, 0.0f, -1.950903220e-01f, -3.826834324e-01f, -5.555702330e-01f, -7.071067812e-01f, -8.314696123e-01f, -9.238795325e-01f, -9.807852804e-01f};
static __device__ constexpr float S32T[16] = {0.000000000e+00f, 1.950903220e-01f, 3.826834324e-01f, 5.555702330e-01f, 7.071067812e-01f, 8.314696123e-01f, 9.238795325e-01f, 9.807852804e-01f, 1.000000000e+00f, 9.807852804e-01f, 9.238795325e-01f, 8.314696123e-01f, 7.071067812e-01f, 5.555702330e-01f, 3.826834324e-01f, 1.950903220e-01f};
static __device__ constexpr float C64T[32] = {1.000000000e+00f, 9.951847267e-01f, 9.807852804e-01f, 9.569403357e-01f, 9.238795325e-01f, 8.819212643e-01f, 8.314696123e-01f, 7.730104534e-01f, 7.071067812e-01f, 6.343932842e-01f, 5.555702330e-01f, 4.713967368e-01f, 3.826834324e-01f, 2.902846773e-01f, 1.950903220e-01f, 9.801714033e-02f, 0.0f, -9.801714033e-02f, -1.950903220e-01f, -2.902846773e-01f, -3.826834324e-01f, -4.713967368e-01f, -5.555702330e-01f, -6.343932842e-01f, -7.071067812e-01f, -7.730104534e-01f, -8.314696123e-01f, -8.819212643e-01f, -9.238795325e-01f, -9.569403357e-01f, -9.807852804e-01f, -9.951847267e-01f};
static __device__ constexpr float S64T[32] = {0.000000000e+00f, 9.801714033e-02f, 1.950903220e-01f, 2.902846773e-01f, 3.826834324e-01f, 4.713967368e-01f, 5.555702330e-01f, 6.343932842e-01f, 7.071067812e-01f, 7.730104534e-01f, 8.314696123e-01f, 8.819212643e-01f, 9.238795325e-01f, 9.569403357e-01f, 9.807852804e-01f, 9.951847267e-01f, 1.000000000e+00f, 9.951847267e-01f, 9.807852804e-01f, 9.569403357e-01f, 9.238795325e-01f, 8.819212643e-01f, 8.314696123e-01f, 7.730104534e-01f, 7.071067812e-01f, 6.343932842e-01f, 5.555702330e-01f, 4.713967368e-01f, 3.826834324e-01f, 2.902846773e-01f, 1.950903220e-01f, 9.801714033e-02f};

namespace fft {
constexpr int L = SEQ, N2 = 2 * SEQ;
constexpr int XSLOTS = 17904;
constexpr int LDS_X_BYTES = XSLOTS * 8;
constexpr int LDS_RED = LDS_X_BYTES;
typedef LAS f32x2* xptr;
__device__ __forceinline__ f32x2 cmul(f32x2 a, f32x2 b) { return (f32x2){a.x * b.x - a.y * b.y, a.x * b.y + a.y * b.x}; }
__device__ __forceinline__ f32x2 cmulc(f32x2 a, f32x2 b) { return (f32x2){a.x * b.x + a.y * b.y, a.y * b.x - a.x * b.y}; }
__device__ __forceinline__ f32x2 expi(float x) { float s, c; sincospif(x, &s, &c); return (f32x2){c, s}; }
constexpr __host__ __device__ int bitrev(int j, int R) { int r = 0; for (int b = 1; b < R; b <<= 1) { r = (r << 1) | (j & 1); j >>= 1; } return r; }

template <int R, int S, bool INV> struct Stage {
    static __device__ __forceinline__ void run(f32x2 (&a)[R]) {
#pragma unroll
        for (int base = 0; base < R; base += 2 * S)
#pragma unroll
            for (int k = 0; k < S; ++k) {
                const int i0 = base + k, i1 = i0 + S, ti = k * (16 / S);
                const f32x2 u = a[i0], v = a[i1]; a[i0] = u + v; const f32x2 d = u - v;
                if (ti == 0) a[i1] = d;
                else if (ti == 8) a[i1] = INV ? (f32x2){-d.y, d.x} : (f32x2){d.y, -d.x};
                else { const float c = C32T[ti], s = S32T[ti]; a[i1] = INV ? (f32x2){d.x * c - d.y * s, d.x * s + d.y * c} : (f32x2){d.x * c + d.y * s, d.y * c - d.x * s}; }
            }
        if constexpr (S > 1) Stage<R, S / 2, INV>::run(a);
    }
};
template <int R, bool INV> __device__ __forceinline__ void dft(f32x2 (&a)[R]) {
    Stage<R, R / 2, INV>::run(a);
    f32x2 t[R];
#pragma unroll
    for (int j = 0; j < R; ++j) t[j] = a[bitrev(j, R)];
#pragma unroll
    for (int j = 0; j < R; ++j) a[j] = t[j];
}
template <int R, bool CONJ> __device__ __forceinline__ void twiddle(f32x2 (&a)[R], f32x2 w) {
    f32x2 tw[R]; tw[0] = (f32x2){1.f, 0.f}; tw[1] = w;
#pragma unroll
    for (int j = 2; j < R; ++j) tw[j] = cmul(tw[j >> 1], tw[j - (j >> 1)]);
#pragma unroll
    for (int j = 1; j < R; ++j) a[j] = CONJ ? cmulc(a[j], tw[j]) : cmul(a[j], tw[j]);
}
__device__ __forceinline__ void bar() { __syncthreads(); }
__device__ __forceinline__ int opaque(int v) { asm volatile("" : "+v"(v)); return v; }

__device__ __forceinline__ void fwd12(xptr X, int tid) {
    f32x2 a[32];
    { const int p0 = tid + (tid >> 4);
#pragma unroll
      for (int q = 0; q < 32; ++q) a[q] = X[p0 + 560 * q];
      dft<32, false>(a); twiddle<32, false>(a, expi(-(float)opaque(tid) * (1.0f / 8192.0f)));
#pragma unroll
      for (int q = 0; q < 32; ++q) X[p0 + 560 * q] = a[q]; }
    bar();
    { const int blk = tid >> 4, np = tid & 15, p0 = 560 * blk + np;
#pragma unroll
      for (int q = 0; q < 32; ++q) a[q] = X[p0 + 17 * q];
      dft<32, false>(a); twiddle<32, false>(a, expi(-(float)opaque(np) * (1.0f / 256.0f)));
#pragma unroll
      for (int q = 0; q < 32; ++q) X[p0 + 17 * q] = a[q]; }
    bar();
}
__device__ __forceinline__ void inv21(xptr X, int tid, f32x2 (&a)[32]) {
    { const int blk = tid >> 4, np = tid & 15, p0 = 560 * blk + np;
#pragma unroll
      for (int q = 0; q < 32; ++q) a[q] = X[p0 + 17 * q];
      twiddle<32, true>(a, expi(-(float)opaque(np) * (1.0f / 256.0f))); dft<32, true>(a);
#pragma unroll
      for (int q = 0; q < 32; ++q) X[p0 + 17 * q] = a[q]; }
    bar();
    { const int p0 = tid + (tid >> 4);
#pragma unroll
      for (int q = 0; q < 32; ++q) a[q] = X[p0 + 560 * q];
      twiddle<32, true>(a, expi(-(float)opaque(tid) * (1.0f / 8192.0f))); dft<32, true>(a); }
}
template <int MODE> __device__ __forceinline__ void pass3(xptr X, int tid, f32x2* G, float scale) {
#pragma unroll 1
    for (int gi = 0; gi < 2; ++gi) {
        const int g = tid + 512 * gi, p0 = 17 * g + 16 * (g >> 5);
        f32x2 a[16];
#pragma unroll
        for (int q = 0; q < 16; ++q) a[q] = X[p0 + q];
        dft<16, false>(a);
        if (MODE == 0) {
#pragma unroll
            for (int j = 0; j < 16; j += 2) { f32x4 o = (f32x4){a[j].x * scale, a[j].y * scale, a[j + 1].x * scale, a[j + 1].y * scale}; *(f32x4*)(G + 16 * g + j) = o; }
        } else {
#pragma unroll
            for (int j = 0; j < 16; j += 2) { const f32x4 kv = *(const f32x4*)(G + 16 * g + j); a[j] = cmul(a[j], (f32x2){kv.x, kv.y}); a[j + 1] = cmul(a[j + 1], (f32x2){kv.z, kv.w}); }
            dft<16, true>(a);
#pragma unroll
            for (int q = 0; q < 16; ++q) X[p0 + q] = a[q];
        }
    }
    if (MODE == 1) bar();
}
__device__ __forceinline__ f32x2 wN(f32x2 base, int q) { return cmul(base, (f32x2){C64T[q], -S64T[q]}); }

__device__ __forceinline__ void filter_unit(LAS unsigned char* lds, const float* kf, const float* kb, f32x2* KFo) {
    xptr X = (xptr)lds; LAS float* red = (LAS float*)(lds + LDS_RED);
    const int tid = threadIdx.x, p0 = tid + (tid >> 4);
    const f32x2 base = expi(-(float)tid * (1.0f / 16384.0f));
    float nrm = 0.f;
#pragma unroll 4
    for (int q = 0; q < 32; ++q) { const int n = tid + 512 * q; const float f = kf[n], b = n >= 1 ? kb[L - n] : 0.f; nrm += fabsf(f) + fabsf(b); X[p0 + 560 * q] = (f32x2){f + b, 0.f}; }
    nrm = wave_sum(nrm); if ((tid & 63) == 0) red[tid >> 6] = nrm;
    bar();
    float tot = 0.f;
#pragma unroll
    for (int i = 0; i < 8; ++i) tot += red[i];
    const float scale = 1.0f / (tot * (float)N2);
    fwd12(X, tid); pass3<0>(X, tid, KFo, scale);
    bar();
    asm volatile("" ::: "memory");
#pragma unroll 4
    for (int q = 0; q < 32; ++q) { const int n = tid + 512 * q; const float f = kf[n], b = n >= 1 ? kb[L - n] : 0.f; const f32x2 w = wN(base, q); const float d = f - b; X[p0 + 560 * q] = (f32x2){d * w.x, d * w.y}; asm volatile("" ::: "memory"); }
    bar();
    fwd12(X, tid); pass3<0>(X, tid, KFo + L, scale);
    bar();
}

__device__ __forceinline__ f32x2 conv3_pair(const bf16_t* row, int n, float w0, float w1, float w2, float wb) {
    const int nm = n > 0 ? n - 1 : 0, np = n + 1 < SEQ ? n + 1 : SEQ - 1; const float wm = n > 0 ? w0 : 0.f, wp = n + 1 < SEQ ? w2 : 0.f;
    const float a0 = wb + w1 * bf2f(row[n]) + wm * bf2f(row[nm]) + wp * bf2f(row[np]);
    const float a1 = wb + w1 * bf2f(row[SEQ + n]) + wm * bf2f(row[SEQ + nm]) + wp * bf2f(row[SEQ + np]);
    return (f32x2){a0, a1};
}
__device__ __forceinline__ void hyena_unit(LAS unsigned char* lds, int c, const bf16_t* PTV, const f32x2* KFc, size_t ostride, const float* cw, const float* cb, const float* hbias,
                                           f32x2* Zs, f32x2* Rs, bf16_t* YMIX) {
    xptr X = (xptr)lds;
    const int tid = threadIdx.x, p0 = tid + (tid >> 4);
    f32x2 a[32];
    { const int t0 = opaque(tid); const bf16_t* row = PTV + (size_t)c * MT; const float w0 = cw[c], w1 = cw[768 + c], w2 = cw[1536 + c], wb = cb[c];
#pragma unroll
      for (int q0 = 0; q0 < 32; q0 += 4) {
#pragma unroll
          for (int q = q0; q < q0 + 4; ++q) a[q] = conv3_pair(row, t0 + 512 * q, w0, w1, w2, wb);
          asm volatile("" ::: "memory"); } }
#pragma unroll 1
    for (int order = 0; order < 2; ++order) {
        const f32x2* Ke = KFc + (size_t)order * ostride; const f32x2* Ko = Ke + L;
        { const int t1 = opaque(tid);
#pragma unroll
          for (int q = 0; q < 32; ++q) { X[p0 + 560 * q] = a[q]; Zs[t1 + 512 * q] = a[q]; } }
        bar();
        fwd12(X, tid); pass3<1>(X, tid, const_cast<f32x2*>(Ke), 1.f); inv21(X, tid, a);
        { const int t2 = opaque(tid);
#pragma unroll
          for (int q = 0; q < 32; ++q) Rs[t2 + 512 * q] = a[q]; }
        asm volatile("" ::: "memory");
        const int t3 = opaque(tid); const f32x2 base1 = expi(-(float)t3 * (1.0f / 16384.0f));
#pragma unroll
        for (int q0 = 0; q0 < 32; q0 += 8) {
#pragma unroll
            for (int q = q0; q < q0 + 8; ++q) X[p0 + 560 * q] = cmul(Zs[t3 + 512 * q], wN(base1, q));
            asm volatile("" ::: "memory"); }
        bar();
        fwd12(X, tid); pass3<1>(X, tid, const_cast<f32x2*>(Ko), 1.f); inv21(X, tid, a);
        const int grow = (order == 0 ? 256 : 512) + c; const bf16_t* rowg = PTV + (size_t)grow * MT;
        const float g0 = cw[grow], g1 = cw[768 + grow], g2 = cw[1536 + grow], gb = cb[grow], hb = hbias[order * 256 + c];
        asm volatile("" ::: "memory");
        const int t4 = opaque(tid); const f32x2 base2 = expi(-(float)t4 * (1.0f / 16384.0f));
#pragma unroll
        for (int q0 = 0; q0 < 32; q0 += 4) {
#pragma unroll
            for (int q = q0; q < q0 + 4; ++q) { const int n = t4 + 512 * q;
                const f32x2 y = Rs[n] + cmulc(a[q], wN(base2, q)); const f32x2 zq = Zs[n]; const f32x2 gt = conv3_pair(rowg, n, g0, g1, g2, gb);
                a[q] = (f32x2){gt.x * (y.x + hb * zq.x), gt.y * (y.y + hb * zq.y)}; }
            asm volatile("" ::: "memory"); }
        bar();
    }
    { bf16_t* yp = YMIX + (size_t)tid * D + c;
#pragma unroll
      for (int q = 0; q < 32; ++q) { yp[0] = (bf16_t)f2bf(a[q].x); yp[(size_t)SEQ * D] = (bf16_t)f2bf(a[q].y); yp += (size_t)512 * D; asm volatile("" : "+v"(yp)); } }
}
}

constexpr int MK_LDS_BYTES = 147456;
static_assert(fft::LDS_RED + 64 <= MK_LDS_BYTES, "LDS map");
__global__ void __launch_bounds__(512, 2) k_filt_fft(const float* KF, f32x2* KFS) {
    extern __shared__ __attribute__((aligned(16))) unsigned char lds[];
    for (int u = blockIdx.x; u < 512; u += gridDim.x) { const int order = u >> 8, c = u & 255;
        fft::filter_unit((LAS unsigned char*)lds, KF + (size_t)((order * 2 + 0) * 256 + c) * SEQ, KF + (size_t)((order * 2 + 1) * 256 + c) * SEQ, KFS + ((size_t)order * 256 + c) * 2 * SEQ); }
}
__global__ void __launch_bounds__(512, 2) k_hy_fft(const bf16_t* PTV, const f32x2* KFS, const float* cw, const float* cb, const float* hbias, f32x2* scratch, bf16_t* YMIX) {
    extern __shared__ __attribute__((aligned(16))) unsigned char lds[];
    const int bx = blockIdx.x; f32x2* Zs = scratch + (size_t)bx * SEQ; f32x2* Rs = scratch + (size_t)(gridDim.x + bx) * SEQ;
    for (int u = bx; u < 256; u += gridDim.x) { const int c = (gridDim.x == 256) ? (u & 7) * 32 + (u >> 3) : u;
        fft::hyena_unit((LAS unsigned char*)lds, c, PTV, KFS + (size_t)c * 2 * SEQ, (size_t)256 * 2 * SEQ, cw, cb, hbias, Zs, Rs, YMIX); }
}
namespace lru {
constexpr int TC = 64, NCH = 260;
constexpr int XR_OFF = 0, XR_BYTES = (TC + 3) * 512;
constexpr int UA_OFF = XR_OFF + XR_BYTES, UA_STRIDE = 528;
constexpr int AB_OFF = UA_OFF + 16 * UA_STRIDE, AB_STRIDE = 260;
constexpr int H0_OFF = AB_OFF + 2 * 16 * AB_STRIDE * 4;
constexpr int LDS_END = H0_OFF + TC * 512;
static_assert(LDS_END <= 147456 && (UA_OFF % 16) == 0 && (AB_OFF % 16) == 0 && (H0_OFF % 16) == 0, "lru LDS map");
struct Params {
    const bf16_t* QKL; const bf16_t* LW;
    const float *cw, *cb, *ba, *bi, *lam;
    f32x2* AGG;
    bf16_t* YMIX;
};
__device__ __forceinline__ int chunk_row0(int b, int k) { return k < 4 ? NLAT + b * CTXL + 64 * k : b * SEQ + 64 * (k - 4); }

template <bool FINAL>
__device__ __forceinline__ void chunk_dir(LAS unsigned char* lds, const Params& P, int row0, int dir, float& h, float& pr) {
    const int tid = threadIdx.x, lane = tid & 63, wid = tid >> 6, n = wid >> 1, hf = wid & 1, l15 = lane & 15, kg = lane >> 4;
    const LAS bf16_t* XR = (const LAS bf16_t*)(lds + XR_OFF);
    LAS float* Aab = (LAS float*)(lds + AB_OFF); LAS float* Bab = Aab + 16 * AB_STRIDE;
    LAS bf16_t* H0 = (LAS bf16_t*)(lds + H0_OFF);
    bf16x8 Bf[2][2][2];
#pragma unroll
    for (int ty = 0; ty < 2; ++ty)
#pragma unroll
        for (int cc = 0; cc < 2; ++cc)
#pragma unroll
            for (int ks = 0; ks < 2; ++ks) Bf[ty][cc][ks] = *(const bf16x8*)(P.LW + ((((size_t)dir * 4 + n) * 2 + ty) * 64 + 32 * hf + 16 * cc + l15) * 64 + 32 * ks + 8 * kg);
    float ba[2], bi[2], sp[2], c0[2], c1[2], c2[2], c3[2], cbv[2];
#pragma unroll
    for (int cc = 0; cc < 2; ++cc) { const int ch = 64 * n + 32 * hf + 16 * cc + l15;
        ba[cc] = P.ba[dir * 256 + ch]; bi[cc] = P.bi[dir * 256 + ch]; sp[cc] = -8.0f * log1pf(expf(-P.lam[dir * 256 + ch]));
        c0[cc] = P.cw[ch]; c1[cc] = P.cw[256 + ch]; c2[cc] = P.cw[512 + ch]; c3[cc] = P.cw[768 + ch]; cbv[cc] = P.cb[ch]; }
    const int sch = tid & 255; const bool scanner = (tid >> 8) == dir;
    const float s0 = P.cw[sch], s1 = P.cw[256 + sch], s2 = P.cw[512 + sch], s3 = P.cw[768 + sch], sb = P.cb[sch];
#pragma unroll 1
    for (int s = 0; s < 4; ++s) {
        const int ss = dir == 0 ? s : 3 - s;
#pragma unroll
        for (int i = 0; i < 8; ++i) { const int tok = 2 * i + (tid >> 8), r = 16 * ss + tok;
            const float u = sb + s0 * bf2f(XR[(r + 0) * 256 + sch]) + s1 * bf2f(XR[(r + 1) * 256 + sch]) + s2 * bf2f(XR[(r + 2) * 256 + sch]) + s3 * bf2f(XR[(r + 3) * 256 + sch]);
            *(LAS bf16_t*)(lds + UA_OFF + tok * UA_STRIDE + sch * 2) = (bf16_t)f2bf(u); }
        __syncthreads();
        bf16x8 Af[2];
#pragma unroll
        for (int ks = 0; ks < 2; ++ks) Af[ks] = *(const LAS bf16x8*)(lds + UA_OFF + l15 * UA_STRIDE + (64 * n + 32 * ks + 8 * kg) * 2);
#pragma unroll
        for (int cc = 0; cc < 2; ++cc) {
            f32x4 ar = (f32x4){0.f, 0.f, 0.f, 0.f}, ai = ar;
            ar = __builtin_amdgcn_mfma_f32_16x16x32_bf16(Af[0], Bf[0][cc][0], ar, 0, 0, 0); ar = __builtin_amdgcn_mfma_f32_16x16x32_bf16(Af[1], Bf[0][cc][1], ar, 0, 0, 0);
            ai = __builtin_amdgcn_mfma_f32_16x16x32_bf16(Af[0], Bf[1][cc][0], ai, 0, 0, 0); ai = __builtin_amdgcn_mfma_f32_16x16x32_bf16(Af[1], Bf[1][cc][1], ai, 0, 0, 0);
            const int ch = 64 * n + 32 * hf + 16 * cc + l15;
#pragma unroll
            for (int rg = 0; rg < 4; ++rg) { const int tok = 4 * kg + rg, r = 16 * ss + tok;
                const float u = cbv[cc] + c0[cc] * bf2f(XR[(r + 0) * 256 + ch]) + c1[cc] * bf2f(XR[(r + 1) * 256 + ch]) + c2[cc] * bf2f(XR[(r + 2) * 256 + ch]) + c3[cc] * bf2f(XR[(r + 3) * 256 + ch]);
                const float rgt = sigmoid_f(ar[rg] + ba[cc]), igt = sigmoid_f(ai[rg] + bi[cc]);
                const float log_a = rgt * sp[cc]; const float a = expf(log_a);
                Aab[tok * AB_STRIDE + ch] = a; Bab[tok * AB_STRIDE + ch] = sqrtf(-expm1f(2.0f * log_a)) * (igt * u); }
        }
        __syncthreads();
        if (scanner) {
            if (FINAL && dir == 1) {
                const int rowb = row0 + 16 * ss;
#pragma unroll 4
                for (int j = 0; j < 16; ++j) { const int tok = 15 - j; h = Aab[tok * AB_STRIDE + sch] * h + Bab[tok * AB_STRIDE + sch];
                    const float xg = bf2f(P.QKL[(size_t)(rowb + tok) * NQKL + 1280 + sch]);
                    P.YMIX[(size_t)(rowb + tok) * D + 768 + sch] = (bf16_t)f2bf((bf2f(H0[(16 * ss + tok) * 256 + sch]) + h) * gelu_tanh(xg)); }
            } else {
#pragma unroll 4
                for (int j = 0; j < 16; ++j) { const int tok = dir == 0 ? j : 15 - j; const float a = Aab[tok * AB_STRIDE + sch]; h = a * h + Bab[tok * AB_STRIDE + sch];
                    if (FINAL) H0[(16 * ss + tok) * 256 + sch] = (bf16_t)f2bf(h); else pr *= a; }
            }
        }
    }
    __syncthreads();
}
__device__ __forceinline__ void load_xr(LAS unsigned char* lds, const Params& P, int b, int k) {
    const int Ls = k < 4 ? CTXL : SEQ, kk = k < 4 ? k : k - 4, seq0 = k < 4 ? NLAT + b * CTXL : b * SEQ, t0 = 64 * kk - 2;
    for (int e = threadIdx.x; e < (TC + 3) * 32; e += 512) { const int i = e >> 5, cchunk = e & 31, t = t0 + i;
        u32x4 v = (u32x4){0u, 0u, 0u, 0u};
        if (t >= 0 && t < Ls) v = *(const u32x4*)(P.QKL + (size_t)(seq0 + t) * NQKL + 1024 + 8 * cchunk);
        *(LAS u32x4*)(lds + XR_OFF + i * 512 + cchunk * 16) = v; }
    __syncthreads();
}
template <bool FINAL>
__device__ __forceinline__ void super_unit(LAS unsigned char* lds, const Params& P, int su) {
    const int b = su / 130, k0 = 2 * (su % 130), tid = threadIdx.x, dir = tid >> 8, ch = tid & 255;
    float h = 0.f, hb = 0.f, pr = 1.f;
    if (FINAL) {
        const f32x2* ag = P.AGG + ((size_t)b * NCH * 2 + dir) * 256 + ch;
        const int npos = dir == 0 ? k0 : ((k0 + 1) < 4 ? 3 - (k0 + 1) : 263 - (k0 + 1));
#pragma unroll 4
        for (int p = 0; p < npos; ++p) { const int kp = dir == 0 ? p : (p < 4 ? 3 - p : 263 - p); const f32x2 v = ag[(size_t)kp * 512]; h = v.x * h + v.y; }
        if (dir == 1) { hb = h; const f32x2 v = ag[(size_t)(k0 + 1) * 512]; h = v.x * hb + v.y; }
    }
#pragma unroll 1
    for (int j = 0; j < 2; ++j) {
        const int k = k0 + j, row0 = chunk_row0(b, k);
        load_xr(lds, P, b, k);
        if (FINAL) {
            if (j == 1 && dir == 1) h = hb;
            chunk_dir<true>(lds, P, row0, 0, h, pr);
            chunk_dir<true>(lds, P, row0, 1, h, pr);
        } else {
#pragma unroll 1
            for (int d = 0; d < 2; ++d) { h = 0.f; pr = 1.f; chunk_dir<false>(lds, P, row0, d, h, pr);
                if (dir == d) P.AGG[(((size_t)b * NCH + k) * 2 + d) * 256 + ch] = (f32x2){pr, h}; }
        }
    }
}
}

__global__ void __launch_bounds__(256) k_lru_w(const float* wa, const float* wi, bf16_t* LW) {
    const int gid = blockIdx.x * 256 + threadIdx.x; if (gid >= DEPTH * 2 * 4 * 2 * 64 * 64) return;
    const int i = gid & 63, o = (gid >> 6) & 63, ty = (gid >> 12) & 1, nb = (gid >> 13) & 3, dir = (gid >> 15) & 1, l = gid >> 16;
    const float* src = ty == 0 ? wa : wi;
    LW[gid] = (bf16_t)f2bf(src[((((size_t)l * 2 + dir) * 4 + nb) * 64 + i) * 64 + o]);
}
template <bool FINAL>
__global__ void __launch_bounds__(512, 2) k_lru(lru::Params P, int nsu) {
    extern __shared__ __attribute__((aligned(16))) unsigned char lds[];
    for (int su = blockIdx.x; su < 260; su += gridDim.x) { if (FINAL && (su % 130) < 2 && nsu < 260) continue; lru::super_unit<FINAL>((LAS unsigned char*)lds, P, su); }
}
namespace na {
constexpr float LOG2E = 1.4426950408889634f, QSCALE = 0.125f * LOG2E;
constexpr int KC_OFF = 0, VC_OFF = 32768;
constexpr int KL_OFF = 0, VL_OFF = 61440, RPB_OFF = 122880;
constexpr int LDS_END = RPB_OFF + 15 * 32 * 4;
static_assert(LDS_END <= 147456, "na LDS map");
struct Params { const bf16_t* QKL; const bf16_t* VT; const float* rpb; bf16_t* YMIX; };

struct RowState { f32x4 o[4]; float m, l; };
template <bool LOCAL>
__device__ __forceinline__ void chunk(LAS unsigned char* lds, RowState& st, const bf16x8 (&Qf)[2], int kbase, int kstride_pair, int vbase, int lane, int cq, int drbase, int kc0) {
    const int l15 = lane & 15, kg = lane >> 4;
    f32x4 S[8];
#pragma unroll
    for (int t = 0; t < 8; ++t) {
        const int krow = LOCAL ? (kbase + (t >> 1) * kstride_pair + (t & 1) * 16 * 128) : (kbase + t * 16 * 128);
        const int ka = krow + l15 * 128;
        const bf16x8 k0 = *(const LAS bf16x8*)(lds + ka + (((0 + kg) ^ (l15 & 7)) << 4));
        const bf16x8 k1 = *(const LAS bf16x8*)(lds + ka + (((4 + kg) ^ (l15 & 7)) << 4));
        f32x4 s = (f32x4){0.f, 0.f, 0.f, 0.f};
        s = __builtin_amdgcn_mfma_f32_16x16x32_bf16(k0, Qf[0], s, 0, 0, 0);
        s = __builtin_amdgcn_mfma_f32_16x16x32_bf16(k1, Qf[1], s, 0, 0, 0);
        S[t] = s;
    }
    float mx = -3.0e38f;
#pragma unroll
    for (int t = 0; t < 8; ++t)
#pragma unroll
        for (int rg = 0; rg < 4; ++rg) {
            float v = S[t][rg] * QSCALE;
            if (LOCAL) { const int kcol = kc0 + 16 * (t & 1) + 4 * kg + rg; const int start = min(max(cq - 8, 0), GRIDW - 16);
                const bool valid = (kcol >= start) && (kcol < start + 16);
                const float bias = *(const LAS float*)(lds + RPB_OFF + ((drbase + (t >> 1)) * 32 + (valid ? kcol - cq + 15 : 0)) * 4);
                v = valid ? v + bias * LOG2E : -1.0e30f; }
            S[t][rg] = v; mx = fmaxf(mx, v);
        }
    mx = fmaxf(mx, __shfl_xor(mx, 16)); mx = fmaxf(mx, __shfl_xor(mx, 32));
    const float mn = fmaxf(st.m, mx), alpha = __builtin_amdgcn_exp2f(st.m - mn);
    st.m = mn; st.l *= alpha;
#pragma unroll
    for (int dt = 0; dt < 4; ++dt) st.o[dt] *= alpha;
    float ls = 0.f;
#pragma unroll
    for (int t = 0; t < 8; ++t)
#pragma unroll
        for (int rg = 0; rg < 4; ++rg) { const float p = __builtin_amdgcn_exp2f(S[t][rg] - mn); S[t][rg] = p; ls += p; }
    st.l += ls;
#pragma unroll
    for (int j = 0; j < 4; ++j) {
        u32x4 pw; pw.x = pk2(S[2 * j][0], S[2 * j][1]); pw.y = pk2(S[2 * j][2], S[2 * j][3]); pw.z = pk2(S[2 * j + 1][0], S[2 * j + 1][1]); pw.w = pk2(S[2 * j + 1][2], S[2 * j + 1][3]);
        const bf16x8 Pf = __builtin_bit_cast(bf16x8, pw);
        const int vgb = vbase + j * 4096;
#pragma unroll
        for (int dt = 0; dt < 4; ++dt) { const int d = 16 * dt + l15, x = 2 * ((d >> 2) & 3);
            const u32x2 v0 = *(const LAS u32x2*)(lds + vgb + d * 64 + (((0 + kg) ^ x) << 3));
            const u32x2 v1 = *(const LAS u32x2*)(lds + vgb + d * 64 + (((4 + kg) ^ x) << 3));
            const u32x4 vw = (u32x4){v0.x, v0.y, v1.x, v1.y};
            st.o[dt] = __builtin_amdgcn_mfma_f32_16x16x32_bf16(__builtin_bit_cast(bf16x8, vw), Pf, st.o[dt], 0, 0, 0); }
    }
}
__device__ __forceinline__ void stage_ctx(LAS unsigned char* lds, const Params& P, int b, int h) {
    for (int e = threadIdx.x; e < 2048; e += 512) { const int key = e >> 3, c = e & 7;
        *(LAS u32x4*)(lds + KC_OFF + key * 128 + ((c ^ (key & 7)) << 4)) = *(const u32x4*)(P.QKL + (size_t)(NLAT + b * CTXL + key) * NQKL + 512 + h * 64 + 8 * c); }
    for (int e = threadIdx.x; e < 2048; e += 512) { const int d = e >> 5, j8 = e & 31, g32 = j8 >> 2, sp = (j8 & 3) * 2, x = 2 * ((d >> 2) & 3);
        *(LAS u32x4*)(lds + VC_OFF + g32 * 4096 + d * 64 + ((sp ^ x) << 3)) = *(const u32x4*)(P.VT + (size_t)(h * 64 + d) * MT + NLAT + b * CTXL + 8 * j8); }
}
__device__ __forceinline__ void load_q(const Params& P, int row, int h, int lane, bf16x8 (&Qf)[2]) {
    const bf16_t* qp = P.QKL + (size_t)row * NQKL + h * 64 + 8 * (lane >> 4);
    Qf[0] = *(const bf16x8*)(qp); Qf[1] = *(const bf16x8*)(qp + 32);
}
__device__ __forceinline__ void finish_row(const Params& P, RowState& st, int row, int h, int lane) {
    float l = st.l; l += __shfl_xor(l, 16); l += __shfl_xor(l, 32);
    const float inv = 1.0f / l;
    bf16_t* op = P.YMIX + (size_t)row * D + 256 + h * 64 + 4 * (lane >> 4);
#pragma unroll
    for (int dt = 0; dt < 4; ++dt) { const f32x4 o = st.o[dt] * inv; u32x2 w; w.x = pk2(o[0], o[1]); w.y = pk2(o[2], o[3]); *(u32x2*)(op + 16 * dt) = w; }
}
__device__ __forceinline__ void init_row(RowState& st) {
#pragma unroll
    for (int dt = 0; dt < 4; ++dt) st.o[dt] = (f32x4){0.f, 0.f, 0.f, 0.f};
    st.m = -1.0e30f; st.l = 0.f;
}
__device__ __forceinline__ void latent_unit(LAS unsigned char* lds, const Params& P, int u) {
    const int b = u >> 8, h = (u >> 5) & 7, n = (u >> 3) & 3, rr = u & 7, r0 = 32 * rr;
    const int tid = threadIdx.x, lane = tid & 63, w = tid >> 6, l15 = lane & 15;
    const int kc0 = n == 0 ? 0 : (n == 1 ? 8 : (n == 2 ? 24 : 32)), cq = 16 * n + l15;
    __syncthreads();
    stage_ctx(lds, P, b, h);
    __syncthreads();
    RowState st[4]; bf16x8 Qf[2];
#pragma unroll
    for (int g = 0; g < 4; ++g) { init_row(st[g]); const int row = b * SEQ + (r0 + 8 * g + w) * GRIDW + cq; load_q(P, row, h, lane, Qf);
#pragma unroll 1
        for (int cc = 0; cc < 2; ++cc) chunk<false>(lds, st[g], Qf, KC_OFF + cc * 128 * 128, 0, VC_OFF + cc * 4 * 4096, lane, 0, 0, 0); }
    __syncthreads();
    for (int e = tid; e < 15 * 32; e += 512) { const int dr = e >> 5, dc = e & 31; *(LAS float*)(lds + RPB_OFF + e * 4) = dc < 31 ? P.rpb[(h * 15 + dr) * 31 + dc] : 0.f; }
#pragma unroll
    for (int g = 0; g < 4; ++g) {
        const int rg0 = r0 + 8 * g, lo = max(rg0 - 4, 0), hi = min(rg0 + 10, GROWS - 1), nrows = hi - lo + 1;
        if (g > 0) __syncthreads();
#pragma unroll 2
        for (int e = tid; e < nrows * 256; e += 512) { const int kr = e >> 8, col = (e >> 3) & 31, c = e & 7, key = kr * 32 + col;
            *(LAS u32x4*)(lds + KL_OFF + key * 128 + ((c ^ (key & 7)) << 4)) = *(const u32x4*)(P.QKL + (size_t)(b * SEQ + (lo + kr) * GRIDW + kc0 + col) * NQKL + 512 + h * 64 + 8 * c); }
#pragma unroll 2
        for (int e = tid; e < nrows * 256; e += 512) { const int kr = e >> 8, d = (e >> 2) & 63, j8 = e & 3, sp = j8 * 2, x = 2 * ((d >> 2) & 3);
            *(LAS u32x4*)(lds + VL_OFF + kr * 4096 + d * 64 + ((sp ^ x) << 3)) = *(const u32x4*)(P.VT + (size_t)(h * 64 + d) * MT + b * SEQ + (lo + kr) * GRIDW + kc0 + 8 * j8); }
        __syncthreads();
        const int r = rg0 + w, rs = min(max(r - 4, 0), GROWS - 8), row = b * SEQ + r * GRIDW + cq;
        load_q(P, row, h, lane, Qf);
#pragma unroll 1
        for (int cc = 0; cc < 2; ++cc) { const int krel = rs - lo + 4 * cc;
            chunk<true>(lds, st[g], Qf, KL_OFF + krel * 32 * 128, 32 * 128, VL_OFF + krel * 4096, lane, cq, rs + 4 * cc - r + 7, kc0); }
        finish_row(P, st[g], row, h, lane);
    }
}
__device__ __forceinline__ void ctx_unit(LAS unsigned char* lds, const Params& P, int u) {
    const int b = u >> 4, h = (u >> 1) & 7, half = u & 1, lane = threadIdx.x & 63, w = threadIdx.x >> 6;
    __syncthreads();
    stage_ctx(lds, P, b, h);
    __syncthreads();
    RowState st; bf16x8 Qf[2]; init_row(st);
    const int row = NLAT + b * CTXL + 128 * half + 16 * w + (lane & 15);
    load_q(P, row, h, lane, Qf);
#pragma unroll 1
    for (int cc = 0; cc < 2; ++cc) chunk<false>(lds, st, Qf, KC_OFF + cc * 128 * 128, 0, VC_OFF + cc * 4 * 4096, lane, 0, 0, 0);
    finish_row(P, st, row, h, lane);
}
}

__global__ void __launch_bounds__(512, 2) k_na(na::Params P, int nunits) {
    extern __shared__ __attribute__((aligned(16))) unsigned char lds[];
    for (int u = blockIdx.x; u < nunits; u += gridDim.x) { if (u < 512) na::latent_unit((LAS unsigned char*)lds, P, u); else na::ctx_unit((LAS unsigned char*)lds, P, u - 512); }
}
static void launch_gemm(const pg8::GPhase& ph, hipStream_t stream) { hipLaunchKernelGGL(k_gemm, dim3(256), dim3(512), pg8::STAGE_BYTES, stream, ph); }
static pg8::GPhase one_seg(const bf16_t* A, const bf16_t* B, bf16_t* C, int nM, int nN, int ldc, int epi, int K) {
    pg8::GPhase ph{}; ph.s0 = pg8::GSeg{A, B, C, nM, nN, ldc, epi}; ph.s1 = ph.s0; ph.n0 = nM * nN; ph.total = nM * nN; ph.K = K; ph.pad = 0; return ph;
}
extern "C" void kernel_launch(void* const* d_in, const int* in_sizes, int n_in, void* d_out, int out_size, void* d_ws, size_t ws_size, hipStream_t stream) {
    static int inited = 0;
    if (!inited) {
        if (n_in != 31 || in_sizes[0] != NLAT * D || out_size != NLAT * D || ws_size < WS_END) { fprintf(stderr, "kernel_launch: unexpected shapes (n_in %d, in0 %d, out %d, ws %zu)\n", n_in, n_in > 0 ? in_sizes[0] : -1, out_size, ws_size); inited = -1; return; }
        if (hipFuncSetAttribute((const void*)k_gemm, hipFuncAttributeMaxDynamicSharedMemorySize, pg8::STAGE_BYTES) != hipSuccess ||
            hipFuncSetAttribute((const void*)k_filt_fft, hipFuncAttributeMaxDynamicSharedMemorySize, MK_LDS_BYTES) != hipSuccess ||
            hipFuncSetAttribute((const void*)k_hy_fft, hipFuncAttributeMaxDynamicSharedMemorySize, MK_LDS_BYTES) != hipSuccess ||
            hipFuncSetAttribute((const void*)k_na, hipFuncAttributeMaxDynamicSharedMemorySize, MK_LDS_BYTES) != hipSuccess ||
            hipFuncSetAttribute((const void*)k_lru<false>, hipFuncAttributeMaxDynamicSharedMemorySize, MK_LDS_BYTES) != hipSuccess ||
            hipFuncSetAttribute((const void*)k_lru<true>, hipFuncAttributeMaxDynamicSharedMemorySize, MK_LDS_BYTES) != hipSuccess) { fprintf(stderr, "kernel_launch: hipFuncSetAttribute failed\n"); inited = -1; return; }
        inited = 1;
    }
    if (inited < 0) return;
    const float* x = (const float*)d_in[0]; const float* c = (const float*)d_in[1]; const float* ctx = (const float*)d_in[2]; const float* c_ctx = (const float*)d_in[3];
    const float* ada_w = (const float*)d_in[4]; const float* ada_b = (const float*)d_in[5];
    const float* g_mix_pre = (const float*)d_in[6]; const float* g_mix_post = (const float*)d_in[7]; const float* g_ffn_pre = (const float*)d_in[8]; const float* g_ffn_post = (const float*)d_in[9];
    const float* w_in = (const float*)d_in[10]; const float* w_out = (const float*)d_in[11];
    const float* hy_conv_w = (const float*)d_in[12]; const float* hy_conv_b = (const float*)d_in[13];
    const float* hy_f_w1 = (const float*)d_in[14]; const float* hy_f_b1 = (const float*)d_in[15]; const float* hy_f_w2 = (const float*)d_in[16]; const float* hy_f_b2 = (const float*)d_in[17];
    const float* hy_f_w3 = (const float*)d_in[18]; const float* hy_f_freq = (const float*)d_in[19]; const float* hy_bias = (const float*)d_in[20];
    const float* na_rpb = (const float*)d_in[21];
    const float* lru_conv_w = (const float*)d_in[22]; const float* lru_conv_b = (const float*)d_in[23]; const float* lru_wa = (const float*)d_in[24]; const float* lru_ba = (const float*)d_in[25];
    const float* lru_wi = (const float*)d_in[26]; const float* lru_bi = (const float*)d_in[27]; const float* lru_lam = (const float*)d_in[28];
    const float* w_gu = (const float*)d_in[29]; const float* w_dn = (const float*)d_in[30];
    unsigned char* ws = (unsigned char*)d_ws; float* out = (float*)d_out;
    bf16_t* Win_t = (bf16_t*)(ws + WS_WIN); bf16_t* Wout_t = (bf16_t*)(ws + WS_WOUT); bf16_t* Wgu_t = (bf16_t*)(ws + WS_WGU); bf16_t* Wdn_t = (bf16_t*)(ws + WS_WDN);
    float* MOD = (float*)(ws + WS_MOD); float* XC = (float*)(ws + WS_XC); float* H2 = (float*)(ws + WS_H2); float* KN = (float*)(ws + WS_KN);
    bf16_t* H = (bf16_t*)(ws + WS_H); bf16_t* Y = (bf16_t*)(ws + WS_Y); bf16_t* PTV = (bf16_t*)(ws + WS_PTV); bf16_t* QKL = (bf16_t*)(ws + WS_QKL); bf16_t* ACT = (bf16_t*)(ws + WS_ACT);
    bf16_t* YMIX = (bf16_t*)(ws + WS_YMIX); float* KF = (float*)(ws + WS_KF); float* KFC = (float*)(ws + WS_KFC);
    float* HS = (float*)(ws + WS_HF); float* Z1 = (float*)(ws + WS_Z1);

    hipLaunchKernelGGL(k_wconv, dim3(1024), dim3(256), 0, stream, w_in, w_out, w_gu, w_dn, ws);
    hipLaunchKernelGGL(k_lru_w, dim3(DEPTH * 2 * 4 * 2 * 64 * 64 / 256), dim3(256), 0, stream, lru_wa, lru_wi, (bf16_t*)(ws + WS_LW));
    hipLaunchKernelGGL(k_mod, dim3(DEPTH * 6 * D / 256), dim3(256), 0, stream, c, c_ctx, ada_w, ada_b, MOD);
    hipLaunchKernelGGL(k_filt_h2, dim3(DEPTH * FPOS / 4), dim3(256), 0, stream, hy_f_w1, hy_f_b1, hy_f_w2, hy_f_b2, hy_f_freq, H2);
    hipLaunchKernelGGL(k_rownorm0, dim3(MT / 4), dim3(256), 0, stream, x, ctx, g_mix_pre, MOD, H, XC);
    for (int l = 0; l < DEPTH; ++l) {
        const float* modl = MOD + (size_t)l * 3 * 6 * D;
        hipLaunchKernelGGL(k_filt_k, dim3((SEQ / 64) * 16 + (CTXL / 64) * 16), dim3(256), 0, stream, H2 + (size_t)l * FPOS * 64, hy_f_w3 + (size_t)l * 64 * 1024, KF, KFC);
        {
            pg8::GPhase ph{}; const bf16_t* W = Win_t + (size_t)l * INW * D;
            ph.s0 = pg8::GSeg{W, H, PTV, NPTV / 256, MT / 256, MT, 0}; ph.s1 = pg8::GSeg{H, W + (size_t)NPTV * D, QKL, MT / 256, NQKL / 256, NQKL, 0};
            ph.n0 = (NPTV / 256) * (MT / 256); ph.total = ph.n0 + (MT / 256) * (NQKL / 256); ph.K = D; ph.pad = 0;
            launch_gemm(ph, stream);
        }
        const float* hcw = hy_conv_w + (size_t)l * 3 * 768; const float* hcb = hy_conv_b + (size_t)l * 768; const float* hb = hy_bias + (size_t)l * 2 * 256;
        hipLaunchKernelGGL(k_filt_fft, dim3(256), dim3(512), MK_LDS_BYTES, stream, KF, (f32x2*)(ws + WS_H));
        hipLaunchKernelGGL(k_hy_fft, dim3(256), dim3(512), MK_LDS_BYTES, stream, PTV, (const f32x2*)(ws + WS_H), hcw, hcb, hb, (f32x2*)(ws + WS_KF), YMIX);
        const int nrows = (l == 0) ? MT : NLAT;
        if (l == 0) hipLaunchKernelGGL(k_hy_ctx, dim3(256), dim3(512), 0, stream, PTV, KFC, hcw, hcb, hb, YMIX);
        { na::Params np{QKL, PTV + (size_t)768 * MT, na_rpb + (size_t)l * 8 * 15 * 31, YMIX};
          hipLaunchKernelGGL(k_na, dim3(256), dim3(512), MK_LDS_BYTES, stream, np, l == 0 ? 544 : 512); }
        { lru::Params lp{QKL, (const bf16_t*)(ws + WS_LW) + (size_t)l * 2 * 4 * 2 * 64 * 64, lru_conv_w + (size_t)l * 4 * 256, lru_conv_b + (size_t)l * 256, lru_ba + (size_t)l * 512, lru_bi + (size_t)l * 512,
                          lru_lam + (size_t)l * 512, (f32x2*)(ws + WS_AGG), YMIX};
          hipLaunchKernelGGL(k_lru<false>, dim3(256), dim3(512), MK_LDS_BYTES, stream, lp, 260);
          hipLaunchKernelGGL(k_lru<true>, dim3(256), dim3(512), MK_LDS_BYTES, stream, lp, l == 0 ? 260 : 256); }
        launch_gemm(one_seg(YMIX, Wout_t + (size_t)l * D * D, Y, MT / 256, D / 256, D, 0, D), stream);
        hipLaunchKernelGGL(k_rowpass, dim3(MT / 4), dim3(256), 0, stream, Y, l == 0 ? x : out, l == 0 ? ctx : XC, out, XC, g_mix_post + (size_t)l * D, modl, 2,
                           g_ffn_pre + (size_t)l * D, modl, 3, H, nrows);
        launch_gemm(one_seg(H, Wgu_t + (size_t)l * 2 * DFF * D, ACT, MT / 256, 2 * DFF / 256, DFF, 1, D), stream);
        launch_gemm(one_seg(ACT, Wdn_t + (size_t)l * D * DFF, Y, MT / 256, D / 256, D, 0, DFF), stream);
        const bool lastl = (l == DEPTH - 1);
        hipLaunchKernelGGL(k_rowpass, dim3(MT / 4), dim3(256), 0, stream, Y, out, XC, out, XC, g_ffn_post + (size_t)l * D, modl, 5,
                           lastl ? (const float*)nullptr : g_mix_pre + (size_t)(l + 1) * D, lastl ? modl : modl + 3 * 6 * D, 0, H, nrows);
    }
}
```

```cpp
#include <hip/hip_runtime.h>
#include <cstdio>
#include <cstdint>
#include <cmath>

#define LAS __attribute__((address_space(3)))
typedef unsigned short bf16_t;
typedef short bf16x8 __attribute__((ext_vector_type(8)));
typedef float f32x4 __attribute__((ext_vector_type(4)));
typedef float f32x2 __attribute__((ext_vector_type(2)));
typedef unsigned u32x4 __attribute__((ext_vector_type(4)));
typedef unsigned u32x2 __attribute__((ext_vector_type(2)));

constexpr int D = 1024, NB = 2, SEQ = 16384, DEPTH = 2, GRIDW = 64, GROWS = 256, CTXL = 256;
constexpr int NLAT = NB * SEQ, NCTX = NB * CTXL, MT = NLAT + NCTX;
constexpr int HYW = 256, NAW = 512, NHEAD = 8, DH = 64, LRW = 256, INW = 2816, DFF = 2816;
constexpr int NPTV = 1280;
constexpr int NQKL = 1536;
constexpr int FPOS = SEQ + CTXL;

constexpr size_t MiB = 1u << 20;
constexpr size_t WS_CTL = 0;
constexpr size_t WS_WIN = 1 * MiB, WS_WOUT = 12 * MiB, WS_WGU = 16 * MiB, WS_WDN = 38 * MiB;
constexpr size_t WS_MOD = 49 * MiB;
constexpr size_t WS_XC = 50 * MiB;
constexpr size_t WS_H2 = 52 * MiB;
constexpr size_t WS_KN = 61 * MiB;
constexpr size_t WS_H = 64 * MiB;
constexpr size_t WS_Y = 129 * MiB;
constexpr size_t WS_PTV = 194 * MiB;
constexpr size_t WS_QKL = WS_PTV + (size_t)NPTV * MT * 2;
constexpr size_t WS_ACT = WS_PTV;
constexpr size_t WS_YMIX = 373 * MiB;
constexpr size_t WS_KF = 438 * MiB;
constexpr size_t WS_KFC = 502 * MiB;
constexpr size_t WS_AGG = 504 * MiB;
constexpr size_t WS_LW = 62 * MiB;
constexpr size_t WS_END = 508 * MiB;
constexpr size_t WS_HF = WS_H, WS_HR = WS_H + (size_t)MT * LRW * 4;
constexpr size_t WS_Z1 = WS_Y;
static_assert(WS_QKL + (size_t)MT * NQKL * 2 <= WS_YMIX && WS_ACT + (size_t)MT * DFF * 2 <= WS_YMIX, "ws map");
static_assert(WS_HR + (size_t)MT * LRW * 4 <= WS_Y && WS_Z1 + (size_t)256 * 2 * SEQ * 4 <= WS_PTV, "ws map");

__device__ __forceinline__ int opaque_i(int v) { asm volatile("" : "+v"(v)); return v; }
__device__ __forceinline__ unsigned f2bf(float f) { unsigned u = __float_as_uint(f); return (u + 0x7fffu + ((u >> 16) & 1u)) >> 16; }
__device__ __forceinline__ unsigned pk2(float lo, float hi) { return f2bf(lo) | (f2bf(hi) << 16); }
__device__ __forceinline__ float bf2f(unsigned h) { return __uint_as_float(h << 16); }
__device__ __forceinline__ float wave_sum(float v) {
#pragma unroll
    for (int o = 1; o < 64; o <<= 1) v += __shfl_xor(v, o);
    return v;
}
__device__ __forceinline__ float wave_max(float v) {
#pragma unroll
    for (int o = 1; o < 64; o <<= 1) v = fmaxf(v, __shfl_xor(v, o));
    return v;
}
__device__ __forceinline__ float silu_f(float g) { return g * __builtin_amdgcn_rcpf(1.0f + __builtin_amdgcn_exp2f(-1.44269504089f * g)); }
__device__ __forceinline__ float sigmoid_f(float g) { return 1.0f / (1.0f + expf(-g)); }
__device__ __forceinline__ float gelu_tanh(float x) { const float u = 0.7978845608028654f * (x + 0.044715f * x * x * x); return 0.5f * x * (1.0f + tanhf(u)); }

namespace pg8 {
constexpr int BM = 256, BK = 64, HALF = 128, HTB = HALF * BK * 2, STAGE_BYTES = 8 * HTB;
#ifndef MK_WGM
#define MK_WGM 8
#endif
constexpr int WGM = MK_WGM;
__host__ __device__ __forceinline__ int lds_byte(int r, int c) { const int st = (r >> 4) * 2 + (c >> 5), rr = r & 15, cc = c & 31, ob = rr * 64 + cc * 2; return st * 1024 + (ob ^ (((ob >> 9) & 1) << 5)); }
__host__ __device__ __forceinline__ void stage_rc(int b, int& R, int& C) { const int st = b / 1024, sb = b % 1024, swz = sb ^ (((sb >> 9) & 1) << 5); R = (st >> 1) * 16 + swz / 64; C = (st & 1) * 32 + (swz % 64) / 2; }
__host__ __device__ __forceinline__ int perm32(int rho) { const int n = rho >> 4, i = rho & 15; return 8 * (i >> 2) + 4 * n + (i & 3); }

struct GSeg { const bf16_t* A; const bf16_t* B; bf16_t* C; int nM, nN, ldc, epi; };
struct GPhase { GSeg s0, s1; int n0, total, K, pad; };
struct Unit { const char* a; const char* b; bf16_t* C; int ldc, epi, pm, pn; };

struct Sched {
    GPhase ph; int G, c;
    __device__ __forceinline__ bool next(int i, Unit& u) const {
        const long L = (long)i * G + c; if (L >= ph.total) return false;
        int wgid = (int)L; { const int nwg = ph.total, q = nwg / 8, r = nwg % 8, xcd = wgid % 8, off = wgid / 8; wgid = (xcd < r ? xcd * (q + 1) : r * (q + 1) + (xcd - r) * q) + off; }
        const bool first = wgid < ph.n0; if (!first) wgid -= ph.n0;
        const bf16_t* A = first ? ph.s0.A : ph.s1.A; const bf16_t* B = first ? ph.s0.B : ph.s1.B; bf16_t* C = first ? ph.s0.C : ph.s1.C;
        const int nM = first ? ph.s0.nM : ph.s1.nM, nN = first ? ph.s0.nN : ph.s1.nN;
        u.ldc = first ? ph.s0.ldc : ph.s1.ldc; u.epi = first ? ph.s0.epi : ph.s1.epi; u.C = C;
        const int nig = WGM * nN, gid = wgid / nig, fm = gid * WGM, gsz = (nM - fm) < WGM ? (nM - fm) : WGM;
        u.pm = fm + ((wgid % nig) % gsz); u.pn = (wgid % nig) / gsz;
        u.a = (const char*)A + (size_t)u.pm * BM * ph.K * 2; u.b = (const char*)B + (size_t)u.pn * BM * ph.K * 2;
        return true;
    }
};

__device__ __forceinline__ unsigned cvt_pk_bf16(float lo, float hi) { unsigned r; asm volatile("v_cvt_pk_bf16_f32 %0, %1, %2" : "=v"(r) : "v"(lo), "v"(hi)); return r; }

struct Epi {
    __device__ __forceinline__ void operator()(const f32x4 (&acc)[2][2][4][2], const Unit& u, int wr, int wc, int fr, int fq) const {
        const int row0 = u.pm * BM + wr * 64 + fr;
        if (u.epi == 0) {
            const int col0 = u.pn * BM + wc * 32 + 8 * fq;
#pragma unroll
            for (int ai = 0; ai < 2; ++ai)
#pragma unroll
                for (int m = 0; m < 4; ++m) { bf16_t* rowp = u.C + (size_t)(row0 + ai * HALF + m * 16) * u.ldc + col0;
#pragma unroll
                    for (int bj = 0; bj < 2; ++bj) { const f32x4 v0 = acc[ai][bj][m][0], v1 = acc[ai][bj][m][1];
                        u32x4 w; w.x = cvt_pk_bf16(v0[0], v0[1]); w.y = cvt_pk_bf16(v0[2], v0[3]); w.z = cvt_pk_bf16(v1[0], v1[1]); w.w = cvt_pk_bf16(v1[2], v1[3]);
                        *(u32x4*)(rowp + bj * HALF) = w; } }
        } else {
            const int col0 = u.pn * HALF + wc * 32 + 8 * fq;
#pragma unroll
            for (int ai = 0; ai < 2; ++ai)
#pragma unroll
                for (int m = 0; m < 4; ++m) { bf16_t* rowp = u.C + (size_t)(row0 + ai * HALF + m * 16) * u.ldc + col0;
                    const f32x4 g0 = acc[ai][0][m][0], g1 = acc[ai][0][m][1], u0 = acc[ai][1][m][0], u1 = acc[ai][1][m][1];
                    u32x4 w; w.x = cvt_pk_bf16(silu_f(g0[0]) * u0[0], silu_f(g0[1]) * u0[1]); w.y = cvt_pk_bf16(silu_f(g0[2]) * u0[2], silu_f(g0[3]) * u0[3]);
                    w.z = cvt_pk_bf16(silu_f(g1[0]) * u1[0], silu_f(g1[1]) * u1[1]); w.w = cvt_pk_bf16(silu_f(g1[2]) * u1[2], silu_f(g1[3]) * u1[3]);
                    *(u32x4*)rowp = w; }
        }
    }
};

__device__ __forceinline__ void gemm_phase(LAS unsigned char* lds, const Sched& S, const Epi& E) {
    const int tid = opaque_i(threadIdx.x), wid = __builtin_amdgcn_readfirstlane(tid >> 6), lane = tid & 63, wr = wid >> 2, wc = wid & 3, fr = lane & 15, fq = lane >> 4;
    const int K = S.ph.K, nt = K / BK;
    unsigned voffA[2], voffB[2];
#pragma unroll
    for (int i = 0; i < 2; ++i) { int R, C; stage_rc(tid * 16 + i * 8192, R, C); const int Rb = (R & ~31) + perm32(R & 31);
        voffA[i] = (unsigned)(R * K + C) * 2u; voffB[i] = (unsigned)(Rb * K + C) * 2u; }
    const size_t kstep = (size_t)(BK * 2);
    const size_t hstep = (size_t)HALF * K * 2;
    const unsigned ldsw = (unsigned)wid * 1024u;
    const int aoff = lds_byte(wr * 64 + fr, fq * 8), boff = lds_byte(wc * 32 + fr, fq * 8);
#define PG8_SA(b, h) (((b) * 2 + (h)) * HTB)
#define PG8_SB(b, h) ((4 + (b) * 2 + (h)) * HTB)
#define PG8_STAGE(bufoff, gbase, voff) do { _Pragma("unroll") for (int _i = 0; _i < 2; ++_i) \
        __builtin_amdgcn_global_load_lds((const unsigned*)((const char*)(gbase) + (voff)[_i]), (LAS unsigned*)(lds + (bufoff) + ldsw + _i * 8192), 16, 0, 0); } while (0)
#define PG8_LDA(dst, b, h) do { _Pragma("unroll") for (int m = 0; m < 4; ++m) _Pragma("unroll") for (int k = 0; k < 2; ++k) dst[m][k] = *(const LAS bf16x8*)(lds + PG8_SA(b, h) + aoff + m * 2048 + k * 1024); } while (0)
#define PG8_LDB(dst, b, h) do { _Pragma("unroll") for (int n = 0; n < 2; ++n) _Pragma("unroll") for (int k = 0; k < 2; ++k) dst[n][k] = *(const LAS bf16x8*)(lds + PG8_SB(b, h) + boff + n * 2048 + k * 1024); } while (0)
#define PG8_MMA(ai, bj, At, Bt) do { __builtin_amdgcn_s_setprio(1); _Pragma("unroll") for (int m = 0; m < 4; ++m) _Pragma("unroll") for (int n = 0; n < 2; ++n) _Pragma("unroll") for (int k = 0; k < 2; ++k) \
        acc[ai][bj][m][n] = __builtin_amdgcn_mfma_f32_16x16x32_bf16(Bt[n][k], At[m][k], acc[ai][bj][m][n], 0, 0, 0); __builtin_amdgcn_s_setprio(0); } while (0)
#define PG8_WAIT_V(n) asm volatile("s_waitcnt vmcnt(" #n ")" ::: "memory")
#define PG8_WAIT_L(n) asm volatile("s_waitcnt lgkmcnt(" #n ")" ::: "memory")
#define PG8_BAR __builtin_amdgcn_s_barrier()
#define PG8_SCHED __builtin_amdgcn_sched_barrier(0)
    Unit cur, nxt; int ui = 0;
    if (!S.next(0, cur)) return;
    f32x4 acc[2][2][4][2];
#pragma unroll
    for (int a = 0; a < 2; ++a)
#pragma unroll
        for (int b = 0; b < 2; ++b)
#pragma unroll
            for (int m = 0; m < 4; ++m)
#pragma unroll
                for (int n = 0; n < 2; ++n) acc[a][b][m][n] = (f32x4){0.f, 0.f, 0.f, 0.f};
    bf16x8 At[4][2], B0[2][2], B1[2][2];
    const char* cA = cur.a; const char* cB = cur.b;
    PG8_STAGE(PG8_SB(0, 0), cB, voffB); PG8_STAGE(PG8_SB(0, 1), cB + hstep, voffB); PG8_STAGE(PG8_SA(0, 0), cA, voffA); PG8_STAGE(PG8_SA(0, 1), cA + hstep, voffA);
    if (wr == 1) PG8_BAR;
    PG8_WAIT_V(2); PG8_BAR;
    PG8_STAGE(PG8_SB(1, 0), cB + kstep, voffB); PG8_STAGE(PG8_SA(1, 0), cA + kstep, voffA); PG8_STAGE(PG8_SB(1, 1), cB + hstep + kstep, voffB);
    PG8_WAIT_V(6); PG8_BAR;
    for (;;) {
        const bool has_next = S.next(ui + 1, nxt);
        const char* nA = has_next ? nxt.a : cA; const char* nB = has_next ? nxt.b : cB;
        for (int t = 0; t < nt; t += 2) {
            const bool last = (t == nt - 2);
            const char* a1 = cA + (size_t)(t + 1) * kstep;
            const char* a2 = last ? nA : cA + (size_t)(t + 2) * kstep; const char* b2 = last ? nB : cB + (size_t)(t + 2) * kstep;
            const char* a3 = a2 + kstep; const char* b3 = b2 + kstep;
            PG8_LDB(B0, 0, 0); PG8_LDB(B1, 0, 1); PG8_SCHED; PG8_LDA(At, 0, 0); PG8_STAGE(PG8_SA(1, 1), a1 + hstep, voffA);
            PG8_WAIT_V(8); PG8_WAIT_L(0); PG8_BAR; PG8_MMA(0, 0, At, B0); PG8_MMA(0, 1, At, B1); PG8_BAR; PG8_SCHED;
            PG8_LDA(At, 0, 1); PG8_STAGE(PG8_SB(0, 0), b2, voffB); PG8_STAGE(PG8_SB(0, 1), b2 + hstep, voffB); PG8_STAGE(PG8_SA(0, 0), a2, voffA);
            PG8_WAIT_V(8); PG8_WAIT_L(0); PG8_BAR; PG8_MMA(1, 0, At, B0); PG8_MMA(1, 1, At, B1); PG8_BAR; PG8_SCHED;
            PG8_LDB(B0, 1, 0); PG8_LDB(B1, 1, 1); PG8_SCHED; PG8_LDA(At, 1, 0); PG8_STAGE(PG8_SA(0, 1), a2 + hstep, voffA);
            PG8_WAIT_V(8); PG8_WAIT_L(0); PG8_BAR; PG8_MMA(0, 0, At, B0); PG8_MMA(0, 1, At, B1); PG8_BAR; PG8_SCHED;
            PG8_LDA(At, 1, 1); PG8_STAGE(PG8_SB(1, 0), b3, voffB); PG8_STAGE(PG8_SB(1, 1), b3 + hstep, voffB); PG8_STAGE(PG8_SA(1, 0), a3, voffA);
            PG8_WAIT_V(8); PG8_WAIT_L(0); PG8_BAR; PG8_MMA(1, 0, At, B0); PG8_MMA(1, 1, At, B1); PG8_BAR; PG8_SCHED;
        }
        if (wr == 0) PG8_BAR;
        E(acc, cur, wr, wc, fr, fq);
        if (!has_next) break;
#pragma unroll
        for (int a = 0; a < 2; ++a)
#pragma unroll
            for (int b = 0; b < 2; ++b)
#pragma unroll
                for (int m = 0; m < 4; ++m)
#pragma unroll
                    for (int n = 0; n < 2; ++n) acc[a][b][m][n] = (f32x4){0.f, 0.f, 0.f, 0.f};
        cur = nxt; cA = nA; cB = nB; ++ui;
        if (wr == 1) PG8_BAR;
    }
    PG8_WAIT_V(0);
    PG8_BAR;
#undef PG8_SA
#undef PG8_SB
#undef PG8_STAGE
#undef PG8_LDA
#undef PG8_LDB
#undef PG8_MMA
#undef PG8_WAIT_V
#undef PG8_WAIT_L
#undef PG8_BAR
#undef PG8_SCHED
}
}
__device__ __forceinline__ int wrowmap(int kind, int n0) {
    if (kind == 0) { if (n0 < 768) return n0; if (n0 < 1792) return 1280 + (n0 - 768); if (n0 < 2304) return 768 + (n0 - 1792); return n0; }
    if (kind == 2) { if (n0 < DFF) return 256 * (n0 / 128) + (n0 % 128); const int m = n0 - DFF; return 256 * (m / 128) + 128 + (m % 128); }
    return n0;
}
__device__ __forceinline__ void transpose_item(const float* W, int K, int N, bf16_t* WT, int kind, LAS float* scr, int item, int lane) {
    const int nblk = N / 32, kb = item / nblk, nb = item % nblk, k0 = 64 * kb, n0 = 32 * nb, r0 = wrowmap(kind, n0);
    float wv[32];
#pragma unroll
    for (int i = 0; i < 32; ++i) { const int kk = 2 * i + (lane >> 5); wv[i] = W[(size_t)(k0 + kk) * N + n0 + (lane & 31)]; }
#pragma unroll
    for (int i = 0; i < 32; ++i) { const int kk = 2 * i + (lane >> 5); scr[kk * 33 + (lane & 31)] = wv[i]; }
    asm volatile("s_waitcnt lgkmcnt(0)" ::: "memory");
    const int c = lane & 7;
#pragma unroll
    for (int j = 0; j < 4; ++j) { const int n = (lane >> 3) + 8 * j; const LAS float* s = scr + (8 * c) * 33 + n;
        u32x4 o; o.x = pk2(s[0 * 33], s[1 * 33]); o.y = pk2(s[2 * 33], s[3 * 33]); o.z = pk2(s[4 * 33], s[5 * 33]); o.w = pk2(s[6 * 33], s[7 * 33]);
        *(u32x4*)(WT + (size_t)(r0 + n) * K + k0 + 8 * c) = o; }
    asm volatile("s_waitcnt lgkmcnt(0)" ::: "memory");
}
constexpr int WI_IN = (D / 64) * (INW / 32), WI_OUT = (D / 64) * (D / 32), WI_GU = (D / 64) * (2 * DFF / 32), WI_DN = (DFF / 64) * (D / 32), WI_LAYER = WI_IN + WI_OUT + WI_GU + WI_DN;
__device__ __forceinline__ void wconv_item(int it, const float* w_in, const float* w_out, const float* w_gu, const float* w_dn, unsigned char* ws, LAS float* scr, int lane) {
    const int l = it / WI_LAYER; int r = it % WI_LAYER;
    if (r < WI_IN) { transpose_item(w_in + (size_t)l * D * INW, D, INW, (bf16_t*)(ws + WS_WIN) + (size_t)l * INW * D, 0, scr, r, lane); return; } r -= WI_IN;
    if (r < WI_OUT) { transpose_item(w_out + (size_t)l * D * D, D, D, (bf16_t*)(ws + WS_WOUT) + (size_t)l * D * D, 1, scr, r, lane); return; } r -= WI_OUT;
    if (r < WI_GU) { transpose_item(w_gu + (size_t)l * D * 2 * DFF, D, 2 * DFF, (bf16_t*)(ws + WS_WGU) + (size_t)l * 2 * DFF * D, 2, scr, r, lane); return; } r -= WI_GU;
    transpose_item(w_dn + (size_t)l * DFF * D, DFF, D, (bf16_t*)(ws + WS_WDN) + (size_t)l * D * DFF, 1, scr, r, lane);
}
static __device__ constexpr float C32T[16] = {1.000000000e+00f, 9.807852804e-01f, 9.238795325e-01f, 8.314696123e-01f, 7.071067812e-01f, 5.555702330e-01f, 3.826834324e-01f, 1.950903220e-01f, 0.0f, -1.950903220e-01f, -3.826834324e-01f, -5.555702330e-01f, -7.071067812e-01f, -8.314696123e-01f, -9.238795325e-01f, -9.807852804e-01f};
static __device__ constexpr float S32T[16] = {0.000000000e+00f, 1.950903220e-01f, 3.826834324e-01f, 5.555702330e-01f, 7.071067812e-01f, 8.314696123e-01f, 9.238795325e-01f, 9.807852804e-01f, 1.000000000e+00f, 9.807852804e-01f, 9.238795325e-01f, 8.314696123e-01f, 7.071067812e-01f, 5.555702330e-01f, 3.826834324e-01f, 1.950903220e-01f};
static __device__ constexpr float C64T[32] = {1.000000000e+00f, 9.951847267e-01f, 9.807852804e-01f, 9.569403357e-01f, 9.238795325e-01f, 8.819212643e-01f, 8.314696123e-01f, 7.730104534e-01f, 7.071067812e-01f, 6.343932842e-01f, 5.555702330e-01f, 4.713967368e-01f, 3.826834324e-01f, 2.902846773e-01f, 1.950903220e-01f, 9.801714033e-02f, 0.0f, -9.801714033e-02f, -1.950903220e-01f, -2.902846773e-01f, -3.826834324e-01f, -4.713967368e-01f, -5.555702330e-01f, -6.343932842e-01f, -7.071067812e-01f, -7.730104534e-01f, -8.314696123e-01f, -8.819212643e-01f, -9.238795325e-01f, -9.569403357e-01f, -9.807852804e-01f, -9.951847267e-01f};
static __device__ constexpr float S64T[32] = {0.000000000e+00f, 9.801714033e-02f, 1.950903220e-01f, 2.902846773e-01f, 3.826834324e-01f, 4.713967368e-01f, 5.555702330e-01f, 6.343932842e-01f, 7.071067812e-01f, 7.730104534e-01f, 8.314696123e-01f, 8.819212643e-01f, 9.238795325e-01f, 9.569403357e-01f, 9.807852804e-01f, 9.951847267e-01f, 1.000000000e+00f, 9.951847267e-01f, 9.807852804e-01f, 9.569403357e-01f, 9.238795325e-01f, 8.819212643e-01f, 8.314696123e-01f, 7.730104534e-01f, 7.071067812e-01f, 6.343932842e-01f, 5.555702330e-01f, 4.713967368e-01f, 3.826834324e-01f, 2.902846773e-01f, 1.950903220e-01f, 9.801714033e-02f};

namespace fft {
constexpr int L = SEQ, N2 = 2 * SEQ;
constexpr int XSLOTS = 17904;
constexpr int LDS_X_BYTES = XSLOTS * 8;
constexpr int LDS_RED = LDS_X_BYTES;
typedef LAS f32x2* xptr;
typedef unsigned spec_t;
__device__ __forceinline__ unsigned pack_h2(float lo, float hi) { typedef _Float16 h2v __attribute__((ext_vector_type(2))); const h2v v = {(_Float16)lo, (_Float16)hi}; return __builtin_bit_cast(unsigned, v); }
__device__ __forceinline__ f32x2 unpack_h2(unsigned w) { typedef _Float16 h2v __attribute__((ext_vector_type(2))); const h2v v = __builtin_bit_cast(h2v, w); return (f32x2){(float)v.x, (float)v.y}; }
__device__ __forceinline__ f32x2 cmul(f32x2 a, f32x2 b) { return (f32x2){a.x * b.x - a.y * b.y, a.x * b.y + a.y * b.x}; }
__device__ __forceinline__ f32x2 cmulc(f32x2 a, f32x2 b) { return (f32x2){a.x * b.x + a.y * b.y, a.y * b.x - a.x * b.y}; }
__device__ __forceinline__ f32x2 expi(float x) { float s, c; sincospif(x, &s, &c); return (f32x2){c, s}; }
constexpr __host__ __device__ int bitrev(int j, int R) { int r = 0; for (int b = 1; b < R; b <<= 1) { r = (r << 1) | (j & 1); j >>= 1; } return r; }

template <int R, int S, bool INV> struct Stage {
    static __device__ __forceinline__ void run(f32x2 (&a)[R]) {
#pragma unroll
        for (int base = 0; base < R; base += 2 * S)
#pragma unroll
            for (int k = 0; k < S; ++k) {
                const int i0 = base + k, i1 = i0 + S, ti = k * (16 / S);
                const f32x2 u = a[i0], v = a[i1]; a[i0] = u + v; const f32x2 d = u - v;
                if (ti == 0) a[i1] = d;
                else if (ti == 8) a[i1] = INV ? (f32x2){-d.y, d.x} : (f32x2){d.y, -d.x};
                else { const float c = C32T[ti], s = S32T[ti]; a[i1] = INV ? (f32x2){d.x * c - d.y * s, d.x * s + d.y * c} : (f32x2){d.x * c + d.y * s, d.y * c - d.x * s}; }
            }
        if constexpr (S > 1) Stage<R, S / 2, INV>::run(a);
    }
};
template <int R, bool INV> __device__ __forceinline__ void dft(f32x2 (&a)[R]) {
    Stage<R, R / 2, INV>::run(a);
    f32x2 t[R];
#pragma unroll
    for (int j = 0; j < R; ++j) t[j] = a[bitrev(j, R)];
#pragma unroll
    for (int j = 0; j < R; ++j) a[j] = t[j];
}
template <int R, bool CONJ> __device__ __forceinline__ void twiddle(f32x2 (&a)[R], f32x2 w) {
    f32x2 tw[R]; tw[0] = (f32x2){1.f, 0.f}; tw[1] = w;
#pragma unroll
    for (int j = 2; j < R; ++j) tw[j] = cmul(tw[j >> 1], tw[j - (j >> 1)]);
#pragma unroll
    for (int j = 1; j < R; ++j) a[j] = CONJ ? cmulc(a[j], tw[j]) : cmul(a[j], tw[j]);
}
__device__ __forceinline__ void bar() { __syncthreads(); }
__device__ __forceinline__ int opaque(int v) { return opaque_i(v); }

__device__ __forceinline__ void fwd12(xptr X, int tid) {
    f32x2 a[32];
    { const int p0 = tid + (tid >> 4);
#pragma unroll
      for (int q = 0; q < 32; ++q) a[q] = X[p0 + 560 * q];
      dft<32, false>(a); twiddle<32, false>(a, expi(-(float)opaque(tid) * (1.0f / 8192.0f)));
#pragma unroll
      for (int q = 0; q < 32; ++q) X[p0 + 560 * q] = a[q]; }
    bar();
    { const int blk = tid >> 4, np = tid & 15, p0 = 560 * blk + np;
#pragma unroll
      for (int q = 0; q < 32; ++q) a[q] = X[p0 + 17 * q];
      dft<32, false>(a); twiddle<32, false>(a, expi(-(float)opaque(np) * (1.0f / 256.0f)));
#pragma unroll
      for (int q = 0; q < 32; ++q) X[p0 + 17 * q] = a[q]; }
    bar();
}
__device__ __forceinline__ void inv21(xptr X, int tid, f32x2 (&a)[32]) {
    { const int blk = tid >> 4, np = tid & 15, p0 = 560 * blk + np;
#pragma unroll
      for (int q = 0; q < 32; ++q) a[q] = X[p0 + 17 * q];
      twiddle<32, true>(a, expi(-(float)opaque(np) * (1.0f / 256.0f))); dft<32, true>(a);
#pragma unroll
      for (int q = 0; q < 32; ++q) X[p0 + 17 * q] = a[q]; }
    bar();
    { const int p0 = tid + (tid >> 4);
#pragma unroll
      for (int q = 0; q < 32; ++q) a[q] = X[p0 + 560 * q];
      twiddle<32, true>(a, expi(-(float)opaque(tid) * (1.0f / 8192.0f))); dft<32, true>(a); }
}
template <int MODE> __device__ __forceinline__ void pass3(xptr X, int tid, spec_t* G, float scale) {
    u32x2 kv[2][8];
    if (MODE == 1) {
#pragma unroll
        for (int gi = 0; gi < 2; ++gi)
#pragma unroll
            for (int j2 = 0; j2 < 8; ++j2) kv[gi][j2] = *(const u32x2*)(G + j2 * 2048 + 2 * (tid + 512 * gi));
    }
#pragma unroll
    for (int gi = 0; gi < 2; ++gi) {
        const int g = tid + 512 * gi, p0 = 17 * g + 16 * (g >> 5);
        f32x2 a[16];
#pragma unroll
        for (int q = 0; q < 16; ++q) a[q] = X[p0 + q];
        dft<16, false>(a);
        if (MODE == 0) {
#pragma unroll
            for (int j = 0; j < 16; j += 2) { u32x2 o; o.x = pack_h2(a[j].x * scale, a[j].y * scale); o.y = pack_h2(a[j + 1].x * scale, a[j + 1].y * scale); *(u32x2*)(G + (j >> 1) * 2048 + 2 * g) = o; }
        } else {
#pragma unroll
            for (int j = 0; j < 16; j += 2) { const u32x2 k2 = kv[gi][j >> 1]; a[j] = cmul(a[j], unpack_h2(k2.x)); a[j + 1] = cmul(a[j + 1], unpack_h2(k2.y)); }
            dft<16, true>(a);
#pragma unroll
            for (int q = 0; q < 16; ++q) X[p0 + q] = a[q];
        }
        asm volatile("" ::: "memory");
    }
    if (MODE == 1) bar();
}
__device__ __forceinline__ f32x2 wN(f32x2 base, int q) { return cmul(base, (f32x2){C64T[q], -S64T[q]}); }

__device__ __forceinline__ void filter_unit(LAS unsigned char* lds, const bf16_t* kf, const bf16_t* kb, spec_t* KFo) {
    xptr X = (xptr)lds; LAS float* red = (LAS float*)(lds + LDS_RED);
    const int tid = opaque_i(threadIdx.x), p0 = tid + (tid >> 4);
    const f32x2 base = expi(-(float)tid * (1.0f / 16384.0f));
    float nrm = 0.f;
    {   float fv[32], bv[32];
#pragma unroll
        for (int q = 0; q < 32; ++q) { const int n = tid + 512 * q; fv[q] = bf2f(kf[n]); bv[q] = bf2f(kb[n >= 1 ? L - n : 0]); }
#pragma unroll
        for (int q = 0; q < 32; ++q) { const int n = tid + 512 * q; const float f = fv[q], b = n >= 1 ? bv[q] : 0.f; nrm += fabsf(f) + fabsf(b); X[p0 + 560 * q] = (f32x2){f + b, 0.f}; } }
    nrm = wave_sum(nrm); if ((tid & 63) == 0) red[tid >> 6] = nrm;
    bar();
    float tot = 0.f;
#pragma unroll
    for (int i = 0; i < 8; ++i) tot += red[i];
    const float scale = 1.0f / tot;
    fwd12(X, tid); pass3<0>(X, tid, KFo, scale);
    bar();
    asm volatile("" ::: "memory");
    {   float fv[32], bv[32];
        const int tq = opaque(tid);
#pragma unroll
        for (int q = 0; q < 32; ++q) { const int n = tq + 512 * q; fv[q] = bf2f(kf[n]); bv[q] = bf2f(kb[n >= 1 ? L - n : 0]); }
#pragma unroll
        for (int q = 0; q < 32; ++q) { const int n = tq + 512 * q; const float d = fv[q] - (n >= 1 ? bv[q] : 0.f); const f32x2 w = wN(base, q); X[p0 + 560 * q] = (f32x2){d * w.x, d * w.y}; } }
    bar();
    fwd12(X, tid); pass3<0>(X, tid, KFo + L, scale);
    bar();
}

__device__ __forceinline__ void stage_row(LAS unsigned char* lds, const bf16_t* row, int tid_) {
    const int tid = opaque(tid_), wv = __builtin_amdgcn_readfirstlane(tid >> 6), lane = tid & 63;
#pragma unroll
    for (int it = 0; it < 8; ++it) { const int e = (it * 8 + wv) * 64 + lane, b = e >> 11, ck = e & 2047;
        __builtin_amdgcn_global_load_lds((const unsigned*)(row + (size_t)b * SEQ + 8 * ck), (LAS unsigned*)(lds + (it * 8 + wv) * 1024), 16, 0, 0); }
}
__device__ __forceinline__ f32x2 conv3_lds(const LAS bf16_t* S, int n, float w0, float w1, float w2, float wb) {
    const int nm = n > 0 ? n - 1 : 0, np = n + 1 < SEQ ? n + 1 : SEQ - 1; const float wm = n > 0 ? w0 : 0.f, wp = n + 1 < SEQ ? w2 : 0.f;
    const float a0 = wb + w1 * bf2f(S[n]) + wm * bf2f(S[nm]) + wp * bf2f(S[np]);
    const float a1 = wb + w1 * bf2f(S[SEQ + n]) + wm * bf2f(S[SEQ + nm]) + wp * bf2f(S[SEQ + np]);
    return (f32x2){a0, a1};
}
__device__ __forceinline__ void hyena_unit(LAS unsigned char* lds, int c, const bf16_t* PTV, const spec_t* KFc, size_t ostride, const float* cw, const float* cb, const float* hbias,
                                           unsigned* Zs, unsigned* Rs, bf16_t* YMIX, int pm = 0) {
    xptr X = (xptr)lds;
    const int tid = opaque_i(threadIdx.x), p0 = tid + (tid >> 4);
#ifdef MK_HY_EXTRA
    for (int xr_ = 0; xr_ < MK_HY_EXTRA; ++xr_) {
        f32x2 dmy[32];
        bar(); fwd12(X, tid); pass3<1>(X, tid, KFc, 1.f); inv21(X, tid, dmy);
#pragma unroll
        for (int q = 0; q < 32; ++q) asm volatile("" :: "v"(dmy[q].x), "v"(dmy[q].y));
        bar();
    }
#endif
    f32x2 a[32];
    { const float w0 = cw[c], w1 = cw[768 + c], w2 = cw[1536 + c], wb = cb[c];
      bar(); stage_row(lds, PTV + (size_t)c * MT, tid); bar();
      const int t0 = opaque(tid);
#pragma unroll
      for (int q0 = 0; q0 < 32; q0 += 8) {
#pragma unroll
          for (int q = q0; q < q0 + 8; ++q) a[q] = conv3_lds((const LAS bf16_t*)lds, t0 + 512 * q, w0, w1, w2, wb);
          asm volatile("" ::: "memory"); }
      bar(); }
#pragma unroll 1
    for (int order = 0; order < 2; ++order) {
        const spec_t* Ke = KFc + (size_t)order * ostride; const spec_t* Ko = Ke + L;
        { const int t1 = opaque(tid);
#pragma unroll
          for (int q = 0; q < 32; ++q) { const unsigned zp = pg8::cvt_pk_bf16(a[q].x, a[q].y); Zs[t1 + 512 * q] = zp; X[p0 + 560 * q] = (f32x2){bf2f(zp & 0xffffu), bf2f(zp >> 16)}; } }
        bar();
#ifdef MK_HY_PM
        if (!(pm & 2))
#endif
        { fwd12(X, tid); pass3<1>(X, tid, const_cast<spec_t*>(Ke), 1.f); inv21(X, tid, a); }
        { const int t2 = opaque(tid);
#pragma unroll
          for (int q = 0; q < 32; ++q) Rs[t2 + 512 * q] = pg8::cvt_pk_bf16(a[q].x, a[q].y); }
        asm volatile("" ::: "memory");
        const int t3 = opaque(tid); const f32x2 base1 = expi(-(float)t3 * (1.0f / 16384.0f));
#pragma unroll
        for (int q = 0; q < 32; ++q) { const unsigned zp = Zs[t3 + 512 * q]; a[q] = (f32x2){bf2f(zp & 0xffffu), bf2f(zp >> 16)}; }
#pragma unroll
        for (int q = 0; q < 32; ++q) X[p0 + 560 * q] = cmul(a[q], wN(base1, q));
        bar();
#ifdef MK_HY_PM
        if (!(pm & 2))
#endif
        { fwd12(X, tid); pass3<1>(X, tid, const_cast<spec_t*>(Ko), 1.f); inv21(X, tid, a); }
        const int grow = (order == 0 ? 256 : 512) + c;
        const float g0 = cw[grow], g1 = cw[768 + grow], g2 = cw[1536 + grow], gb = cb[grow], hb = hbias[order * 256 + c];
        { const int t4 = opaque(tid); const f32x2 base2 = expi(-(float)t4 * (1.0f / 16384.0f));
#pragma unroll
          for (int q0 = 0; q0 < 32; q0 += 16) { unsigned r1p[16];
#pragma unroll
              for (int q = 0; q < 16; ++q) r1p[q] = Rs[t4 + 512 * (q0 + q)];
#pragma unroll
              for (int q = 0; q < 16; ++q) a[q0 + q] = (f32x2){bf2f(r1p[q] & 0xffffu), bf2f(r1p[q] >> 16)} + cmulc(a[q0 + q], wN(base2, q0 + q));
              asm volatile("" ::: "memory"); } }
        bar();
        stage_row(lds, PTV + (size_t)grow * MT, tid);
        bar();
        { const int t5 = opaque(tid);
#pragma unroll
          for (int q0 = 0; q0 < 32; q0 += 16) { unsigned zqp[16];
#pragma unroll
              for (int q = 0; q < 16; ++q) zqp[q] = Zs[t5 + 512 * (q0 + q)];
#pragma unroll
              for (int q = 0; q < 16; ++q) { const f32x2 gt = conv3_lds((const LAS bf16_t*)lds, t5 + 512 * (q0 + q), g0, g1, g2, gb);
                  a[q0 + q] = (f32x2){gt.x * (a[q0 + q].x * (1.0f / (float)N2) + hb * bf2f(zqp[q] & 0xffffu)), gt.y * (a[q0 + q].y * (1.0f / (float)N2) + hb * bf2f(zqp[q] >> 16))}; }
              asm volatile("" ::: "memory"); } }
        bar();
    }
#ifdef MK_HY_PM
    if (!(pm & 1))
#endif
    { bf16_t* yp = YMIX + (size_t)tid * D + c;
#pragma unroll
      for (int q = 0; q < 32; ++q) { { const unsigned pw_ = pg8::cvt_pk_bf16(a[q].x, a[q].y); yp[0] = (bf16_t)(pw_ & 0xffffu); yp[(size_t)SEQ * D] = (bf16_t)(pw_ >> 16); } yp += (size_t)512 * D; asm volatile("" : "+v"(yp)); } }
}
}

constexpr int MK_LDS_BYTES = 147456;
static_assert(fft::LDS_RED + 64 <= MK_LDS_BYTES, "LDS map");
namespace lru {
constexpr int TC = 64, NCH = 260, NSU = 130;
constexpr int RS = 264, RSB = RS * 2;
constexpr int XR_OFF = 0, XR_BYTES = (TC + 3) * RSB;
constexpr int XG_OFF = XR_OFF + XR_BYTES;
constexpr int HY_OFF = XG_OFF + TC * RSB;
constexpr int CW_OFF = HY_OFF + TC * RSB;
constexpr int CAR_OFF = CW_OFF + 5 * 1024;
constexpr int U_OFF = CAR_OFF + 4 * 1024;
constexpr int LDS_END = U_OFF + TC * RSB;
static_assert(LDS_END <= 147456 - 64 && (U_OFF % 16) == 0 && (XG_OFF % 16) == 0 && (HY_OFF % 16) == 0 && (CW_OFF % 16) == 0, "lru LDS map");
constexpr float LOG2E = 1.4426950408889634f;
struct Params {
    const bf16_t* QKL; const bf16_t* LW;
    const float *cw, *cb, *ba, *bi, *lam;
    f32x2* AGG;
    bf16_t* YMIX;
};
__device__ __forceinline__ int chunk_row0(int b, int k) { return k < 4 ? NLAT + b * CTXL + 64 * k : b * SEQ + 64 * (k - 4); }
__device__ __forceinline__ float fsig(float x) { return __builtin_amdgcn_rcpf(1.0f + __builtin_amdgcn_exp2f(-LOG2E * x)); }

struct LaneConst { int ch[2]; };
struct DirConst { bf16x8 Bf[2][2][2]; float ba[2], bi[2], sp2[2]; };
__device__ __forceinline__ void load_dir(const Params& P, int dir, int n, int hf, int l15, int kg, const LaneConst& lc, DirConst& dc) {
#pragma unroll
    for (int ty = 0; ty < 2; ++ty)
#pragma unroll
        for (int cc = 0; cc < 2; ++cc)
#pragma unroll
            for (int ks = 0; ks < 2; ++ks) dc.Bf[ty][cc][ks] = *(const bf16x8*)(P.LW + ((((size_t)dir * 4 + n) * 2 + ty) * 64 + 32 * hf + 16 * cc + l15) * 64 + 32 * ks + 8 * kg);
#pragma unroll
    for (int cc = 0; cc < 2; ++cc) { dc.ba[cc] = P.ba[dir * 256 + lc.ch[cc]]; dc.bi[cc] = P.bi[dir * 256 + lc.ch[cc]]; dc.sp2[cc] = -8.0f * LOG2E * log1pf(expf(-P.lam[dir * 256 + lc.ch[cc]])); }
}
template <bool FINAL, int DIR>
__device__ __forceinline__ void tile_dir(LAS unsigned char* lds, const LaneConst& lc, const DirConst& dc, int n, int lane, int ss, LAS bf16_t* Hs, float (&car)[2], float (&Pm)[2], float (&Qm)[2]) {
    const int l15 = lane & 15, kg = lane >> 4;
    const LAS bf16_t* UU = (const LAS bf16_t*)(lds + U_OFF);
    bf16x8 Af[2];
#pragma unroll
    for (int ks = 0; ks < 2; ++ks) Af[ks] = *(const LAS bf16x8*)(UU + (16 * ss + l15) * RS + 64 * n + 32 * ks + 8 * kg);
#pragma unroll
    for (int cc = 0; cc < 2; ++cc) {
        f32x4 ar = (f32x4){0.f, 0.f, 0.f, 0.f}, ai = ar;
        ar = __builtin_amdgcn_mfma_f32_16x16x32_bf16(Af[0], dc.Bf[0][cc][0], ar, 0, 0, 0); ar = __builtin_amdgcn_mfma_f32_16x16x32_bf16(Af[1], dc.Bf[0][cc][1], ar, 0, 0, 0);
        ai = __builtin_amdgcn_mfma_f32_16x16x32_bf16(Af[0], dc.Bf[1][cc][0], ai, 0, 0, 0); ai = __builtin_amdgcn_mfma_f32_16x16x32_bf16(Af[1], dc.Bf[1][cc][1], ai, 0, 0, 0);
        const int ch = lc.ch[cc];
        float av[4], bv[4];
#pragma unroll
        for (int rg = 0; rg < 4; ++rg) { const int r = 16 * ss + 4 * kg + rg;
            const float u = bf2f(UU[r * RS + ch]);
            const float rgt = fsig(ar[rg] + dc.ba[cc]), igt = fsig(ai[rg] + dc.bi[cc]);
            const float x2 = rgt * dc.sp2[cc]; const float a = __builtin_amdgcn_exp2f(x2), a2 = a * a;
            av[rg] = a; bv[rg] = __builtin_amdgcn_sqrtf(fmaxf(1.0f - a2, 0.f)) * (igt * u); }
        float Pl = 1.f, Ql = 0.f;
#pragma unroll
        for (int i = 0; i < 4; ++i) { const int rg = DIR == 0 ? i : 3 - i; Ql = av[rg] * Ql + bv[rg]; Pl *= av[rg]; }
        const int pos = DIR == 0 ? kg : 3 - kg;
        { const int src = DIR == 0 ? lane - 16 : lane + 16; const float Pp = __shfl(Pl, src), Qp = __shfl(Ql, src); if (pos >= 1) { Ql = Pl * Qp + Ql; Pl = Pl * Pp; } }
        { const int src = DIR == 0 ? lane - 32 : lane + 32; const float Pp = __shfl(Pl, src), Qp = __shfl(Ql, src); if (pos >= 2) { Ql = Pl * Qp + Ql; Pl = Pl * Pp; } }
        const int lastsrc = DIR == 0 ? l15 + 48 : l15;
        const float Pt = __shfl(Pl, lastsrc), Qt = __shfl(Ql, lastsrc);
        if (FINAL) {
            const int src = DIR == 0 ? lane - 16 : lane + 16; float Pe = __shfl(Pl, src), Qe = __shfl(Ql, src); if (pos == 0) { Pe = 1.f; Qe = 0.f; }
            float h = Pe * car[cc] + Qe;
#pragma unroll
            for (int i = 0; i < 4; ++i) { const int rg = DIR == 0 ? i : 3 - i; h = av[rg] * h + bv[rg]; Hs[(16 * ss + 4 * kg + rg) * RS + ch] = (bf16_t)pg8::cvt_pk_bf16(h, h); }
            car[cc] = Pt * car[cc] + Qt;
        } else { Qm[cc] = Pt * Qm[cc] + Qt; Pm[cc] = Pt * Pm[cc]; }
    }
}
__device__ __forceinline__ void load_chunk(LAS unsigned char* lds, const Params& P, int b, int k, bool with_xg, int tid) {
    const int Ls = k < 4 ? CTXL : SEQ, kk = k < 4 ? k : k - 4, seq0 = k < 4 ? NLAT + b * CTXL : b * SEQ, t0 = 64 * kk - 2;
    {   u32x4 vr[5];
#pragma unroll
        for (int i5 = 0; i5 < 5; ++i5) { const int e = tid + 512 * i5, i = e >> 5, cchunk = e & 31, t = t0 + i;
            vr[i5] = (u32x4){0u, 0u, 0u, 0u};
            if (e < (TC + 3) * 32 && t >= 0 && t < Ls) vr[i5] = *(const u32x4*)(P.QKL + (size_t)(seq0 + t) * NQKL + 1024 + 8 * cchunk); }
#pragma unroll
        for (int i5 = 0; i5 < 5; ++i5) { const int e = tid + 512 * i5, i = e >> 5, cchunk = e & 31; if (e < (TC + 3) * 32) *(LAS u32x4*)(lds + XR_OFF + i * RSB + cchunk * 16) = vr[i5]; }
        asm volatile("" ::: "memory"); }
    if (with_xg) { u32x4 vg[4];
#pragma unroll
        for (int i4 = 0; i4 < 4; ++i4) { const int e = tid + 512 * i4, i = e >> 5, cchunk = e & 31; vg[i4] = *(const u32x4*)(P.QKL + (size_t)(seq0 + 64 * kk + i) * NQKL + 1280 + 8 * cchunk); }
#pragma unroll
        for (int i4 = 0; i4 < 4; ++i4) { const int e = tid + 512 * i4, i = e >> 5, cchunk = e & 31; *(LAS u32x4*)(lds + XG_OFF + i * RSB + cchunk * 16) = vg[i4]; }
    }
}
template <bool FINAL>
__device__ __forceinline__ void super_unit(LAS unsigned char* lds, const Params& P, int su) {
    const int tid = opaque_i(threadIdx.x), lane = tid & 63, wid = tid >> 6, n = wid >> 1, hf = wid & 1, l15 = lane & 15, kg = lane >> 4;
    const bool isctx = su >= 256; const int b = isctx ? (su - 256) >> 2 : su >> 7, s = isctx ? ((su - 256) & 3) >> 1 : 2 + (su & 127), k0 = isctx ? (su - 256) & 3 : 2 * s, nchk = isctx ? 1 : 2;
    LAS float* CW = (LAS float*)(lds + CW_OFF); LAS float* CAR = (LAS float*)(lds + CAR_OFF);
    f32x2* AGG64 = P.AGG; f32x2* AGG128 = P.AGG + (size_t)2 * NCH * 2 * 256;
    __syncthreads();
    for (int e = tid; e < 5 * 256; e += 512) CW[e] = e < 1024 ? P.cw[e] : P.cb[e - 1024];
    if (FINAL) {
        const int dir = tid >> 8, ch = tid & 255;
        const f32x2* a64 = AGG64 + ((size_t)b * NCH * 2 + dir) * 256 + ch;
        const f32x2* a128 = AGG128 + ((size_t)b * NSU * 2 + dir) * 256 + ch;
        const int nc = isctx ? (dir == 0 ? k0 : 3 - k0) : 4;
        const int npos = nc + (isctx ? 0 : (dir == 0 ? s - 2 : 129 - s));
        float h = 0.f;
#pragma unroll 1
        for (int p0 = 0; p0 < 132; p0 += 33) {
            if (p0 >= npos) break;
            f32x2 v[33];
#pragma unroll
            for (int i = 0; i < 33; ++i) { const int p = p0 + i, pc = p < npos ? p : 0;
                const f32x2* src = pc < nc ? a64 + (size_t)(dir == 0 ? pc : 3 - pc) * 512 : a128 + (size_t)(dir == 0 ? 2 + (pc - nc) : 129 - (pc - nc)) * 512;
                v[i] = *src; }
#pragma unroll
            for (int i = 0; i < 33; ++i) { const bool live = p0 + i < npos; h = (live ? v[i].x : 1.f) * h + (live ? v[i].y : 0.f); }
        }
        if (dir == 0) CAR[0 * 512 + ch] = h;
        else if (isctx) CAR[0 * 512 + 256 + ch] = h;
        else { CAR[1 * 512 + 256 + ch] = h; const f32x2 v = AGG64[(((size_t)b * NCH + k0 + 1) * 2 + 1) * 256 + ch]; CAR[0 * 512 + 256 + ch] = v.x * h + v.y; }
    }
    LaneConst lc;
#pragma unroll
    for (int cc = 0; cc < 2; ++cc) lc.ch[cc] = 64 * n + 32 * hf + 16 * cc + l15;
    float car0[2] = {0.f, 0.f};
    float P0m[2][2], Q0m[2][2];
#pragma unroll 1
    for (int j = 0; j < nchk; ++j) {
        const int k = k0 + j, row0 = chunk_row0(b, k);
        if (j > 0) __syncthreads();
#ifdef MK_LRU_XL
        if (!FINAL) for (int xl_ = 0; xl_ < MK_LRU_XL; ++xl_) { load_chunk(lds, P, b, k, FINAL, tid); __syncthreads(); }
#endif
        load_chunk(lds, P, b, k, FINAL, tid);
        __syncthreads();
        {
            const int cg8 = 8 * (tid & 31); const LAS float* CWr = (const LAS float*)(lds + CW_OFF); const LAS bf16_t* XRr = (const LAS bf16_t*)(lds + XR_OFF);
            f32x4 wl[5], wh[5];
#pragma unroll
            for (int kx = 0; kx < 5; ++kx) { wl[kx] = *(const LAS f32x4*)(CWr + kx * 256 + cg8); wh[kx] = *(const LAS f32x4*)(CWr + kx * 256 + cg8 + 4); }
#pragma unroll
            for (int i = 0; i < 4; ++i) { const int tok = (tid >> 5) + 16 * i; f32x4 lo = wl[4], hi = wh[4];
#pragma unroll
                for (int kx = 0; kx < 4; ++kx) { const u32x4 xw = *(const LAS u32x4*)(XRr + (tok + kx) * RS + cg8);
                    lo[0] += wl[kx][0] * bf2f(xw.x & 0xffffu); lo[1] += wl[kx][1] * bf2f(xw.x >> 16); lo[2] += wl[kx][2] * bf2f(xw.y & 0xffffu); lo[3] += wl[kx][3] * bf2f(xw.y >> 16);
                    hi[0] += wh[kx][0] * bf2f(xw.z & 0xffffu); hi[1] += wh[kx][1] * bf2f(xw.z >> 16); hi[2] += wh[kx][2] * bf2f(xw.w & 0xffffu); hi[3] += wh[kx][3] * bf2f(xw.w >> 16); }
                u32x4 pw; pw.x = pg8::cvt_pk_bf16(lo[0], lo[1]); pw.y = pg8::cvt_pk_bf16(lo[2], lo[3]); pw.z = pg8::cvt_pk_bf16(hi[0], hi[1]); pw.w = pg8::cvt_pk_bf16(hi[2], hi[3]);
                *(LAS u32x4*)(lds + U_OFF + tok * RSB + cg8 * 2) = pw; }
        }
        __syncthreads();
        {
            float carF[2], carR[2], PmF[2] = {1.f, 1.f}, QmF[2] = {0.f, 0.f}, PmR[2] = {1.f, 1.f}, QmR[2] = {0.f, 0.f};
            if (FINAL) {
#pragma unroll
                for (int cc = 0; cc < 2; ++cc) { carF[cc] = j == 1 ? car0[cc] : CAR[0 * 256 + lc.ch[cc]]; carR[cc] = CAR[j * 512 + 256 + lc.ch[cc]]; }
            } else { carF[0] = carF[1] = carR[0] = carR[1] = 0.f; }
            LAS bf16_t* H0 = (LAS bf16_t*)(lds + HY_OFF); LAS bf16_t* H1 = (LAS bf16_t*)(lds + XR_OFF);
            {   DirConst dc0, dc1; load_dir(P, 0, n, hf, l15, kg, lc, dc0); load_dir(P, 1, n, hf, l15, kg, lc, dc1);
#ifdef MK_LRU_XS
                if (!FINAL) for (int xs_ = 0; xs_ < MK_LRU_XS; ++xs_) { float c1_[2] = {0.f, 0.f}, c2_[2] = {0.f, 0.f}, p1_[2] = {1.f, 1.f}, q1_[2] = {0.f, 0.f}, p2_[2] = {1.f, 1.f}, q2_[2] = {0.f, 0.f};
#pragma unroll 1
                    for (int sx = 0; sx < 4; ++sx) { tile_dir<false, 0>(lds, lc, dc0, n, lane, sx, H0, c1_, p1_, q1_); tile_dir<false, 1>(lds, lc, dc1, n, lane, 3 - sx, H1, c2_, p2_, q2_); }
                    asm volatile("" :: "v"(p1_[0]), "v"(q1_[0]), "v"(p2_[1]), "v"(q2_[1])); }
#endif
#pragma unroll 1
                for (int sx = 0; sx < 4; ++sx) { tile_dir<FINAL, 0>(lds, lc, dc0, n, lane, sx, H0, carF, PmF, QmF); tile_dir<FINAL, 1>(lds, lc, dc1, n, lane, 3 - sx, H1, carR, PmR, QmR); } }
            if (FINAL) { car0[0] = carF[0]; car0[1] = carF[1]; }
            else {
#pragma unroll
                for (int cc = 0; cc < 2; ++cc) {
                    if (kg == 0) { AGG64[(((size_t)b * NCH + k) * 2 + 0) * 256 + lc.ch[cc]] = (f32x2){PmF[cc], QmF[cc]}; AGG64[(((size_t)b * NCH + k) * 2 + 1) * 256 + lc.ch[cc]] = (f32x2){PmR[cc], QmR[cc]}; }
                    if (j == 0) { P0m[0][cc] = PmF[cc]; Q0m[0][cc] = QmF[cc]; P0m[1][cc] = PmR[cc]; Q0m[1][cc] = QmR[cc]; }
                    else if (kg == 0) {
                        AGG128[(((size_t)b * NSU + s) * 2 + 0) * 256 + lc.ch[cc]] = (f32x2){P0m[0][cc] * PmF[cc], PmF[cc] * Q0m[0][cc] + QmF[cc]};
                        AGG128[(((size_t)b * NSU + s) * 2 + 1) * 256 + lc.ch[cc]] = (f32x2){P0m[1][cc] * PmR[cc], P0m[1][cc] * QmR[cc] + Q0m[1][cc]}; }
                }
            }
        }
        if (FINAL) {
            __syncthreads();
            for (int e = tid; e < TC * 32; e += 512) { const int i = e >> 5, cchunk = e & 31;
                const u32x4 hf4 = *(const LAS u32x4*)(lds + HY_OFF + i * RSB + cchunk * 16), hr4 = *(const LAS u32x4*)(lds + XR_OFF + i * RSB + cchunk * 16), xg4 = *(const LAS u32x4*)(lds + XG_OFF + i * RSB + cchunk * 16);
                u32x4 o;
#pragma unroll
                for (int w2 = 0; w2 < 4; ++w2) { float y2[2];
#pragma unroll
                    for (int hh = 0; hh < 2; ++hh) { const float hs = bf2f(hh ? hf4[w2] >> 16 : hf4[w2] & 0xffffu) + bf2f(hh ? hr4[w2] >> 16 : hr4[w2] & 0xffffu), xg = bf2f(hh ? xg4[w2] >> 16 : xg4[w2] & 0xffffu);
                        y2[hh] = hs * (xg * fsig(1.5957691216057308f * (xg + 0.044715f * xg * xg * xg))); }
                    o[w2] = pg8::cvt_pk_bf16(y2[0], y2[1]); }
                *(u32x4*)(P.YMIX + (size_t)(row0 + i) * D + 768 + 8 * cchunk) = o; }
        }
    }
}
}
namespace na {
constexpr float LOG2E = 1.4426950408889634f, QSCALE = 0.125f * LOG2E;
constexpr int KC_OFF = 0, VC_OFF = 32768;
constexpr int KL_OFF = 0, VL_OFF = 61440, RPB_OFF = 122880;
constexpr int LDS_END = RPB_OFF + 15 * 32 * 4;
static_assert(LDS_END <= 147456, "na LDS map");
struct Params { const bf16_t* QKL; const bf16_t* VT; const float* rpb; bf16_t* YMIX; };

struct RowState { f32x4 o[4]; float m, l; };
template <bool LOCAL>
__device__ __forceinline__ void chunk(LAS unsigned char* lds, RowState& st, const bf16x8 (&Qf)[2], int kbase, int kstride_pair, int vbase, int lane, int cq, int drbase, int kc0) {
    const int l15 = lane & 15, kg = lane >> 4;
    f32x4 S[8];
#pragma unroll
    for (int t = 0; t < 8; ++t) {
        const int krow = LOCAL ? (kbase + (t >> 1) * kstride_pair + (t & 1) * 16 * 128) : (kbase + t * 16 * 128);
        const int ka = krow + l15 * 128;
        const bf16x8 k0 = *(const LAS bf16x8*)(lds + ka + (((0 + kg) ^ (l15 & 7)) << 4));
        const bf16x8 k1 = *(const LAS bf16x8*)(lds + ka + (((4 + kg) ^ (l15 & 7)) << 4));
        f32x4 s = (f32x4){0.f, 0.f, 0.f, 0.f};
        s = __builtin_amdgcn_mfma_f32_16x16x32_bf16(k0, Qf[0], s, 0, 0, 0);
        s = __builtin_amdgcn_mfma_f32_16x16x32_bf16(k1, Qf[1], s, 0, 0, 0);
        S[t] = s;
    }
    int bidx[2][4];
    if (LOCAL) {
        const int start = min(max(cq - 8, 0), GRIDW - 16);
#pragma unroll
        for (int hh = 0; hh < 2; ++hh)
#pragma unroll
            for (int rg = 0; rg < 4; ++rg) { const int kcol = kc0 + 16 * hh + 4 * kg + rg; const bool valid = (kcol >= start) && (kcol < start + 16); bidx[hh][rg] = RPB_OFF + (drbase * 32 + (valid ? kcol - cq + 15 : 31)) * 4; }
    }
    float mx = -3.0e38f;
#pragma unroll
    for (int t = 0; t < 8; ++t) {
        if (LOCAL) {
#pragma unroll
            for (int rg = 0; rg < 4; ++rg) S[t][rg] = __builtin_fmaf(S[t][rg], QSCALE, *(const LAS float*)(lds + bidx[t & 1][rg] + (t >> 1) * 128));
        }
        mx = fmaxf(mx, fmaxf(fmaxf(S[t][0], S[t][1]), fmaxf(S[t][2], S[t][3])));
    }
    if (!LOCAL) mx *= QSCALE;
    mx = fmaxf(mx, __shfl_xor(mx, 16)); mx = fmaxf(mx, __shfl_xor(mx, 32));
    const float mn = fmaxf(st.m, mx), alpha = __builtin_amdgcn_exp2f(st.m - mn);
    st.m = mn; st.l *= alpha;
#pragma unroll
    for (int dt = 0; dt < 4; ++dt) st.o[dt] *= alpha;
    float ls = 0.f;
#pragma unroll
    for (int t = 0; t < 8; ++t)
#pragma unroll
        for (int rg = 0; rg < 4; ++rg) { const float p = __builtin_amdgcn_exp2f(LOCAL ? S[t][rg] - mn : __builtin_fmaf(S[t][rg], QSCALE, -mn)); S[t][rg] = p; ls += p; }
    st.l += ls;
#pragma unroll
    for (int j = 0; j < 4; ++j) {
        u32x4 pw; pw.x = pg8::cvt_pk_bf16(S[2 * j][0], S[2 * j][1]); pw.y = pg8::cvt_pk_bf16(S[2 * j][2], S[2 * j][3]); pw.z = pg8::cvt_pk_bf16(S[2 * j + 1][0], S[2 * j + 1][1]); pw.w = pg8::cvt_pk_bf16(S[2 * j + 1][2], S[2 * j + 1][3]);
        const bf16x8 Pf = __builtin_bit_cast(bf16x8, pw);
        const int vgb = vbase + j * 4096;
#pragma unroll
        for (int dt = 0; dt < 4; ++dt) { const int d = 16 * dt + l15, x = 2 * ((d >> 2) & 3);
            const u32x2 v0 = *(const LAS u32x2*)(lds + vgb + d * 64 + (((0 + kg) ^ x) << 3));
            const u32x2 v1 = *(const LAS u32x2*)(lds + vgb + d * 64 + (((4 + kg) ^ x) << 3));
            const u32x4 vw = (u32x4){v0.x, v0.y, v1.x, v1.y};
            st.o[dt] = __builtin_amdgcn_mfma_f32_16x16x32_bf16(__builtin_bit_cast(bf16x8, vw), Pf, st.o[dt], 0, 0, 0); }
    }
}
__device__ __forceinline__ void glds16(const void* g, LAS unsigned char* l) { __builtin_amdgcn_global_load_lds((const unsigned*)g, (LAS unsigned*)l, 16, 0, 0); }
__device__ __forceinline__ void stage_ctx(LAS unsigned char* lds, const Params& P, int b, int h) {
    const int tids = opaque_i(threadIdx.x), wv = __builtin_amdgcn_readfirstlane(tids >> 6), lane = tids & 63;
#pragma unroll
    for (int it = 0; it < 4; ++it) { const int e = (it * 8 + wv) * 64 + lane, key = e >> 3, c = (e & 7) ^ (key & 7);
        glds16(P.QKL + (size_t)(NLAT + b * CTXL + key) * NQKL + 512 + h * 64 + 8 * c, lds + KC_OFF + (it * 8 + wv) * 1024); }
#pragma unroll
    for (int it = 0; it < 4; ++it) { const int e = (it * 8 + wv) * 64 + lane, g32 = e >> 8, d = (e >> 2) & 63, j8l = (e & 3) ^ ((d >> 2) & 3);
        glds16(P.VT + (size_t)(h * 64 + d) * MT + NLAT + b * CTXL + 32 * g32 + 8 * j8l, lds + VC_OFF + (it * 8 + wv) * 1024); }
}
__device__ __forceinline__ void load_q(const Params& P, int row, int h, int lane, bf16x8 (&Qf)[2]) {
    const bf16_t* qp = P.QKL + (size_t)row * NQKL + h * 64 + 8 * (lane >> 4);
    Qf[0] = *(const bf16x8*)(qp); Qf[1] = *(const bf16x8*)(qp + 32);
}
__device__ __forceinline__ void finish_row(const Params& P, RowState& st, int row, int h, int lane) {
    float l = st.l; l += __shfl_xor(l, 16); l += __shfl_xor(l, 32);
    const float inv = 1.0f / l;
    bf16_t* op = P.YMIX + (size_t)row * D + 256 + h * 64 + 4 * (lane >> 4);
#pragma unroll
    for (int dt = 0; dt < 4; ++dt) { const f32x4 o = st.o[dt] * inv; u32x2 w; w.x = pg8::cvt_pk_bf16(o[0], o[1]); w.y = pg8::cvt_pk_bf16(o[2], o[3]); *(u32x2*)(op + 16 * dt) = w; }
}
__device__ __forceinline__ void init_row(RowState& st) {
#pragma unroll
    for (int dt = 0; dt < 4; ++dt) st.o[dt] = (f32x4){0.f, 0.f, 0.f, 0.f};
    st.m = -1.0e30f; st.l = 0.f;
}
__device__ __forceinline__ void latent_unit(LAS unsigned char* lds, const Params& P, int u, int pm = 0) {
    const int b = u >> 8, h = (u >> 5) & 7, n = (u >> 3) & 3, rr = u & 7, r0 = 32 * rr;
    const int tid = opaque_i(threadIdx.x), lane = tid & 63, w = tid >> 6, l15 = lane & 15;
    const int kc0 = n == 0 ? 0 : (n == 1 ? 8 : (n == 2 ? 24 : 32)), cq = 16 * n + l15;
    __syncthreads();
    stage_ctx(lds, P, b, h);
    __syncthreads();
    RowState st[4]; bf16x8 Qf[2][2];
    load_q(P, b * SEQ + (r0 + w) * GRIDW + cq, h, lane, Qf[0]);
#pragma unroll
    for (int g = 0; g < 4; ++g) { init_row(st[g]);
        load_q(P, b * SEQ + (r0 + 8 * ((g + 1) & 3) + w) * GRIDW + cq, h, lane, Qf[(g + 1) & 1]);
#pragma unroll 1
        for (int cc = 0; cc < 2; ++cc) {
#ifdef MK_NA_PM
            if (pm & 2) continue;
#endif
            chunk<false>(lds, st[g], Qf[g & 1], KC_OFF + cc * 128 * 128, 0, VC_OFF + cc * 4 * 4096, lane, 0, 0, 0); } }
    __syncthreads();
    for (int e = tid; e < 15 * 32; e += 512) { const int dr = e >> 5, dc = e & 31; *(LAS float*)(lds + RPB_OFF + e * 4) = dc < 31 ? P.rpb[(h * 15 + dr) * 31 + dc] * LOG2E : -1.0e30f; }
#pragma unroll
    for (int g = 0; g < 4; ++g) {
        const int rg0 = r0 + 8 * g, lo = max(rg0 - 4, 0), hi = min(rg0 + 10, GROWS - 1), nrows = hi - lo + 1;
        if (g > 0) __syncthreads();
        { const int wv = __builtin_amdgcn_readfirstlane(tid >> 6);
          for (int it = 0; it < nrows / 2; ++it) { const int e = (it * 8 + wv) * 64 + lane, key = e >> 3, kr = key >> 5, col = key & 31, c = (e & 7) ^ (key & 7);
              glds16(P.QKL + (size_t)(b * SEQ + (lo + kr) * GRIDW + kc0 + col) * NQKL + 512 + h * 64 + 8 * c, lds + KL_OFF + (it * 8 + wv) * 1024); }
          for (int it = 0; it < nrows / 2; ++it) { const int e = (it * 8 + wv) * 64 + lane, kr = e >> 8, d = (e >> 2) & 63, j8 = (e & 3) ^ ((d >> 2) & 3);
              glds16(P.VT + (size_t)(h * 64 + d) * MT + b * SEQ + (lo + kr) * GRIDW + kc0 + 8 * j8, lds + VL_OFF + (it * 8 + wv) * 1024); }
          if (nrows & 1) {
              const int it = nrows / 2;
              if (wv < 4) { const int e = (it * 8 + wv) * 64 + lane, key = e >> 3, kr = key >> 5, col = key & 31, c = (e & 7) ^ (key & 7);
                  glds16(P.QKL + (size_t)(b * SEQ + (lo + kr) * GRIDW + kc0 + col) * NQKL + 512 + h * 64 + 8 * c, lds + KL_OFF + (it * 8 + wv) * 1024);
                  const int e2 = e, kr2 = e2 >> 8, d = (e2 >> 2) & 63, j8 = (e2 & 3) ^ ((d >> 2) & 3);
                  glds16(P.VT + (size_t)(h * 64 + d) * MT + b * SEQ + (lo + kr2) * GRIDW + kc0 + 8 * j8, lds + VL_OFF + (it * 8 + wv) * 1024); } } }
        __syncthreads();
        const int r = rg0 + w, rs = min(max(r - 4, 0), GROWS - 8), row = b * SEQ + r * GRIDW + cq;
        if (g < 3) load_q(P, b * SEQ + (r0 + 8 * (g + 1) + w) * GRIDW + cq, h, lane, Qf[(g + 1) & 1]);
#pragma unroll 1
        for (int cc = 0; cc < 2; ++cc) { const int krel = rs - lo + 4 * cc;
#ifdef MK_NA_PM
            if (pm & 4) continue;
#endif
            chunk<true>(lds, st[g], Qf[g & 1], KL_OFF + krel * 32 * 128, 32 * 128, VL_OFF + krel * 4096, lane, cq, rs + 4 * cc - r + 7, kc0); }
        finish_row(P, st[g], row, h, lane);
    }
}
__device__ __forceinline__ void ctx_unit(LAS unsigned char* lds, const Params& P, int u) {
    const int b = u >> 4, h = (u >> 1) & 7, half = u & 1, tidc = opaque_i(threadIdx.x), lane = tidc & 63, w = tidc >> 6;
    __syncthreads();
    stage_ctx(lds, P, b, h);
    __syncthreads();
    RowState st; bf16x8 Qf[2]; init_row(st);
    const int row = NLAT + b * CTXL + 128 * half + 16 * w + (lane & 15);
    load_q(P, row, h, lane, Qf);
#pragma unroll 1
    for (int cc = 0; cc < 2; ++cc) chunk<false>(lds, st, Qf, KC_OFF + cc * 128 * 128, 0, VC_OFF + cc * 4 * 4096, lane, 0, 0, 0);
    finish_row(P, st, row, h, lane);
}
}

#include <hip/hip_cooperative_groups.h>
namespace cg = cooperative_groups;
constexpr int NPHASE = 2 + 8 * DEPTH;
constexpr int FEARLY = 496;

struct MKArgs { const float* in[31]; float* out; unsigned char* ws; int ph_lo, ph_hi; };

#define XB_TMO      128
#define XB_XCNT(j)  (256  + 64 * (j))
#define XB_XSUB(j)  (1280 + 64 * (j))
#define XB_XGEN(j)  (2304 + 64 * (j))
#define XB_TOP      3328
#define XB_TOPGEN   3392
#define XCD_BAR_WORDS 3456
#define XB_SPIN_CAP (1u << 22)

__device__ __forceinline__ unsigned xb_ld(unsigned* p)              { return __hip_atomic_load(p, __ATOMIC_RELAXED, __HIP_MEMORY_SCOPE_AGENT); }
__device__ __forceinline__ unsigned xb_add(unsigned* p, unsigned v) { return __hip_atomic_fetch_add(p, v, __ATOMIC_RELAXED, __HIP_MEMORY_SCOPE_AGENT); }
__device__ __forceinline__ unsigned xb_xcc_id() { return (unsigned)__builtin_amdgcn_s_getreg((3 << 11) | 20) & 0xFu; }
#define XB_SPIN(cond, bar) do { unsigned _sp = 0; while (cond) { __builtin_amdgcn_s_sleep(1); \
    if ((++_sp & 255u) == 0u) { if (xb_ld(&(bar)[XB_TMO])) break; if (_sp > XB_SPIN_CAP) { atomicAdd(&(bar)[XB_TMO], 1u); break; } } } } while (0)

struct XcdBarrier {
    unsigned* bar; unsigned x;
    volatile LAS unsigned* st;
};

__device__ __forceinline__ XcdBarrier xcd_barrier_post(unsigned* bar, volatile LAS unsigned* st) {
    XcdBarrier b; b.bar = bar; b.x = xb_xcc_id(); b.st = st;
    if (threadIdx.x == 0) (void)xb_add(&bar[XB_XCNT(b.x)], 1u);
    return b;
}
__device__ __forceinline__ void xcd_barrier_complete(unsigned* bar, unsigned x, unsigned& nloc, unsigned& nx) {
    const unsigned G = gridDim.x * gridDim.y * gridDim.z;
    unsigned sum, cnt, mine, sp = 0u;
    for (;;) {
        sum = 0u; cnt = 0u; mine = 0u;
#pragma unroll
        for (unsigned j = 0; j < 16; ++j) { const unsigned c = xb_ld(&bar[XB_XCNT(j)]); sum += c; cnt += (c > 0u) ? 1u : 0u; mine = (j == x) ? c : mine; }
        if (sum == G) break;
        __builtin_amdgcn_s_sleep(1);
        if ((++sp & 255u) == 0u) { if (xb_ld(&bar[XB_TMO])) break; if (sp > XB_SPIN_CAP) { atomicAdd(&bar[XB_TMO], 1u); break; } }
    }
    nloc = mine > 0u ? mine : 1u; nx = cnt > 0u ? cnt : 1u;
}

__device__ __forceinline__ void xcd_barrier(const XcdBarrier& b) {
    asm volatile("s_waitcnt vmcnt(0)" ::: "memory");
    __syncthreads();
    if (threadIdx.x == 0) {
        unsigned* bar = b.bar;
        __builtin_amdgcn_s_waitcnt(0);
        unsigned nloc = b.st[0], nx = b.st[1];
        if (nloc == 0u) { xcd_barrier_complete(bar, b.x, nloc, nx); b.st[0] = nloc; b.st[1] = nx; }
        const unsigned old = xb_add(&bar[XB_XSUB(b.x)], 1u);
        const unsigned gen = old / nloc;
        if (old + 1u == (gen + 1u) * nloc) {
            __builtin_amdgcn_fence(__ATOMIC_RELEASE, "agent");
            asm volatile("s_waitcnt vmcnt(0)" ::: "memory");
            const unsigned og = xb_add(&bar[XB_TOP], 1u);
            const unsigned tg = og / nx;
            if (og + 1u == (tg + 1u) * nx) xb_add(&bar[XB_TOPGEN], 1u);
            else XB_SPIN(xb_ld(&bar[XB_TOPGEN]) == tg, bar);
            __builtin_amdgcn_fence(__ATOMIC_ACQUIRE, "agent");
            xb_add(&bar[XB_XGEN(b.x)], 1u);
            asm volatile("s_waitcnt vmcnt(0)" ::: "memory");
        } else {
            XB_SPIN(xb_ld(&bar[XB_XGEN(b.x)]) == gen, bar);
            __builtin_amdgcn_fence(__ATOMIC_ACQUIRE, "agent");
            asm volatile("s_waitcnt vmcnt(0)" ::: "memory");
        }
    }
    __syncthreads();
}


namespace mk {
struct Ctx { LAS unsigned char* lds; int tid, lane, wave, G, bx; };

__device__ __forceinline__ void p_weights(const Ctx& c, const MKArgs& a) {
    LAS float* scr = (LAS float*)c.lds + c.wave * 64 * 33;
    for (int it = c.bx * 8 + c.wave; it < (c.G == 256 ? WI_IN : DEPTH * WI_LAYER); it += c.G * 8) wconv_item(it, a.in[10], a.in[11], a.in[29], a.in[30], a.ws, scr, c.lane);
    bf16_t* LW = (bf16_t*)(a.ws + WS_LW);
    for (int gid = c.bx * 512 + c.tid; gid < DEPTH * 2 * 4 * 2 * 64 * 64; gid += c.G * 512) {
        const int i = gid & 63, o = (gid >> 6) & 63, ty = (gid >> 12) & 1, nb = (gid >> 13) & 3, dir = (gid >> 15) & 1, l = gid >> 16;
        const float* src = ty == 0 ? a.in[24] : a.in[26];
        LW[gid] = (bf16_t)f2bf(src[((((size_t)l * 2 + dir) * 4 + nb) * 64 + i) * 64 + o]); }
}
__device__ __forceinline__ void p_weights_late(const Ctx& c, const MKArgs& a, int first_block, int it_lo, int it_hi) {
    if (c.bx < first_block) return;
    LAS float* scr = (LAS float*)c.lds + c.wave * 64 * 33;
    for (int it = it_lo + (c.bx - first_block) * 8 + c.wave; it < it_hi; it += (c.G - first_block) * 8) wconv_item(it, a.in[10], a.in[11], a.in[29], a.in[30], a.ws, scr, c.lane);
}
__device__ __forceinline__ void p_mod(const Ctx& c, const MKArgs& a, int l_lo, int l_hi, int first_block = 0) {
    LAS float* sc = (LAS float*)(c.lds + 67584); LAS float* red = sc + 3 * D;
    const float* cvec = a.in[1]; const float* cctx = a.in[3]; const float* ada_w = a.in[4]; const float* ada_b = a.in[5]; float* MOD = (float*)(a.ws + WS_MOD);
    for (int i = c.tid; i < 3 * D; i += 512) { const int cd = i / D, k = i % D; const float v = cd < 2 ? cvec[cd * D + k] : cctx[k]; sc[i] = v / (1.0f + expf(-v)); }
    __syncthreads();
    for (int item = l_lo * 96 + (c.bx - first_block); c.bx >= first_block && item < l_hi * 96; item += c.G - first_block) {
        const int l = item / 96, n = (item % 96) * 64 + c.lane;
        const float* w = ada_w + (size_t)l * D * 6 * D + (size_t)(128 * c.wave) * 6 * D + n;
        float a0 = 0.f, a1 = 0.f, a2 = 0.f;
#pragma unroll 32
        for (int k = 0; k < 128; ++k) { const float wv = w[(size_t)k * 6 * D]; const int kk = 128 * c.wave + k; a0 += sc[kk] * wv; a1 += sc[D + kk] * wv; a2 += sc[2 * D + kk] * wv; }
        red[(c.wave * 3 + 0) * 64 + c.lane] = a0; red[(c.wave * 3 + 1) * 64 + c.lane] = a1; red[(c.wave * 3 + 2) * 64 + c.lane] = a2;
        __syncthreads();
        if (c.tid < 192) { const int cd = c.tid >> 6, ln = c.tid & 63; float s = ada_b[l * 6 * D + (item % 96) * 64 + ln];
#pragma unroll
            for (int w8 = 0; w8 < 8; ++w8) s += red[(w8 * 3 + cd) * 64 + ln];
            MOD[(size_t)(l * 3 + cd) * 6 * D + (item % 96) * 64 + ln] = s; }
        __syncthreads();
    }
}
__device__ __forceinline__ void p_filt_h2(const Ctx& c, const MKArgs& a, int l_lo, int l_hi, int first_block = 0) {
    LAS float* z = (LAS float*)(c.lds + 90112); LAS float* h1 = z + 8 * 36;
    const float* w1 = a.in[14]; const float* b1 = a.in[15]; const float* w2 = a.in[16]; const float* b2 = a.in[17]; const float* freq = a.in[19]; float* H2 = (float*)(a.ws + WS_H2);
    const int pl = c.tid >> 6, j = c.tid & 63;
    float W1c[33], W2c[64], b1v = 0.f, b2v = 0.f, f0 = 0.f, f1 = 0.f; int lcur = -1;
    for (int item = l_lo * (FPOS / 8) + (c.bx - first_block); c.bx >= first_block && item < l_hi * (FPOS / 8); item += c.G - first_block) {
        const int l = item / (FPOS / 8), p0 = (item % (FPOS / 8)) * 8, p = p0 + pl;
        if (l != lcur) { lcur = l;
#pragma unroll
            for (int i = 0; i < 33; ++i) W1c[i] = w1[l * 33 * 64 + i * 64 + j];
#pragma unroll
            for (int i = 0; i < 64; ++i) W2c[i] = w2[l * 64 * 64 + i * 64 + j];
            b1v = b1[l * 64 + j]; b2v = b2[l * 64 + j]; f0 = freq[(l * 2 + 0) * 64 + j]; f1 = freq[(l * 2 + 1) * 64 + j]; }
        const float t = p < SEQ ? (float)p / (float)SEQ : (float)(p - SEQ) / (float)CTXL;
        if (j < 33) { float v; if (j == 0) v = t; else { const int bnd = j <= 16 ? j : j - 16; float s, cs; sincospif(2.0f * t * (float)bnd, &s, &cs); v = j <= 16 ? cs : s; } z[pl * 36 + j] = v; }
        __syncthreads();
        float acc = b1v;
#pragma unroll
        for (int i4 = 0; i4 < 8; ++i4) { const f32x4 zv = *(const LAS f32x4*)(z + pl * 36 + 4 * i4); acc += zv[0] * W1c[4 * i4] + zv[1] * W1c[4 * i4 + 1] + zv[2] * W1c[4 * i4 + 2] + zv[3] * W1c[4 * i4 + 3]; }
        acc += z[pl * 36 + 32] * W1c[32];
        h1[pl * 64 + j] = sinf(f0 * acc);
        __syncthreads();
        float a2 = b2v;
#pragma unroll
        for (int i4 = 0; i4 < 16; ++i4) { const f32x4 hv = *(const LAS f32x4*)(h1 + pl * 64 + 4 * i4); a2 += hv[0] * W2c[4 * i4] + hv[1] * W2c[4 * i4 + 1] + hv[2] * W2c[4 * i4 + 2] + hv[3] * W2c[4 * i4 + 3]; }
        H2[((size_t)l * FPOS + p) * 64 + j] = sinf(f1 * a2);
    }
    __syncthreads();
}
__device__ __forceinline__ void p_filt_k(const Ctx& c, const MKArgs& a, int l, bool with_ctx, int first_block = 0) {
    const int half = c.tid >> 8, t256 = c.tid & 255;
    LAS float* hs = (LAS float*)(c.lds + half * 34816); LAS float* wsm = hs + 64 * 68;
    const float* H2l = (const float*)(a.ws + WS_H2) + (size_t)l * FPOS * 64; const float* w3l = a.in[18] + (size_t)l * 64 * 1024;
    bf16_t* KFB = (bf16_t*)(a.ws + WS_KF); float* KFC = (float*)(a.ws + WS_KFC);
    const int nlat = (SEQ / 64) * 16, total = nlat + (with_ctx ? (CTXL / 64) * 16 : 0);
    if (c.bx < first_block) return;
    for (int it0 = 2 * (c.bx - first_block); it0 < total; it0 += 2 * (c.G - first_block)) {
        const int item = it0 + half; const bool live = item < total; int bxi = live ? item : 0;
        const bool isctx = bxi >= nlat; if (isctx) bxi -= nlat;
        const int L = isctx ? CTXL : SEQ; const int pt = bxi / 16, ct = bxi % 16, p0 = pt * 64, c0 = ct * 64;
        const float* Hs = H2l + (size_t)(isctx ? SEQ : 0) * 64;
        __syncthreads();
        { float hv_[16], wv_[16];
#pragma unroll
          for (int i16 = 0; i16 < 16; ++i16) { const int i = t256 + 256 * i16, r = i >> 6, cc = i & 63; hv_[i16] = Hs[(size_t)(p0 + r) * 64 + cc]; wv_[i16] = w3l[r * 1024 + c0 + cc]; }
#pragma unroll
          for (int i16 = 0; i16 < 16; ++i16) { const int i = t256 + 256 * i16, r = i >> 6, cc = i & 63; hs[cc * 68 + r] = hv_[i16]; wsm[r * 68 + cc] = wv_[i16]; } }
        __syncthreads();
        const int tx = t256 & 15, ty = t256 >> 4;
        float acc[4][4];
#pragma unroll
        for (int x = 0; x < 4; ++x)
#pragma unroll
            for (int y = 0; y < 4; ++y) acc[x][y] = 0.f;
#pragma unroll 8
        for (int j = 0; j < 64; ++j) {
            const f32x4 hv = *(const LAS f32x4*)(hs + j * 68 + 4 * tx), wv = *(const LAS f32x4*)(wsm + j * 68 + 4 * ty);
#pragma unroll
            for (int x = 0; x < 4; ++x)
#pragma unroll
                for (int y = 0; y < 4; ++y) acc[x][y] += hv[x] * wv[y];
        }
        if (live) {
#pragma unroll
            for (int y = 0; y < 4; ++y) { const int col = c0 + 4 * ty + y, ch = col & 255;
                const float d0 = 15.350567286626973f, d1 = 3.0701134573253946f; const float delta = d0 + (d1 - d0) * ((float)ch / 255.0f);
                f32x4 o;
#pragma unroll
                for (int x = 0; x < 4; ++x) { const float t = (float)(p0 + 4 * tx + x) / (float)L; o[x] = acc[x][y] * expf(-t * delta); }
                if (isctx) *(f32x4*)(KFC + (size_t)col * L + p0 + 4 * tx) = o;
                else { u32x2 w; w.x = pg8::cvt_pk_bf16(o[0], o[1]); w.y = pg8::cvt_pk_bf16(o[2], o[3]); *(u32x2*)(KFB + (size_t)col * L + p0 + 4 * tx) = w; } }
        }
    }
    __syncthreads();
}
__device__ __forceinline__ void p_rownorm0(const Ctx& c, const MKArgs& a) {
    const float* x = a.in[0]; const float* ctx = a.in[2]; const float* g = a.in[6]; const float* MOD0 = (const float*)(a.ws + WS_MOD); bf16_t* H = (bf16_t*)(a.ws + WS_H);
    const int lane = c.lane;
    for (int row0 = 2 * (c.bx * 8 + c.wave); row0 < MT; row0 += 2 * c.G * 8) {
        f32x4 v[2][4]; float ss[2] = {0.f, 0.f}; int cond[2];
#pragma unroll
        for (int r = 0; r < 2; ++r) { const int row = row0 + r; const bool isctx = row >= NLAT; cond[r] = isctx ? 2 : row / SEQ;
            const float* xr = isctx ? ctx + (size_t)(row - NLAT) * D : x + (size_t)row * D;
#pragma unroll
            for (int j = 0; j < 4; ++j) v[r][j] = __builtin_nontemporal_load((const f32x4*)(xr + 4 * lane + 256 * j)); }
#pragma unroll
        for (int r = 0; r < 2; ++r)
#pragma unroll
            for (int j = 0; j < 4; ++j) ss[r] += v[r][j][0] * v[r][j][0] + v[r][j][1] * v[r][j][1] + v[r][j][2] * v[r][j][2] + v[r][j][3] * v[r][j][3];
#pragma unroll
        for (int o = 1; o < 64; o <<= 1) { ss[0] += __shfl_xor(ss[0], o); ss[1] += __shfl_xor(ss[1], o); }
#pragma unroll
        for (int r = 0; r < 2; ++r) { const float rinv = 1.0f / sqrtf(ss[r] * (1.0f / D) + 1e-6f);
            const float* sh = MOD0 + (size_t)cond[r] * 6 * D; const float* sc = sh + D;
#pragma unroll
            for (int j = 0; j < 4; ++j) { const int col = 4 * lane + 256 * j; const f32x4 gv = *(const f32x4*)(g + col), scv = *(const f32x4*)(sc + col), shv = *(const f32x4*)(sh + col);
                float o[4];
#pragma unroll
                for (int e = 0; e < 4; ++e) o[e] = v[r][j][e] * rinv * gv[e] * (1.0f + scv[e]) + shv[e];
                u32x2 w; w.x = pg8::cvt_pk_bf16(o[0], o[1]); w.y = pg8::cvt_pk_bf16(o[2], o[3]); *(u32x2*)(H + (size_t)(row0 + r) * D + col) = w; } }
    }
}
__device__ __forceinline__ void p_rowpass(const Ctx& c, const bf16_t* Y, const float* xin_lat, const float* xin_ctx, float* xout_lat, float* xout_ctx, const float* g_post, const float* modp, int gate_idx,
                                          const float* g_next, const float* modn, int nidx, bf16_t* H, int nrows) {
    LAS float* VA = (LAS float*)c.lds; LAS float* VB = VA + 3 * D; LAS float* VC = VB + 3 * D;
    __syncthreads();
    for (int i = c.tid; i < 3 * D; i += 512) { const int cd = i / D, col = i % D;
        VA[i] = modp[(size_t)cd * 6 * D + gate_idx * D + col] * g_post[col];
        if (g_next) { VB[i] = g_next[col] * (1.0f + modn[(size_t)cd * 6 * D + (nidx + 1) * D + col]); VC[i] = modn[(size_t)cd * 6 * D + nidx * D + col]; } }
    __syncthreads();
    const int lane = c.lane;
    constexpr int NR = 2;
    for (int row0 = NR * (c.bx * 8 + c.wave); row0 < nrows; row0 += NR * c.G * 8) {
        float y[NR][4][4]; f32x4 xv[NR][4]; float ss[NR]; int cond[NR]; float* xo[NR];
#pragma unroll
        for (int r = 0; r < NR; ++r) { ss[r] = 0.f; const int row = row0 + r; const bool isctx = row >= NLAT; cond[r] = isctx ? 2 : row / SEQ;
            const float* xi = isctx ? xin_ctx + (size_t)(row - NLAT) * D : xin_lat + (size_t)row * D;
            xo[r] = isctx ? xout_ctx + (size_t)(row - NLAT) * D : xout_lat + (size_t)row * D;
#pragma unroll
            for (int j = 0; j < 4; ++j) { const u32x2 w = __builtin_nontemporal_load((const u32x2*)(Y + (size_t)row * D + 4 * lane + 256 * j)); xv[r][j] = __builtin_nontemporal_load((const f32x4*)(xi + 4 * lane + 256 * j));
                y[r][j][0] = bf2f(w.x & 0xffffu); y[r][j][1] = bf2f(w.x >> 16); y[r][j][2] = bf2f(w.y & 0xffffu); y[r][j][3] = bf2f(w.y >> 16); } }
#pragma unroll
        for (int r = 0; r < NR; ++r)
#pragma unroll
            for (int j = 0; j < 4; ++j) ss[r] += y[r][j][0] * y[r][j][0] + y[r][j][1] * y[r][j][1] + y[r][j][2] * y[r][j][2] + y[r][j][3] * y[r][j][3];
#pragma unroll
        for (int o = 1; o < 64; o <<= 1) {
#pragma unroll
            for (int r = 0; r < NR; ++r) ss[r] += __shfl_xor(ss[r], o); }
        float s2[NR];
#pragma unroll
        for (int r = 0; r < NR; ++r) { s2[r] = 0.f; const float rinv = 1.0f / sqrtf(ss[r] * (1.0f / D) + 1e-6f);
#pragma unroll
            for (int j = 0; j < 4; ++j) { const int col = 4 * lane + 256 * j; const f32x4 av = *(const LAS f32x4*)(VA + cond[r] * D + col);
#pragma unroll
                for (int e = 0; e < 4; ++e) { xv[r][j][e] += av[e] * (y[r][j][e] * rinv); s2[r] += xv[r][j][e] * xv[r][j][e]; }
                __builtin_nontemporal_store(xv[r][j], (f32x4*)(xo[r] + col)); } }
        if (g_next) {
#pragma unroll
            for (int o = 1; o < 64; o <<= 1) {
#pragma unroll
                for (int r = 0; r < NR; ++r) s2[r] += __shfl_xor(s2[r], o); }
#pragma unroll
            for (int r = 0; r < NR; ++r) { const float r2 = 1.0f / sqrtf(s2[r] * (1.0f / D) + 1e-6f);
#pragma unroll
                for (int j = 0; j < 4; ++j) { const int col = 4 * lane + 256 * j; const f32x4 bv = *(const LAS f32x4*)(VB + cond[r] * D + col), cv = *(const LAS f32x4*)(VC + cond[r] * D + col);
                    u32x2 w; w.x = pg8::cvt_pk_bf16(xv[r][j][0] * r2 * bv[0] + cv[0], xv[r][j][1] * r2 * bv[1] + cv[1]); w.y = pg8::cvt_pk_bf16(xv[r][j][2] * r2 * bv[2] + cv[2], xv[r][j][3] * r2 * bv[3] + cv[3]);
                    *(u32x2*)(H + (size_t)(row0 + r) * D + col) = w; } }
        }
    }
    __syncthreads();
}
__device__ __forceinline__ float conv3_at(const bf16_t* rowp, int s, int Lseq, float w0, float w1, float w2, float bias) {
    float v = bias + w1 * bf2f(rowp[s]);
    if (s > 0) v += w0 * bf2f(rowp[s - 1]);
    if (s + 1 < Lseq) v += w2 * bf2f(rowp[s + 1]);
    return v;
}
__device__ __forceinline__ void hy_ctx_unit(const Ctx& cx, int c, const bf16_t* PTV, const float* KFC, const float* cw, const float* cb, const float* hbias, bf16_t* YMIX) {
    LAS float* zin = (LAS float*)cx.lds; LAS float* kc = zin + 512; LAS float* red = kc + 512;
    const int tid = cx.tid, b = tid >> 8, t = tid & 255, lane = tid & 63, wave = tid >> 6;
    const bf16_t* base = PTV + NLAT + b * CTXL;
    float zcur = conv3_at(base + (size_t)c * MT, t, CTXL, cw[c], cw[768 + c], cw[1536 + c], cb[c]);
    for (int order = 0; order < 2; ++order) {
        __syncthreads();
        zin[b * 256 + t] = zcur;
        const float* kf = KFC + (size_t)((order * 2 + 0) * 256 + c) * CTXL; const float* kb = KFC + (size_t)((order * 2 + 1) * 256 + c) * CTXL;
        float kv = 0.f; if (tid >= 1) { const int d = tid - 256; kv = d >= 0 ? kf[d] : kb[-d]; } kc[tid] = kv;
        const float s = wave_sum(fabsf(kv)); if (lane == 0) red[wave] = s;
        __syncthreads();
        float tot = 0.f;
#pragma unroll
        for (int i = 0; i < 8; ++i) tot += red[i];
        float acc = 0.f;
        for (int s2 = 0; s2 < 256; ++s2) acc += kc[t - s2 + 256] * zin[b * 256 + s2];
        const int grow = (order == 0 ? 256 : 512) + c;
        const float gate = conv3_at(base + (size_t)grow * MT, t, CTXL, cw[grow], cw[768 + grow], cw[1536 + grow], cb[grow]);
        zcur = gate * (acc / tot + hbias[order * 256 + c] * zcur);
    }
    YMIX[(size_t)(NLAT + b * CTXL + t) * D + c] = (bf16_t)f2bf(zcur);
    __syncthreads();
}
}

__global__ void __launch_bounds__(512, 2) mk_fwd(MKArgs a) {
    extern __shared__ __attribute__((aligned(16))) unsigned char lds_raw[];
    cg::grid_group grid = cg::this_grid();
    mk::Ctx c; c.lds = (LAS unsigned char*)lds_raw; c.tid = threadIdx.x; c.lane = c.tid & 63; c.wave = __builtin_amdgcn_readfirstlane(c.tid >> 6); c.G = gridDim.x; c.bx = blockIdx.x;
#define FRESH() do { c.tid = opaque_i(threadIdx.x); c.lane = c.tid & 63; c.wave = __builtin_amdgcn_readfirstlane(c.tid >> 6); } while (0)
    unsigned char* ws = a.ws; float* out = a.out;
    bf16_t* Win_t = (bf16_t*)(ws + WS_WIN); bf16_t* Wout_t = (bf16_t*)(ws + WS_WOUT); bf16_t* Wgu_t = (bf16_t*)(ws + WS_WGU); bf16_t* Wdn_t = (bf16_t*)(ws + WS_WDN);
    float* MOD = (float*)(ws + WS_MOD); float* XC = (float*)(ws + WS_XC);
    bf16_t* H = (bf16_t*)(ws + WS_H); bf16_t* Y = (bf16_t*)(ws + WS_Y); bf16_t* PTV = (bf16_t*)(ws + WS_PTV); bf16_t* QKL = (bf16_t*)(ws + WS_QKL); bf16_t* ACT = (bf16_t*)(ws + WS_ACT);
    bf16_t* YMIX = (bf16_t*)(ws + WS_YMIX); fft::spec_t* KFS = (fft::spec_t*)(ws + WS_H); f32x2* HSCR = (f32x2*)(ws + WS_KF);
    const int lo = a.ph_lo, hi = a.ph_hi;
    unsigned* barw = (unsigned*)(ws + WS_CTL);
    if (lo > hi) grid.sync();
    if (c.tid < 16) ((LAS unsigned*)(c.lds + MK_LDS_BYTES - 64))[c.tid] = 0u;
    __syncthreads();
    XcdBarrier xbar; xbar.bar = barw; xbar.x = 0; xbar.st = (volatile LAS unsigned*)(c.lds + MK_LDS_BYTES - 64);
    if (hi - lo > 1) xbar = xcd_barrier_post(barw, (volatile LAS unsigned*)(c.lds + MK_LDS_BYTES - 64));
    pg8::Epi E;
#define IN(k) (lo <= (k) && (k) < hi)
#define SEAM(k) do { if (IN(k) && IN((k) + 1)) xcd_barrier(xbar); } while (0)
#ifndef MK_DUP
#define MK_DUP 0
#endif
#ifndef MK_DUP2
#define MK_DUP2 0
#endif
#ifndef MK_DUPN
#define MK_DUPN 1
#endif
#define REP2(b) for (int rep2_ = 0; rep2_ <= (int)((l == 1) && (((unsigned)(MK_DUP2) >> (b)) & 1u)) * MK_DUPN; ++rep2_)
#define REP(k) for (int rep_ = 0; rep_ <= (int)(((unsigned)(MK_DUP) >> (k)) & 1u); ++rep_)
    if (IN(0)) REP(0) { FRESH(); mk::p_weights(c, a); __syncthreads(); mk::p_mod(c, a, 0, DEPTH); mk::p_filt_h2(c, a, 0, (c.G == 256) ? 1 : DEPTH); }
    SEAM(0);
#ifdef MK_XSYNC
    if (lo == 0 && hi == NPHASE) for (int i_ = 0; i_ < MK_XSYNC; ++i_) xcd_barrier(xbar);
#endif
    if (IN(1)) REP(1) { FRESH();
#pragma unroll 1
        for (int stg = 0; stg < 2; ++stg) { if ((stg ^ ((c.bx >> 3) & 1)) == 0) mk::p_rownorm0(c, a); else mk::p_filt_k(c, a, 0, true); } }
    SEAM(1);
#pragma unroll 1
    for (int l = 0; l < DEPTH; ++l) {
        const int pb = 2 + 8 * l; const bool lastl = (l == DEPTH - 1);
        const float* modl = MOD + (size_t)l * 3 * 6 * D;
        const int nrows = lastl ? NLAT : MT;
        if (IN(pb + 0)) REP(pb + 0) {
            pg8::Sched S; const bf16_t* W = Win_t + (size_t)l * INW * D;
            const bf16_t* Hin = (l == 0) ? H : YMIX;
            S.ph.s0 = pg8::GSeg{W, Hin, PTV, NPTV / 256, MT / 256, MT, 0}; S.ph.s1 = pg8::GSeg{Hin, W + (size_t)NPTV * D, QKL, MT / 256, NQKL / 256, NQKL, 0};
            S.ph.n0 = (NPTV / 256) * (MT / 256); S.ph.total = S.ph.n0 + (MT / 256) * (NQKL / 256); S.ph.K = D; S.ph.pad = 0; S.G = c.G; S.c = c.bx;
            pg8::gemm_phase(c.lds, S, E);
            if (l == 0 && c.G == 256) { FRESH(); mk::p_weights_late(c, a, 150, WI_IN, WI_LAYER); }
            if (l > 0 && c.G == 256 && c.bx >= 150 && c.bx < 150 + (512 - FEARLY)) {
                const bf16_t* KF = (const bf16_t*)(ws + WS_KF); const int u = FEARLY + c.bx - 150, order = u >> 8, ch = u & 255;
                fft::filter_unit(c.lds, KF + (size_t)((order * 2 + 0) * 256 + ch) * SEQ, KF + (size_t)((order * 2 + 1) * 256 + ch) * SEQ, KFS + ((size_t)order * 256 + ch) * 2 * SEQ); }
        }
        SEAM(pb + 0);
        if (IN(pb + 1)) REP(pb + 1) {
            const bf16_t* KF = (const bf16_t*)(ws + WS_KF);
            const int rot = (c.bx >> 3) % 3;
#pragma unroll 1
            for (int stg = 0; stg < 3; ++stg) { const int which = (stg + rot) % 3;
                __syncthreads();
                if (which == 0) {
                    REP2(0) for (int u = (l == 0 || c.G != 256) ? c.bx : 512; u < 512; u += c.G)     { const int order = u >> 8, ch = u & 255;
                        fft::filter_unit(c.lds, KF + (size_t)((order * 2 + 0) * 256 + ch) * SEQ, KF + (size_t)((order * 2 + 1) * 256 + ch) * SEQ, KFS + ((size_t)order * 256 + ch) * 2 * SEQ); }
                } else if (which == 1) {
                    na::Params np{QKL, PTV + (size_t)768 * MT, a.in[21] + (size_t)l * 8 * 15 * 31, YMIX}; const int nunits = lastl ? 512 : 544;
                    REP2(1) { for (int u = c.bx; u < 512; u += c.G) na::latent_unit(c.lds, np, u
#ifdef MK_NA_PM
                            , (rep2_ < (int)((l == 1) && ((MK_DUP2 >> 1) & 1u)) * MK_DUPN) ? MK_NA_PM : 0
#endif
                            );
                        if (nunits > 512) for (int u = c.bx - 8; u >= 0 && u < 32; u += c.G) na::ctx_unit(c.lds, np, u); }
                } else {
                    lru::Params lp{QKL, (const bf16_t*)(ws + WS_LW) + (size_t)l * 2 * 4 * 2 * 64 * 64, a.in[22] + (size_t)l * 4 * 256, a.in[23] + (size_t)l * 256, a.in[25] + (size_t)l * 512, a.in[27] + (size_t)l * 512,
                                    a.in[28] + (size_t)l * 512, (f32x2*)(ws + WS_AGG), YMIX};
                    REP2(2) for (int su = c.bx; su < 264; su += c.G) lru::super_unit<false>(c.lds, lp, su);
                }
            }
            if (!lastl) { __syncthreads(); FRESH();
                for (int u = c.bx; u < 256; u += c.G) mk::hy_ctx_unit(c, u, PTV, (const float*)(ws + WS_KFC), a.in[12] + (size_t)l * 3 * 768, a.in[13] + (size_t)l * 768, a.in[20] + (size_t)l * 512, YMIX); }
        }
        SEAM(pb + 1);
        if (IN(pb + 2)) REP(pb + 2) {
            unsigned* Zs = (unsigned*)HSCR + (size_t)c.bx * SEQ; unsigned* Rs = (unsigned*)HSCR + (size_t)(256 + c.bx) * SEQ;
#pragma unroll 1
            for (int stg = 0; stg < 2; ++stg) { const int which = stg ^ ((c.bx >> 3) & 1);
                __syncthreads();
                if (which == 0) {
                    REP2(3) for (int u = c.bx; u < 256; u += c.G) { const int ch = (c.G == 256) ? (u & 7) * 32 + (u >> 3) : u;
                        fft::hyena_unit(c.lds, ch, PTV, KFS + (size_t)ch * 2 * SEQ, (size_t)256 * 2 * SEQ, a.in[12] + (size_t)l * 3 * 768, a.in[13] + (size_t)l * 768, a.in[20] + (size_t)l * 512, Zs, Rs, YMIX
#ifdef MK_HY_PM
                            , (rep2_ < (int)((l == 1) && ((MK_DUP2 >> 3) & 1u)) * MK_DUPN) ? MK_HY_PM : 0
#endif
                            ); }
                } else {
                    lru::Params lp{QKL, (const bf16_t*)(ws + WS_LW) + (size_t)l * 2 * 4 * 2 * 64 * 64, a.in[22] + (size_t)l * 4 * 256, a.in[23] + (size_t)l * 256, a.in[25] + (size_t)l * 512, a.in[27] + (size_t)l * 512,
                                    a.in[28] + (size_t)l * 512, (f32x2*)(ws + WS_AGG), YMIX};
                    REP2(4) for (int su = c.bx; su < (lastl ? 256 : 264); su += c.G) lru::super_unit<true>(c.lds, lp, su);
                }
            }
        }
        SEAM(pb + 2);
        if (IN(pb + 3)) REP(pb + 3) {
            pg8::Sched S; const int nMt = (lastl ? NLAT : MT) / 256; S.ph.s0 = pg8::GSeg{YMIX, Wout_t + (size_t)l * D * D, Y, nMt, D / 256, D, 0}; S.ph.s1 = S.ph.s0; S.ph.n0 = S.ph.total = nMt * (D / 256); S.ph.K = D; S.ph.pad = 0; S.G = c.G; S.c = c.bx;
            pg8::gemm_phase(c.lds, S, E);
            if (l == 0 && c.G == 256) { FRESH(); mk::p_weights_late(c, a, 8, WI_LAYER, DEPTH * WI_LAYER); __syncthreads(); mk::p_filt_h2(c, a, 1, DEPTH, 8); }
        }
        SEAM(pb + 3);
        if (IN(pb + 4)) { FRESH();
#ifdef MK_DUP_RP
            if (l == 1) mk::p_rowpass(c, YMIX, a.in[0], XC, (float*)(ws + WS_PTV), (float*)(ws + WS_PTV) + (size_t)NLAT * D, a.in[7] + (size_t)l * D, modl, 2, a.in[8] + (size_t)l * D, modl, 3, (bf16_t*)(ws + WS_KF), NLAT);
#endif
            mk::p_rowpass(c, Y, l == 0 ? a.in[0] : out, l == 0 ? a.in[2] : XC, out, XC, a.in[7] + (size_t)l * D, modl, 2, a.in[8] + (size_t)l * D, modl, 3, H, nrows);
            if (!lastl && c.G != 256) mk::p_filt_k(c, a, l + 1, false);
        }
        SEAM(pb + 4);
        if (IN(pb + 5)) REP(pb + 5) {
            pg8::Sched S; const int nMt = (lastl ? NLAT : MT) / 256; S.ph.s0 = pg8::GSeg{H, Wgu_t + (size_t)l * 2 * DFF * D, ACT, nMt, 2 * DFF / 256, DFF, 1}; S.ph.s1 = S.ph.s0; S.ph.n0 = S.ph.total = nMt * (2 * DFF / 256); S.ph.K = D; S.ph.pad = 0; S.G = c.G; S.c = c.bx;
            pg8::gemm_phase(c.lds, S, E);
            if (!lastl && c.G == 256) { FRESH(); mk::p_filt_k(c, a, l + 1, false, 44); }
        }
        SEAM(pb + 5);
        if (IN(pb + 6)) REP(pb + 6) {
            pg8::Sched S; const int nMt = (lastl ? NLAT : MT) / 256; S.ph.s0 = pg8::GSeg{ACT, Wdn_t + (size_t)l * D * DFF, Y, nMt, D / 256, D, 0}; S.ph.s1 = S.ph.s0; S.ph.n0 = S.ph.total = nMt * (D / 256); S.ph.K = DFF; S.ph.pad = 0; S.G = c.G; S.c = c.bx;
            pg8::gemm_phase(c.lds, S, E);
            if (!lastl && c.G == 256 && c.bx >= 8) {
                const bf16_t* KF = (const bf16_t*)(ws + WS_KF);
                for (int u = 2 * (c.bx - 8); u < 2 * (c.bx - 8) + 2; ++u) { const int order = u >> 8, ch = u & 255;
                    fft::filter_unit(c.lds, KF + (size_t)((order * 2 + 0) * 256 + ch) * SEQ, KF + (size_t)((order * 2 + 1) * 256 + ch) * SEQ, KFS + ((size_t)order * 256 + ch) * 2 * SEQ); }
            }
        }
        SEAM(pb + 6);
        if (IN(pb + 7)) { FRESH();
            mk::p_rowpass(c, Y, out, XC, out, XC, a.in[9] + (size_t)l * D, modl, 5, lastl ? (const float*)nullptr : a.in[6] + (size_t)(l + 1) * D, lastl ? modl : modl + 3 * 6 * D, 0, YMIX, nrows);
        }
        SEAM(pb + 7);
    }
#undef IN
#undef SEAM
#undef REP
#undef REP2
}

#ifndef MK_N_LAUNCHES
#define MK_N_LAUNCHES 1
#endif
extern "C" void kernel_launch(void* const* d_in, const int* in_sizes, int n_in, void* d_out, int out_size, void* d_ws, size_t ws_size, hipStream_t stream) {
    static int grid = 0;
    if (grid == 0) {
        if (n_in != 31 || in_sizes[0] != NLAT * D || out_size != NLAT * D || ws_size < WS_END) { fprintf(stderr, "kernel_launch: unexpected shapes (n_in %d, in0 %d, out %d, ws %zu)\n", n_in, n_in > 0 ? in_sizes[0] : -1, out_size, ws_size); grid = -1; return; }
        if (hipFuncSetAttribute((const void*)mk_fwd, hipFuncAttributeMaxDynamicSharedMemorySize, MK_LDS_BYTES) != hipSuccess) { fprintf(stderr, "kernel_launch: hipFuncSetAttribute failed\n"); grid = -1; return; }
        int dev = 0, cus = 0, per_cu = 0;
        hipGetDevice(&dev); hipDeviceGetAttribute(&cus, hipDeviceAttributeMultiprocessorCount, dev);
        hipOccupancyMaxActiveBlocksPerMultiprocessor(&per_cu, (const void*)mk_fwd, 512, MK_LDS_BYTES);
        if (per_cu < 1) { fprintf(stderr, "kernel_launch: occupancy query says %d workgroups per CU\n", per_cu); per_cu = 1; }
        grid = cus * per_cu; if (grid > 256) grid = 256;
        (void)hipGetLastError();
    }
    if (grid < 0) return;
    MKArgs a{};
    for (int i = 0; i < 31; ++i) a.in[i] = (const float*)d_in[i];
    a.out = (float*)d_out; a.ws = (unsigned char*)d_ws;
    if (MK_N_LAUNCHES == 1) {
        a.ph_lo = 0; a.ph_hi = NPHASE;
        if (hipMemsetAsync((char*)d_ws + WS_CTL, 0, XCD_BAR_WORDS * 4, stream) != hipSuccess) { fprintf(stderr, "kernel_launch: hipMemsetAsync of the barrier words failed\n"); return; }
        void* args[] = {&a};
        const hipError_t e = hipLaunchCooperativeKernel((const void*)mk_fwd, dim3(grid), dim3(512), args, MK_LDS_BYTES, stream);
        if (e != hipSuccess) fprintf(stderr, "kernel_launch: cooperative launch failed: %s (grid %d)\n", hipGetErrorString(e), grid);
    } else {
        for (int p = 0; p < NPHASE; ++p) { a.ph_lo = p; a.ph_hi = p + 1; hipLaunchKernelGGL(mk_fwd, dim3(grid), dim3(512), MK_LDS_BYTES, stream, a); }
    }
}
```

```cpp
#include <hip/hip_runtime.h>
#include <cstdio>
#include <cstdint>
#include <cmath>

#define LAS __attribute__((address_space(3)))
typedef unsigned short bf16_t;
typedef short bf16x8 __attribute__((ext_vector_type(8)));
typedef float f32x4 __attribute__((ext_vector_type(4)));
typedef float f32x2 __attribute__((ext_vector_type(2)));
typedef unsigned u32x4 __attribute__((ext_vector_type(4)));
typedef unsigned u32x2 __attribute__((ext_vector_type(2)));

constexpr int D = 1024, NB = 2, SEQ = 16384, DEPTH = 2, GRIDW = 64, GROWS = 256, CTXL = 256;
constexpr int NLAT = NB * SEQ, NCTX = NB * CTXL, MT = NLAT + NCTX;
constexpr int HYW = 256, NAW = 512, NHEAD = 8, DH = 64, LRW = 256, INW = 2816, DFF = 2816;
constexpr int NPTV = 1280;
constexpr int NQKL = 1536;
constexpr int FPOS = SEQ + CTXL;

constexpr size_t MiB = 1u << 20;
constexpr size_t WS_CTL = 0;
constexpr size_t WS_WIN = 1 * MiB, WS_WOUT = 12 * MiB, WS_WGU = 16 * MiB, WS_WDN = 38 * MiB;
constexpr size_t WS_MOD = 49 * MiB;
constexpr size_t WS_XC = 50 * MiB;
constexpr size_t WS_H2 = 52 * MiB;
constexpr size_t WS_KN = 61 * MiB;
constexpr size_t WS_H = 64 * MiB;
constexpr size_t WS_Y = 129 * MiB;
constexpr size_t WS_PTV = 194 * MiB;
constexpr size_t WS_QKL = WS_PTV + (size_t)NPTV * MT * 2;
constexpr size_t WS_ACT = WS_PTV;
constexpr size_t WS_YMIX = 373 * MiB;
constexpr size_t WS_KF = 438 * MiB;
constexpr size_t WS_KFC = 502 * MiB;
constexpr size_t WS_AGG = 504 * MiB;
constexpr size_t WS_LW = 62 * MiB;
constexpr size_t WS_END = 508 * MiB;
constexpr size_t WS_HF = WS_H, WS_HR = WS_H + (size_t)MT * LRW * 4;
constexpr size_t WS_Z1 = WS_Y;
static_assert(WS_QKL + (size_t)MT * NQKL * 2 <= WS_YMIX && WS_ACT + (size_t)MT * DFF * 2 <= WS_YMIX, "ws map");
static_assert(WS_HR + (size_t)MT * LRW * 4 <= WS_Y && WS_Z1 + (size_t)256 * 2 * SEQ * 4 <= WS_PTV, "ws map");

__device__ __forceinline__ int opaque_i(int v) { asm volatile("" : "+v"(v)); return v; }
__device__ __forceinline__ unsigned f2bf(float f) { unsigned u = __float_as_uint(f); return (u + 0x7fffu + ((u >> 16) & 1u)) >> 16; }
__device__ __forceinline__ unsigned pk2(float lo, float hi) { return f2bf(lo) | (f2bf(hi) << 16); }
__device__ __forceinline__ float bf2f(unsigned h) { return __uint_as_float(h << 16); }
__device__ __forceinline__ float wave_sum(float v) {
#pragma unroll
    for (int o = 1; o < 64; o <<= 1) v += __shfl_xor(v, o);
    return v;
}
__device__ __forceinline__ float wave_max(float v) {
#pragma unroll
    for (int o = 1; o < 64; o <<= 1) v = fmaxf(v, __shfl_xor(v, o));
    return v;
}
__device__ __forceinline__ float silu_f(float g) { return g * __builtin_amdgcn_rcpf(1.0f + __builtin_amdgcn_exp2f(-1.44269504089f * g)); }
__device__ __forceinline__ float sigmoid_f(float g) { return 1.0f / (1.0f + expf(-g)); }
__device__ __forceinline__ float gelu_tanh(float x) { const float u = 0.7978845608028654f * (x + 0.044715f * x * x * x); return 0.5f * x * (1.0f + tanhf(u)); }

namespace pg8 {
constexpr int BM = 256, BK = 64, HALF = 128, HTB = HALF * BK * 2, STAGE_BYTES = 8 * HTB;
#ifndef MK_WGM
#define MK_WGM 8
#endif
constexpr int WGM = MK_WGM;
__host__ __device__ __forceinline__ int lds_byte(int r, int c) { const int st = (r >> 4) * 2 + (c >> 5), rr = r & 15, cc = c & 31, ob = rr * 64 + cc * 2; return st * 1024 + (ob ^ (((ob >> 9) & 1) << 5)); }
__host__ __device__ __forceinline__ void stage_rc(int b, int& R, int& C) { const int st = b / 1024, sb = b % 1024, swz = sb ^ (((sb >> 9) & 1) << 5); R = (st >> 1) * 16 + swz / 64; C = (st & 1) * 32 + (swz % 64) / 2; }
__host__ __device__ __forceinline__ int perm32(int rho) { const int n = rho >> 4, i = rho & 15; return 8 * (i >> 2) + 4 * n + (i & 3); }

struct GSeg { const bf16_t* A; const bf16_t* B; bf16_t* C; int nM, nN, ldc, epi; };
struct GPhase { GSeg s0, s1; int n0, total, K, pad; };
struct Unit { const char* a; const char* b; bf16_t* C; int ldc, epi, pm, pn; };

struct Sched {
    GPhase ph; int G, c;
    __device__ __forceinline__ bool next(int i, Unit& u) const {
        const long L = (long)i * G + c; if (L >= ph.total) return false;
        int wgid = (int)L; { const int nwg = ph.total, q = nwg / 8, r = nwg % 8, xcd = wgid % 8, off = wgid / 8; wgid = (xcd < r ? xcd * (q + 1) : r * (q + 1) + (xcd - r) * q) + off; }
        const bool first = wgid < ph.n0; if (!first) wgid -= ph.n0;
        const bf16_t* A = first ? ph.s0.A : ph.s1.A; const bf16_t* B = first ? ph.s0.B : ph.s1.B; bf16_t* C = first ? ph.s0.C : ph.s1.C;
        const int nM = first ? ph.s0.nM : ph.s1.nM, nN = first ? ph.s0.nN : ph.s1.nN;
        u.ldc = first ? ph.s0.ldc : ph.s1.ldc; u.epi = first ? ph.s0.epi : ph.s1.epi; u.C = C;
        const int nig = WGM * nN, gid = wgid / nig, fm = gid * WGM, gsz = (nM - fm) < WGM ? (nM - fm) : WGM;
        u.pm = fm + ((wgid % nig) % gsz); u.pn = (wgid % nig) / gsz;
        u.a = (const char*)A + (size_t)u.pm * BM * ph.K * 2; u.b = (const char*)B + (size_t)u.pn * BM * ph.K * 2;
        return true;
    }
};

__device__ __forceinline__ unsigned cvt_pk_bf16(float lo, float hi) { unsigned r; asm volatile("v_cvt_pk_bf16_f32 %0, %1, %2" : "=v"(r) : "v"(lo), "v"(hi)); return r; }

struct Epi {
    __device__ __forceinline__ void operator()(const f32x4 (&acc)[2][2][4][2], const Unit& u, int wr, int wc, int fr, int fq) const {
        const int row0 = u.pm * BM + wr * 64 + fr;
        if (u.epi == 0) {
            const int col0 = u.pn * BM + wc * 32 + 8 * fq;
#pragma unroll
            for (int ai = 0; ai < 2; ++ai)
#pragma unroll
                for (int m = 0; m < 4; ++m) { bf16_t* rowp = u.C + (size_t)(row0 + ai * HALF + m * 16) * u.ldc + col0;
#pragma unroll
                    for (int bj = 0; bj < 2; ++bj) { const f32x4 v0 = acc[ai][bj][m][0], v1 = acc[ai][bj][m][1];
                        u32x4 w; w.x = cvt_pk_bf16(v0[0], v0[1]); w.y = cvt_pk_bf16(v0[2], v0[3]); w.z = cvt_pk_bf16(v1[0], v1[1]); w.w = cvt_pk_bf16(v1[2], v1[3]);
                        *(u32x4*)(rowp + bj * HALF) = w; } }
        } else {
            const int col0 = u.pn * HALF + wc * 32 + 8 * fq;
#pragma unroll
            for (int ai = 0; ai < 2; ++ai)
#pragma unroll
                for (int m = 0; m < 4; ++m) { bf16_t* rowp = u.C + (size_t)(row0 + ai * HALF + m * 16) * u.ldc + col0;
                    const f32x4 g0 = acc[ai][0][m][0], g1 = acc[ai][0][m][1], u0 = acc[ai][1][m][0], u1 = acc[ai][1][m][1];
                    u32x4 w; w.x = cvt_pk_bf16(silu_f(g0[0]) * u0[0], silu_f(g0[1]) * u0[1]); w.y = cvt_pk_bf16(silu_f(g0[2]) * u0[2], silu_f(g0[3]) * u0[3]);
                    w.z = cvt_pk_bf16(silu_f(g1[0]) * u1[0], silu_f(g1[1]) * u1[1]); w.w = cvt_pk_bf16(silu_f(g1[2]) * u1[2], silu_f(g1[3]) * u1[3]);
                    *(u32x4*)rowp = w; }
        }
    }
};

__device__ __forceinline__ void gemm_phase(LAS unsigned char* lds, const Sched& S, const Epi& E) {
    const int tid = opaque_i(threadIdx.x), wid = __builtin_amdgcn_readfirstlane(tid >> 6), lane = tid & 63, wr = wid >> 2, wc = wid & 3, fr = lane & 15, fq = lane >> 4;
    const int K = S.ph.K, nt = K / BK;
    unsigned voffA[2], voffB[2];
#pragma unroll
    for (int i = 0; i < 2; ++i) { int R, C; stage_rc(tid * 16 + i * 8192, R, C); const int Rb = (R & ~31) + perm32(R & 31);
        voffA[i] = (unsigned)(R * K + C) * 2u; voffB[i] = (unsigned)(Rb * K + C) * 2u; }
    const size_t kstep = (size_t)(BK * 2);
    const size_t hstep = (size_t)HALF * K * 2;
    const unsigned ldsw = (unsigned)wid * 1024u;
    const int aoff = lds_byte(wr * 64 + fr, fq * 8), boff = lds_byte(wc * 32 + fr, fq * 8);
#define PG8_SA(b, h) (((b) * 2 + (h)) * HTB)
#define PG8_SB(b, h) ((4 + (b) * 2 + (h)) * HTB)
#define PG8_STAGE(bufoff, gbase, voff) do { _Pragma("unroll") for (int _i = 0; _i < 2; ++_i) \
        __builtin_amdgcn_global_load_lds((const unsigned*)((const char*)(gbase) + (voff)[_i]), (LAS unsigned*)(lds + (bufoff) + ldsw + _i * 8192), 16, 0, 0); } while (0)
#define PG8_LDA(dst, b, h) do { _Pragma("unroll") for (int m = 0; m < 4; ++m) _Pragma("unroll") for (int k = 0; k < 2; ++k) dst[m][k] = *(const LAS bf16x8*)(lds + PG8_SA(b, h) + aoff + m * 2048 + k * 1024); } while (0)
#define PG8_LDB(dst, b, h) do { _Pragma("unroll") for (int n = 0; n < 2; ++n) _Pragma("unroll") for (int k = 0; k < 2; ++k) dst[n][k] = *(const LAS bf16x8*)(lds + PG8_SB(b, h) + boff + n * 2048 + k * 1024); } while (0)
#define PG8_MMA(ai, bj, At, Bt) do { __builtin_amdgcn_s_setprio(1); _Pragma("unroll") for (int m = 0; m < 4; ++m) _Pragma("unroll") for (int n = 0; n < 2; ++n) _Pragma("unroll") for (int k = 0; k < 2; ++k) \
        acc[ai][bj][m][n] = __builtin_amdgcn_mfma_f32_16x16x32_bf16(Bt[n][k], At[m][k], acc[ai][bj][m][n], 0, 0, 0); __builtin_amdgcn_s_setprio(0); } while (0)
#define PG8_WAIT_V(n) asm volatile("s_waitcnt vmcnt(" #n ")" ::: "memory")
#define PG8_WAIT_L(n) asm volatile("s_waitcnt lgkmcnt(" #n ")" ::: "memory")
#define PG8_BAR __builtin_amdgcn_s_barrier()
#define PG8_SCHED __builtin_amdgcn_sched_barrier(0)
    Unit cur, nxt; int ui = 0;
    if (!S.next(0, cur)) return;
    f32x4 acc[2][2][4][2];
#pragma unroll
    for (int a = 0; a < 2; ++a)
#pragma unroll
        for (int b = 0; b < 2; ++b)
#pragma unroll
            for (int m = 0; m < 4; ++m)
#pragma unroll
                for (int n = 0; n < 2; ++n) acc[a][b][m][n] = (f32x4){0.f, 0.f, 0.f, 0.f};
    bf16x8 At[4][2], B0[2][2], B1[2][2];
    const char* cA = cur.a; const char* cB = cur.b;
    PG8_STAGE(PG8_SB(0, 0), cB, voffB); PG8_STAGE(PG8_SB(0, 1), cB + hstep, voffB); PG8_STAGE(PG8_SA(0, 0), cA, voffA); PG8_STAGE(PG8_SA(0, 1), cA + hstep, voffA);
    if (wr == 1) PG8_BAR;
    PG8_WAIT_V(2); PG8_BAR;
    PG8_STAGE(PG8_SB(1, 0), cB + kstep, voffB); PG8_STAGE(PG8_SA(1, 0), cA + kstep, voffA); PG8_STAGE(PG8_SB(1, 1), cB + hstep + kstep, voffB);
    PG8_WAIT_V(6); PG8_BAR;
    for (;;) {
        const bool has_next = S.next(ui + 1, nxt);
        const char* nA = has_next ? nxt.a : cA; const char* nB = has_next ? nxt.b : cB;
        for (int t = 0; t < nt; t += 2) {
            const bool last = (t == nt - 2);
            const char* a1 = cA + (size_t)(t + 1) * kstep;
            const char* a2 = last ? nA : cA + (size_t)(t + 2) * kstep; const char* b2 = last ? nB : cB + (size_t)(t + 2) * kstep;
            const char* a3 = a2 + kstep; const char* b3 = b2 + kstep;
            PG8_LDB(B0, 0, 0); PG8_LDB(B1, 0, 1); PG8_SCHED; PG8_LDA(At, 0, 0); PG8_STAGE(PG8_SA(1, 1), a1 + hstep, voffA);
            PG8_WAIT_V(8); PG8_WAIT_L(0); PG8_BAR; PG8_MMA(0, 0, At, B0); PG8_MMA(0, 1, At, B1); PG8_BAR; PG8_SCHED;
            PG8_LDA(At, 0, 1); PG8_STAGE(PG8_SB(0, 0), b2, voffB); PG8_STAGE(PG8_SB(0, 1), b2 + hstep, voffB); PG8_STAGE(PG8_SA(0, 0), a2, voffA);
            PG8_WAIT_V(8); PG8_WAIT_L(0); PG8_BAR; PG8_MMA(1, 0, At, B0); PG8_MMA(1, 1, At, B1); PG8_BAR; PG8_SCHED;
            PG8_LDB(B0, 1, 0); PG8_LDB(B1, 1, 1); PG8_SCHED; PG8_LDA(At, 1, 0); PG8_STAGE(PG8_SA(0, 1), a2 + hstep, voffA);
            PG8_WAIT_V(8); PG8_WAIT_L(0); PG8_BAR; PG8_MMA(0, 0, At, B0); PG8_MMA(0, 1, At, B1); PG8_BAR; PG8_SCHED;
            PG8_LDA(At, 1, 1); PG8_STAGE(PG8_SB(1, 0), b3, voffB); PG8_STAGE(PG8_SB(1, 1), b3 + hstep, voffB); PG8_STAGE(PG8_SA(1, 0), a3, voffA);
            PG8_WAIT_V(8); PG8_WAIT_L(0); PG8_BAR; PG8_MMA(1, 0, At, B0); PG8_MMA(1, 1, At, B1); PG8_BAR; PG8_SCHED;
        }
        if (wr == 0) PG8_BAR;
        E(acc, cur, wr, wc, fr, fq);
        if (!has_next) break;
#pragma unroll
        for (int a = 0; a < 2; ++a)
#pragma unroll
            for (int b = 0; b < 2; ++b)
#pragma unroll
                for (int m = 0; m < 4; ++m)
#pragma unroll
                    for (int n = 0; n < 2; ++n) acc[a][b][m][n] = (f32x4){0.f, 0.f, 0.f, 0.f};
        cur = nxt; cA = nA; cB = nB; ++ui;
        if (wr == 1) PG8_BAR;
    }
    PG8_WAIT_V(0);
    PG8_BAR;
#undef PG8_SA
#undef PG8_SB
#undef PG8_STAGE
#undef PG8_LDA
#undef PG8_LDB
#undef PG8_MMA
#undef PG8_WAIT_V
#undef PG8_WAIT_L
#undef PG8_BAR
#undef PG8_SCHED
}
}
__device__ __forceinline__ int wrowmap(int kind, int n0) {
    if (kind == 0) { if (n0 < 768) return n0; if (n0 < 1792) return 1280 + (n0 - 768); if (n0 < 2304) return 768 + (n0 - 1792); return n0; }
    if (kind == 2) { if (n0 < DFF) return 256 * (n0 / 128) + (n0 % 128); const int m = n0 - DFF; return 256 * (m / 128) + 128 + (m % 128); }
    return n0;
}
__device__ __forceinline__ void transpose_item(const float* W, int K, int N, bf16_t* WT, int kind, LAS float* scr, int item, int lane) {
    const int nblk = N / 32, kb = item / nblk, nb = item % nblk, k0 = 64 * kb, n0 = 32 * nb, r0 = wrowmap(kind, n0);
    float wv[32];
#pragma unroll
    for (int i = 0; i < 32; ++i) { const int kk = 2 * i + (lane >> 5); wv[i] = W[(size_t)(k0 + kk) * N + n0 + (lane & 31)]; }
#pragma unroll
    for (int i = 0; i < 32; ++i) { const int kk = 2 * i + (lane >> 5); scr[kk * 33 + (lane & 31)] = wv[i]; }
    asm volatile("s_waitcnt lgkmcnt(0)" ::: "memory");
    const int c = lane & 7;
#pragma unroll
    for (int j = 0; j < 4; ++j) { const int n = (lane >> 3) + 8 * j; const LAS float* s = scr + (8 * c) * 33 + n;
        u32x4 o; o.x = pk2(s[0 * 33], s[1 * 33]); o.y = pk2(s[2 * 33], s[3 * 33]); o.z = pk2(s[4 * 33], s[5 * 33]); o.w = pk2(s[6 * 33], s[7 * 33]);
        *(u32x4*)(WT + (size_t)(r0 + n) * K + k0 + 8 * c) = o; }
    asm volatile("s_waitcnt lgkmcnt(0)" ::: "memory");
}
constexpr int WI_IN = (D / 64) * (INW / 32), WI_OUT = (D / 64) * (D / 32), WI_GU = (D / 64) * (2 * DFF / 32), WI_DN = (DFF / 64) * (D / 32), WI_LAYER = WI_IN + WI_OUT + WI_GU + WI_DN;
__device__ __forceinline__ void wconv_item(int it, const float* w_in, const float* w_out, const float* w_gu, const float* w_dn, unsigned char* ws, LAS float* scr, int lane) {
    const int l = it / WI_LAYER; int r = it % WI_LAYER;
    if (r < WI_IN) { transpose_item(w_in + (size_t)l * D * INW, D, INW, (bf16_t*)(ws + WS_WIN) + (size_t)l * INW * D, 0, scr, r, lane); return; } r -= WI_IN;
    if (r < WI_OUT) { transpose_item(w_out + (size_t)l * D * D, D, D, (bf16_t*)(ws + WS_WOUT) + (size_t)l * D * D, 1, scr, r, lane); return; } r -= WI_OUT;
    if (r < WI_GU) { transpose_item(w_gu + (size_t)l * D * 2 * DFF, D, 2 * DFF, (bf16_t*)(ws + WS_WGU) + (size_t)l * 2 * DFF * D, 2, scr, r, lane); return; } r -= WI_GU;
    transpose_item(w_dn + (size_t)l * DFF * D, DFF, D, (bf16_t*)(ws + WS_WDN) + (size_t)l * D * DFF, 1, scr, r, lane);
}
static __device__ constexpr float C32T[16] = {1.000000000e+00f, 9.807852804e-01f, 9.238795325e-01f, 8.314696123e-01f, 7.071067812e-01f, 5.555702330e-01f, 3.826834324e-01f, 1.950903220e-01f, 0.0f, -1.950903220e-01f, -3.826834324e-01f, -5.555702330e-01f, -7.071067812e-01f, -8.314696123e-01f, -9.238795325e-01f, -9.807852804e-01f};
static __device__ constexpr float S32T[16] = {0.000000000e+00f, 1.950903220e-01f, 3.826834324e-01f, 5.555702330e-01f, 7.071067812e-01f, 8.314696123e-01f, 9.238795325e-01f, 9.807852804e-01f, 1.000000000e+00f, 9.807852804e-01f, 9.238795325e-01f, 8.314696123e-01f, 7.071067812e-01f, 5.555702330e-01f, 3.826834324e-01f, 1.950903220e-01f};
static __device__ constexpr float C64T[32] = {1.000000000e+00f, 9.951847267e-01f, 9.807852804e-01f, 9.569403357e-01f, 9.238795325e-01f, 8.819212643e-01f, 8.314696123e-01f, 7.730104534e-01f, 7.071067812e-01f, 6.343932842e-01f, 5.555702330e-01f, 4.713967368e-01f, 3.826834324e-01f, 2.902846773e-01f, 1.950903220e-01f, 9.801714033e-02f, 0.0f, -9.801714033e-02f, -1.950903220e-01f, -2.902846773e-01f, -3.826834324e-01f, -4.713967368e-01f, -5.555702330e-01f, -6.343932842e-01f, -7.071067812e-01f, -7.730104534e-01f, -8.314696123e-01f, -8.819212643e-01f, -9.238795325e-01f, -9.569403357e-01f, -9.807852804e-01f, -9.951847267e-01f};
static __device__ constexpr float S64T[32] = {0.000000000e+00f, 9.801714033e-02f, 1.950903220e-01f, 2.902846773e-01f, 3.826834324e-01f, 4.713967368e-01f, 5.555702330e-01f, 6.343932842e-01f, 7.071067812e-01f, 7.730104534e-01f, 8.314696123e-01f, 8.819212643e-01f, 9.238795325e-01f, 9.569403357e-01f, 9.807852804e-01f, 9.951847267e-01f, 1.000000000e+00f, 9.951847267e-01f, 9.807852804e-01f, 9.569403357e-01f, 9.238795325e-01f, 8.819212643e-01f, 8.314696123e-01f, 7.730104534e-01f, 7.071067812e-01f, 6.343932842e-01f, 5.555702330e-01f, 4.713967368e-01f, 3.826834324e-01f, 2.902846773e-01f, 1.950903220e-01f, 9.801714033e-02f};

namespace fft {
constexpr int L = SEQ, N2 = 2 * SEQ;
constexpr int XSLOTS = 17904;
constexpr int LDS_X_BYTES = XSLOTS * 8;
constexpr int LDS_RED = LDS_X_BYTES;
typedef LAS f32x2* xptr;
typedef unsigned spec_t;
__device__ __forceinline__ unsigned pack_h2(float lo, float hi) { typedef _Float16 h2v __attribute__((ext_vector_type(2))); const h2v v = {(_Float16)lo, (_Float16)hi}; return __builtin_bit_cast(unsigned, v); }
__device__ __forceinline__ f32x2 unpack_h2(unsigned w) { typedef _Float16 h2v __attribute__((ext_vector_type(2))); const h2v v = __builtin_bit_cast(h2v, w); return (f32x2){(float)v.x, (float)v.y}; }
__device__ __forceinline__ f32x2 cmul(f32x2 a, f32x2 b) { return (f32x2){a.x * b.x - a.y * b.y, a.x * b.y + a.y * b.x}; }
__device__ __forceinline__ f32x2 cmulc(f32x2 a, f32x2 b) { return (f32x2){a.x * b.x + a.y * b.y, a.y * b.x - a.x * b.y}; }
__device__ __forceinline__ f32x2 expi(float x) { float s, c; sincospif(x, &s, &c); return (f32x2){c, s}; }
constexpr __host__ __device__ int bitrev(int j, int R) { int r = 0; for (int b = 1; b < R; b <<= 1) { r = (r << 1) | (j & 1); j >>= 1; } return r; }

template <int R, int S, bool INV> struct Stage {
    static __device__ __forceinline__ void run(f32x2 (&a)[R]) {
#pragma unroll
        for (int base = 0; base < R; base += 2 * S)
#pragma unroll
            for (int k = 0; k < S; ++k) {
                const int i0 = base + k, i1 = i0 + S, ti = k * (16 / S);
                const f32x2 u = a[i0], v = a[i1]; a[i0] = u + v; const f32x2 d = u - v;
                if (ti == 0) a[i1] = d;
                else if (ti == 8) a[i1] = INV ? (f32x2){-d.y, d.x} : (f32x2){d.y, -d.x};
                else { const float c = C32T[ti], s = S32T[ti]; a[i1] = INV ? (f32x2){d.x * c - d.y * s, d.x * s + d.y * c} : (f32x2){d.x * c + d.y * s, d.y * c - d.x * s}; }
            }
        if constexpr (S > 1) Stage<R, S / 2, INV>::run(a);
    }
};
template <int R, bool INV> __device__ __forceinline__ void dft(f32x2 (&a)[R]) {
    Stage<R, R / 2, INV>::run(a);
    f32x2 t[R];
#pragma unroll
    for (int j = 0; j < R; ++j) t[j] = a[bitrev(j, R)];
#pragma unroll
    for (int j = 0; j < R; ++j) a[j] = t[j];
}
template <int R, bool CONJ> __device__ __forceinline__ void twiddle(f32x2 (&a)[R], f32x2 w) {
    f32x2 tw[R]; tw[0] = (f32x2){1.f, 0.f}; tw[1] = w;
#pragma unroll
    for (int j = 2; j < R; ++j) tw[j] = cmul(tw[j >> 1], tw[j - (j >> 1)]);
#pragma unroll
    for (int j = 1; j < R; ++j) a[j] = CONJ ? cmulc(a[j], tw[j]) : cmul(a[j], tw[j]);
}
__device__ __forceinline__ void bar() { __syncthreads(); }
__device__ __forceinline__ int opaque(int v) { return opaque_i(v); }

__device__ __forceinline__ void fwd12(xptr X, int tid) {
    f32x2 a[32];
    { const int p0 = tid + (tid >> 4);
#pragma unroll
      for (int q = 0; q < 32; ++q) a[q] = X[p0 + 560 * q];
      dft<32, false>(a); twiddle<32, false>(a, expi(-(float)opaque(tid) * (1.0f / 8192.0f)));
#pragma unroll
      for (int q = 0; q < 32; ++q) X[p0 + 560 * q] = a[q]; }
    bar();
    { const int blk = tid >> 4, np = tid & 15, p0 = 560 * blk + np;
#pragma unroll
      for (int q = 0; q < 32; ++q) a[q] = X[p0 + 17 * q];
      dft<32, false>(a); twiddle<32, false>(a, expi(-(float)opaque(np) * (1.0f / 256.0f)));
#pragma unroll
      for (int q = 0; q < 32; ++q) X[p0 + 17 * q] = a[q]; }
    bar();
}
__device__ __forceinline__ void inv21(xptr X, int tid, f32x2 (&a)[32]) {
    { const int blk = tid >> 4, np = tid & 15, p0 = 560 * blk + np;
#pragma unroll
      for (int q = 0; q < 32; ++q) a[q] = X[p0 + 17 * q];
      twiddle<32, true>(a, expi(-(float)opaque(np) * (1.0f / 256.0f))); dft<32, true>(a);
#pragma unroll
      for (int q = 0; q < 32; ++q) X[p0 + 17 * q] = a[q]; }
    bar();
    { const int p0 = tid + (tid >> 4);
#pragma unroll
      for (int q = 0; q < 32; ++q) a[q] = X[p0 + 560 * q];
      twiddle<32, true>(a, expi(-(float)opaque(tid) * (1.0f / 8192.0f))); dft<32, true>(a); }
}
template <int MODE> __device__ __forceinline__ void pass3(xptr X, int tid, spec_t* G, float scale) {
    u32x2 kv[2][8];
    if (MODE == 1) {
#pragma unroll
        for (int gi = 0; gi < 2; ++gi)
#pragma unroll
            for (int j2 = 0; j2 < 8; ++j2) kv[gi][j2] = *(const u32x2*)(G + j2 * 2048 + 2 * (tid + 512 * gi));
    }
#pragma unroll
    for (int gi = 0; gi < 2; ++gi) {
        const int g = tid + 512 * gi, p0 = 17 * g + 16 * (g >> 5);
        f32x2 a[16];
#pragma unroll
        for (int q = 0; q < 16; ++q) a[q] = X[p0 + q];
        dft<16, false>(a);
        if (MODE == 0) {
#pragma unroll
            for (int j = 0; j < 16; j += 2) { u32x2 o; o.x = pack_h2(a[j].x * scale, a[j].y * scale); o.y = pack_h2(a[j + 1].x * scale, a[j + 1].y * scale); *(u32x2*)(G + (j >> 1) * 2048 + 2 * g) = o; }
        } else {
#pragma unroll
            for (int j = 0; j < 16; j += 2) { const u32x2 k2 = kv[gi][j >> 1]; a[j] = cmul(a[j], unpack_h2(k2.x)); a[j + 1] = cmul(a[j + 1], unpack_h2(k2.y)); }
            dft<16, true>(a);
#pragma unroll
            for (int q = 0; q < 16; ++q) X[p0 + q] = a[q];
        }
        asm volatile("" ::: "memory");
    }
    if (MODE == 1) bar();
}
__device__ __forceinline__ f32x2 wN(f32x2 base, int q) { return cmul(base, (f32x2){C64T[q], -S64T[q]}); }

__device__ __forceinline__ void filter_unit(LAS unsigned char* lds, const bf16_t* kf, const bf16_t* kb, spec_t* KFo) {
    xptr X = (xptr)lds; LAS float* red = (LAS float*)(lds + LDS_RED);
    const int tid = opaque_i(threadIdx.x), p0 = tid + (tid >> 4);
    const f32x2 base = expi(-(float)tid * (1.0f / 16384.0f));
    float nrm = 0.f;
    {   float fv[32], bv[32];
#pragma unroll
        for (int q = 0; q < 32; ++q) { const int n = tid + 512 * q; fv[q] = bf2f(kf[n]); bv[q] = bf2f(kb[n >= 1 ? L - n : 0]); }
#pragma unroll
        for (int q = 0; q < 32; ++q) { const int n = tid + 512 * q; const float f = fv[q], b = n >= 1 ? bv[q] : 0.f; nrm += fabsf(f) + fabsf(b); X[p0 + 560 * q] = (f32x2){f + b, 0.f}; } }
    nrm = wave_sum(nrm); if ((tid & 63) == 0) red[tid >> 6] = nrm;
    bar();
    float tot = 0.f;
#pragma unroll
    for (int i = 0; i < 8; ++i) tot += red[i];
    const float scale = 1.0f / tot;
    fwd12(X, tid); pass3<0>(X, tid, KFo, scale);
    bar();
    asm volatile("" ::: "memory");
    {   float fv[32], bv[32];
        const int tq = opaque(tid);
#pragma unroll
        for (int q = 0; q < 32; ++q) { const int n = tq + 512 * q; fv[q] = bf2f(kf[n]); bv[q] = bf2f(kb[n >= 1 ? L - n : 0]); }
#pragma unroll
        for (int q = 0; q < 32; ++q) { const int n = tq + 512 * q; const float d = fv[q] - (n >= 1 ? bv[q] : 0.f); const f32x2 w = wN(base, q); X[p0 + 560 * q] = (f32x2){d * w.x, d * w.y}; } }
    bar();
    fwd12(X, tid); pass3<0>(X, tid, KFo + L, scale);
    bar();
}

__device__ __forceinline__ void stage_row(LAS unsigned char* lds, const bf16_t* row, int tid_) {
    const int tid = opaque(tid_), wv = __builtin_amdgcn_readfirstlane(tid >> 6), lane = tid & 63;
#pragma unroll
    for (int it = 0; it < 8; ++it) { const int e = (it * 8 + wv) * 64 + lane, b = e >> 11, ck = e & 2047;
        __builtin_amdgcn_global_load_lds((const unsigned*)(row + (size_t)b * SEQ + 8 * ck), (LAS unsigned*)(lds + (it * 8 + wv) * 1024), 16, 0, 0); }
}
__device__ __forceinline__ f32x2 conv3_lds(const LAS bf16_t* S, int n, float w0, float w1, float w2, float wb) {
    const int nm = n > 0 ? n - 1 : 0, np = n + 1 < SEQ ? n + 1 : SEQ - 1; const float wm = n > 0 ? w0 : 0.f, wp = n + 1 < SEQ ? w2 : 0.f;
    const float a0 = wb + w1 * bf2f(S[n]) + wm * bf2f(S[nm]) + wp * bf2f(S[np]);
    const float a1 = wb + w1 * bf2f(S[SEQ + n]) + wm * bf2f(S[SEQ + nm]) + wp * bf2f(S[SEQ + np]);
    return (f32x2){a0, a1};
}
__device__ __forceinline__ void hyena_unit(LAS unsigned char* lds, int c, const bf16_t* PTV, const spec_t* KFc, size_t ostride, const float* cw, const float* cb, const float* hbias,
                                           unsigned* Zs, unsigned* Rs, bf16_t* YMIX, int pm = 0) {
    xptr X = (xptr)lds;
    const int tid = opaque_i(threadIdx.x), p0 = tid + (tid >> 4);
#ifdef MK_HY_EXTRA
    for (int xr_ = 0; xr_ < MK_HY_EXTRA; ++xr_) {
        f32x2 dmy[32];
        bar(); fwd12(X, tid); pass3<1>(X, tid, KFc, 1.f); inv21(X, tid, dmy);
#pragma unroll
        for (int q = 0; q < 32; ++q) asm volatile("" :: "v"(dmy[q].x), "v"(dmy[q].y));
        bar();
    }
#endif
    f32x2 a[32];
    { const float w0 = cw[c], w1 = cw[768 + c], w2 = cw[1536 + c], wb = cb[c];
      bar(); stage_row(lds, PTV + (size_t)c * MT, tid); bar();
      const int t0 = opaque(tid);
#pragma unroll
      for (int q0 = 0; q0 < 32; q0 += 8) {
#pragma unroll
          for (int q = q0; q < q0 + 8; ++q) a[q] = conv3_lds((const LAS bf16_t*)lds, t0 + 512 * q, w0, w1, w2, wb);
          asm volatile("" ::: "memory"); }
      bar(); }
#pragma unroll 1
    for (int order = 0; order < 2; ++order) {
        const spec_t* Ke = KFc + (size_t)order * ostride; const spec_t* Ko = Ke + L;
        { const int t1 = opaque(tid);
#pragma unroll
          for (int q = 0; q < 32; ++q) { const unsigned zp = pg8::cvt_pk_bf16(a[q].x, a[q].y); Zs[t1 + 512 * q] = zp; X[p0 + 560 * q] = (f32x2){bf2f(zp & 0xffffu), bf2f(zp >> 16)}; } }
        bar();
#ifdef MK_HY_PM
        if (!(pm & 2))
#endif
        { fwd12(X, tid); pass3<1>(X, tid, const_cast<spec_t*>(Ke), 1.f); inv21(X, tid, a); }
        { const int t2 = opaque(tid);
#pragma unroll
          for (int q = 0; q < 32; ++q) Rs[t2 + 512 * q] = pg8::cvt_pk_bf16(a[q].x, a[q].y); }
        asm volatile("" ::: "memory");
        const int t3 = opaque(tid); const f32x2 base1 = expi(-(float)t3 * (1.0f / 16384.0f));
#pragma unroll
        for (int q = 0; q < 32; ++q) { const unsigned zp = Zs[t3 + 512 * q]; a[q] = (f32x2){bf2f(zp & 0xffffu), bf2f(zp >> 16)}; }
#pragma unroll
        for (int q = 0; q < 32; ++q) X[p0 + 560 * q] = cmul(a[q], wN(base1, q));
        bar();
#ifdef MK_HY_PM
        if (!(pm & 2))
#endif
        { fwd12(X, tid); pass3<1>(X, tid, const_cast<spec_t*>(Ko), 1.f); inv21(X, tid, a); }
        const int grow = (order == 0 ? 256 : 512) + c;
        const float g0 = cw[grow], g1 = cw[768 + grow], g2 = cw[1536 + grow], gb = cb[grow], hb = hbias[order * 256 + c];
        { const int t4 = opaque(tid); const f32x2 base2 = expi(-(float)t4 * (1.0f / 16384.0f));
#pragma unroll
          for (int q0 = 0; q0 < 32; q0 += 16) { unsigned r1p[16];
#pragma unroll
              for (int q = 0; q < 16; ++q) r1p[q] = Rs[t4 + 512 * (q0 + q)];
#pragma unroll
              for (int q = 0; q < 16; ++q) a[q0 + q] = (f32x2){bf2f(r1p[q] & 0xffffu), bf2f(r1p[q] >> 16)} + cmulc(a[q0 + q], wN(base2, q0 + q));
              asm volatile("" ::: "memory"); } }
        bar();
        stage_row(lds, PTV + (size_t)grow * MT, tid);
        bar();
        { const int t5 = opaque(tid);
#pragma unroll
          for (int q0 = 0; q0 < 32; q0 += 16) { unsigned zqp[16];
#pragma unroll
              for (int q = 0; q < 16; ++q) zqp[q] = Zs[t5 + 512 * (q0 + q)];
#pragma unroll
              for (int q = 0; q < 16; ++q) { const f32x2 gt = conv3_lds((const LAS bf16_t*)lds, t5 + 512 * (q0 + q), g0, g1, g2, gb);
                  a[q0 + q] = (f32x2){gt.x * (a[q0 + q].x * (1.0f / (float)N2) + hb * bf2f(zqp[q] & 0xffffu)), gt.y * (a[q0 + q].y * (1.0f / (float)N2) + hb * bf2f(zqp[q] >> 16))}; }
              asm volatile("" ::: "memory"); } }
        bar();
    }
#ifdef MK_HY_PM
    if (!(pm & 1))
#endif
    { bf16_t* yp = YMIX + (size_t)tid * D + c;
#pragma unroll
      for (int q = 0; q < 32; ++q) { { const unsigned pw_ = pg8::cvt_pk_bf16(a[q].x, a[q].y); yp[0] = (bf16_t)(pw_ & 0xffffu); yp[(size_t)SEQ * D] = (bf16_t)(pw_ >> 16); } yp += (size_t)512 * D; asm volatile("" : "+v"(yp)); } }
}
}

constexpr int MK_LDS_BYTES = 147456;
static_assert(fft::LDS_RED + 64 <= MK_LDS_BYTES, "LDS map");
namespace lru {
constexpr int TC = 64, NCH = 260, NSU = 130;
constexpr int RS = 264, RSB = RS * 2;
constexpr int XR_OFF = 0, XR_BYTES = (TC + 3) * RSB;
constexpr int XG_OFF = XR_OFF + XR_BYTES;
constexpr int HY_OFF = XG_OFF + TC * RSB;
constexpr int CW_OFF = HY_OFF + TC * RSB;
constexpr int CAR_OFF = CW_OFF + 5 * 1024;
constexpr int U_OFF = CAR_OFF + 4 * 1024;
constexpr int LDS_END = U_OFF + TC * RSB;
static_assert(LDS_END <= 147456 - 64 && (U_OFF % 16) == 0 && (XG_OFF % 16) == 0 && (HY_OFF % 16) == 0 && (CW_OFF % 16) == 0, "lru LDS map");
constexpr float LOG2E = 1.4426950408889634f;
struct Params {
    const bf16_t* QKL; const bf16_t* LW;
    const float *cw, *cb, *ba, *bi, *lam;
    f32x2* AGG;
    bf16_t* YMIX;
};
__device__ __forceinline__ int chunk_row0(int b, int k) { return k < 4 ? NLAT + b * CTXL + 64 * k : b * SEQ + 64 * (k - 4); }
__device__ __forceinline__ float fsig(float x) { return __builtin_amdgcn_rcpf(1.0f + __builtin_amdgcn_exp2f(-LOG2E * x)); }

struct LaneConst { int ch[2]; };
struct DirConst { bf16x8 Bf[2][2][2]; float ba[2], bi[2], sp2[2]; };
__device__ __forceinline__ void load_dir(const Params& P, int dir, int n, int hf, int l15, int kg, const LaneConst& lc, DirConst& dc) {
#pragma unroll
    for (int ty = 0; ty < 2; ++ty)
#pragma unroll
        for (int cc = 0; cc < 2; ++cc)
#pragma unroll
            for (int ks = 0; ks < 2; ++ks) dc.Bf[ty][cc][ks] = *(const bf16x8*)(P.LW + ((((size_t)dir * 4 + n) * 2 + ty) * 64 + 32 * hf + 16 * cc + l15) * 64 + 32 * ks + 8 * kg);
#pragma unroll
    for (int cc = 0; cc < 2; ++cc) { dc.ba[cc] = P.ba[dir * 256 + lc.ch[cc]]; dc.bi[cc] = P.bi[dir * 256 + lc.ch[cc]]; dc.sp2[cc] = -8.0f * LOG2E * log1pf(expf(-P.lam[dir * 256 + lc.ch[cc]])); }
}
template <bool FINAL, int DIR>
__device__ __forceinline__ void tile_dir(LAS unsigned char* lds, const LaneConst& lc, const DirConst& dc, int n, int lane, int ss, LAS bf16_t* Hs, float (&car)[2], float (&Pm)[2], float (&Qm)[2]) {
    const int l15 = lane & 15, kg = lane >> 4;
    const LAS bf16_t* UU = (const LAS bf16_t*)(lds + U_OFF);
    bf16x8 Af[2];
#pragma unroll
    for (int ks = 0; ks < 2; ++ks) Af[ks] = *(const LAS bf16x8*)(UU + (16 * ss + l15) * RS + 64 * n + 32 * ks + 8 * kg);
#pragma unroll
    for (int cc = 0; cc < 2; ++cc) {
        f32x4 ar = (f32x4){0.f, 0.f, 0.f, 0.f}, ai = ar;
        ar = __builtin_amdgcn_mfma_f32_16x16x32_bf16(Af[0], dc.Bf[0][cc][0], ar, 0, 0, 0); ar = __builtin_amdgcn_mfma_f32_16x16x32_bf16(Af[1], dc.Bf[0][cc][1], ar, 0, 0, 0);
        ai = __builtin_amdgcn_mfma_f32_16x16x32_bf16(Af[0], dc.Bf[1][cc][0], ai, 0, 0, 0); ai = __builtin_amdgcn_mfma_f32_16x16x32_bf16(Af[1], dc.Bf[1][cc][1], ai, 0, 0, 0);
        const int ch = lc.ch[cc];
        float av[4], bv[4];
#pragma unroll
        for (int rg = 0; rg < 4; ++rg) { const int r = 16 * ss + 4 * kg + rg;
            const float u = bf2f(UU[r * RS + ch]);
            const float rgt = fsig(ar[rg] + dc.ba[cc]), igt = fsig(ai[rg] + dc.bi[cc]);
            const float x2 = rgt * dc.sp2[cc]; const float a = __builtin_amdgcn_exp2f(x2), a2 = a * a;
            av[rg] = a; bv[rg] = __builtin_amdgcn_sqrtf(fmaxf(1.0f - a2, 0.f)) * (igt * u); }
        float Pl = 1.f, Ql = 0.f;
#pragma unroll
        for (int i = 0; i < 4; ++i) { const int rg = DIR == 0 ? i : 3 - i; Ql = av[rg] * Ql + bv[rg]; Pl *= av[rg]; }
        const int pos = DIR == 0 ? kg : 3 - kg;
        { const int src = DIR == 0 ? lane - 16 : lane + 16; const float Pp = __shfl(Pl, src), Qp = __shfl(Ql, src); if (pos >= 1) { Ql = Pl * Qp + Ql; Pl = Pl * Pp; } }
        { const int src = DIR == 0 ? lane - 32 : lane + 32; const float Pp = __shfl(Pl, src), Qp = __shfl(Ql, src); if (pos >= 2) { Ql = Pl * Qp + Ql; Pl = Pl * Pp; } }
        const int lastsrc = DIR == 0 ? l15 + 48 : l15;
        const float Pt = __shfl(Pl, lastsrc), Qt = __shfl(Ql, lastsrc);
        if (FINAL) {
            const int src = DIR == 0 ? lane - 16 : lane + 16; float Pe = __shfl(Pl, src), Qe = __shfl(Ql, src); if (pos == 0) { Pe = 1.f; Qe = 0.f; }
            float h = Pe * car[cc] + Qe;
#pragma unroll
            for (int i = 0; i < 4; ++i) { const int rg = DIR == 0 ? i : 3 - i; h = av[rg] * h + bv[rg]; Hs[(16 * ss + 4 * kg + rg) * RS + ch] = (bf16_t)pg8::cvt_pk_bf16(h, h); }
            car[cc] = Pt * car[cc] + Qt;
        } else { Qm[cc] = Pt * Qm[cc] + Qt; Pm[cc] = Pt * Pm[cc]; }
    }
}
__device__ __forceinline__ void load_chunk(LAS unsigned char* lds, const Params& P, int b, int k, bool with_xg, int tid) {
    const int Ls = k < 4 ? CTXL : SEQ, kk = k < 4 ? k : k - 4, seq0 = k < 4 ? NLAT + b * CTXL : b * SEQ, t0 = 64 * kk - 2;
    {   u32x4 vr[5];
#pragma unroll
        for (int i5 = 0; i5 < 5; ++i5) { const int e = tid + 512 * i5, i = e >> 5, cchunk = e & 31, t = t0 + i;
            vr[i5] = (u32x4){0u, 0u, 0u, 0u};
            if (e < (TC + 3) * 32 && t >= 0 && t < Ls) vr[i5] = *(const u32x4*)(P.QKL + (size_t)(seq0 + t) * NQKL + 1024 + 8 * cchunk); }
#pragma unroll
        for (int i5 = 0; i5 < 5; ++i5) { const int e = tid + 512 * i5, i = e >> 5, cchunk = e & 31; if (e < (TC + 3) * 32) *(LAS u32x4*)(lds + XR_OFF + i * RSB + cchunk * 16) = vr[i5]; }
        asm volatile("" ::: "memory"); }
    if (with_xg) { u32x4 vg[4];
#pragma unroll
        for (int i4 = 0; i4 < 4; ++i4) { const int e = tid + 512 * i4, i = e >> 5, cchunk = e & 31; vg[i4] = *(const u32x4*)(P.QKL + (size_t)(seq0 + 64 * kk + i) * NQKL + 1280 + 8 * cchunk); }
#pragma unroll
        for (int i4 = 0; i4 < 4; ++i4) { const int e = tid + 512 * i4, i = e >> 5, cchunk = e & 31; *(LAS u32x4*)(lds + XG_OFF + i * RSB + cchunk * 16) = vg[i4]; }
    }
}
template <bool FINAL>
__device__ __forceinline__ void super_unit(LAS unsigned char* lds, const Params& P, int su) {
    const int tid = opaque_i(threadIdx.x), lane = tid & 63, wid = tid >> 6, n = wid >> 1, hf = wid & 1, l15 = lane & 15, kg = lane >> 4;
    const bool isctx = su >= 256; const int b = isctx ? (su - 256) >> 2 : su >> 7, s = isctx ? ((su - 256) & 3) >> 1 : 2 + (su & 127), k0 = isctx ? (su - 256) & 3 : 2 * s, nchk = isctx ? 1 : 2;
    LAS float* CW = (LAS float*)(lds + CW_OFF); LAS float* CAR = (LAS float*)(lds + CAR_OFF);
    f32x2* AGG64 = P.AGG; f32x2* AGG128 = P.AGG + (size_t)2 * NCH * 2 * 256;
    __syncthreads();
    for (int e = tid; e < 5 * 256; e += 512) CW[e] = e < 1024 ? P.cw[e] : P.cb[e - 1024];
    if (FINAL) {
        const int dir = tid >> 8, ch = tid & 255;
        const f32x2* a64 = AGG64 + ((size_t)b * NCH * 2 + dir) * 256 + ch;
        const f32x2* a128 = AGG128 + ((size_t)b * NSU * 2 + dir) * 256 + ch;
        const int nc = isctx ? (dir == 0 ? k0 : 3 - k0) : 4;
        const int npos = nc + (isctx ? 0 : (dir == 0 ? s - 2 : 129 - s));
        float h = 0.f;
#pragma unroll 1
        for (int p0 = 0; p0 < 132; p0 += 33) {
            if (p0 >= npos) break;
            f32x2 v[33];
#pragma unroll
            for (int i = 0; i < 33; ++i) { const int p = p0 + i, pc = p < npos ? p : 0;
                const f32x2* src = pc < nc ? a64 + (size_t)(dir == 0 ? pc : 3 - pc) * 512 : a128 + (size_t)(dir == 0 ? 2 + (pc - nc) : 129 - (pc - nc)) * 512;
                v[i] = *src; }
#pragma unroll
            for (int i = 0; i < 33; ++i) { const bool live = p0 + i < npos; h = (live ? v[i].x : 1.f) * h + (live ? v[i].y : 0.f); }
        }
        if (dir == 0) CAR[0 * 512 + ch] = h;
        else if (isctx) CAR[0 * 512 + 256 + ch] = h;
        else { CAR[1 * 512 + 256 + ch] = h; const f32x2 v = AGG64[(((size_t)b * NCH + k0 + 1) * 2 + 1) * 256 + ch]; CAR[0 * 512 + 256 + ch] = v.x * h + v.y; }
    }
    LaneConst lc;
#pragma unroll
    for (int cc = 0; cc < 2; ++cc) lc.ch[cc] = 64 * n + 32 * hf + 16 * cc + l15;
    float car0[2] = {0.f, 0.f};
    float P0m[2][2], Q0m[2][2];
#pragma unroll 1
    for (int j = 0; j < nchk; ++j) {
        const int k = k0 + j, row0 = chunk_row0(b, k);
        if (j > 0) __syncthreads();
#ifdef MK_LRU_XL
        if (!FINAL) for (int xl_ = 0; xl_ < MK_LRU_XL; ++xl_) { load_chunk(lds, P, b, k, FINAL, tid); __syncthreads(); }
#endif
        load_chunk(lds, P, b, k, FINAL, tid);
        __syncthreads();
        {
            const int cg8 = 8 * (tid & 31); const LAS float* CWr = (const LAS float*)(lds + CW_OFF); const LAS bf16_t* XRr = (const LAS bf16_t*)(lds + XR_OFF);
            f32x4 wl[5], wh[5];
#pragma unroll
            for (int kx = 0; kx < 5; ++kx) { wl[kx] = *(const LAS f32x4*)(CWr + kx * 256 + cg8); wh[kx] = *(const LAS f32x4*)(CWr + kx * 256 + cg8 + 4); }
#pragma unroll
            for (int i = 0; i < 4; ++i) { const int tok = (tid >> 5) + 16 * i; f32x4 lo = wl[4], hi = wh[4];
#pragma unroll
                for (int kx = 0; kx < 4; ++kx) { const u32x4 xw = *(const LAS u32x4*)(XRr + (tok + kx) * RS + cg8);
                    lo[0] += wl[kx][0] * bf2f(xw.x & 0xffffu); lo[1] += wl[kx][1] * bf2f(xw.x >> 16); lo[2] += wl[kx][2] * bf2f(xw.y & 0xffffu); lo[3] += wl[kx][3] * bf2f(xw.y >> 16);
                    hi[0] += wh[kx][0] * bf2f(xw.z & 0xffffu); hi[1] += wh[kx][1] * bf2f(xw.z >> 16); hi[2] += wh[kx][2] * bf2f(xw.w & 0xffffu); hi[3] += wh[kx][3] * bf2f(xw.w >> 16); }
                u32x4 pw; pw.x = pg8::cvt_pk_bf16(lo[0], lo[1]); pw.y = pg8::cvt_pk_bf16(lo[2], lo[3]); pw.z = pg8::cvt_pk_bf16(hi[0], hi[1]); pw.w = pg8::cvt_pk_bf16(hi[2], hi[3]);
                *(LAS u32x4*)(lds + U_OFF + tok * RSB + cg8 * 2) = pw; }
        }
        __syncthreads();
        {
            float carF[2], carR[2], PmF[2] = {1.f, 1.f}, QmF[2] = {0.f, 0.f}, PmR[2] = {1.f, 1.f}, QmR[2] = {0.f, 0.f};
            if (FINAL) {
#pragma unroll
                for (int cc = 0; cc < 2; ++cc) { carF[cc] = j == 1 ? car0[cc] : CAR[0 * 256 + lc.ch[cc]]; carR[cc] = CAR[j * 512 + 256 + lc.ch[cc]]; }
            } else { carF[0] = carF[1] = carR[0] = carR[1] = 0.f; }
            LAS bf16_t* H0 = (LAS bf16_t*)(lds + HY_OFF); LAS bf16_t* H1 = (LAS bf16_t*)(lds + XR_OFF);
            {   DirConst dc0, dc1; load_dir(P, 0, n, hf, l15, kg, lc, dc0); load_dir(P, 1, n, hf, l15, kg, lc, dc1);
#ifdef MK_LRU_XS
                if (!FINAL) for (int xs_ = 0; xs_ < MK_LRU_XS; ++xs_) { float c1_[2] = {0.f, 0.f}, c2_[2] = {0.f, 0.f}, p1_[2] = {1.f, 1.f}, q1_[2] = {0.f, 0.f}, p2_[2] = {1.f, 1.f}, q2_[2] = {0.f, 0.f};
#pragma unroll 1
                    for (int sx = 0; sx < 4; ++sx) { tile_dir<false, 0>(lds, lc, dc0, n, lane, sx, H0, c1_, p1_, q1_); tile_dir<false, 1>(lds, lc, dc1, n, lane, 3 - sx, H1, c2_, p2_, q2_); }
                    asm volatile("" :: "v"(p1_[0]), "v"(q1_[0]), "v"(p2_[1]), "v"(q2_[1])); }
#endif
#pragma unroll 1
                for (int sx = 0; sx < 4; ++sx) { tile_dir<FINAL, 0>(lds, lc, dc0, n, lane, sx, H0, carF, PmF, QmF); tile_dir<FINAL, 1>(lds, lc, dc1, n, lane, 3 - sx, H1, carR, PmR, QmR); } }
            if (FINAL) { car0[0] = carF[0]; car0[1] = carF[1]; }
            else {
#pragma unroll
                for (int cc = 0; cc < 2; ++cc) {
                    if (kg == 0) { AGG64[(((size_t)b * NCH + k) * 2 + 0) * 256 + lc.ch[cc]] = (f32x2){PmF[cc], QmF[cc]}; AGG64[(((size_t)b * NCH + k) * 2 + 1) * 256 + lc.ch[cc]] = (f32x2){PmR[cc], QmR[cc]}; }
                    if (j == 0) { P0m[0][cc] = PmF[cc]; Q0m[0][cc] = QmF[cc]; P0m[1][cc] = PmR[cc]; Q0m[1][cc] = QmR[cc]; }
                    else if (kg == 0) {
                        AGG128[(((size_t)b * NSU + s) * 2 + 0) * 256 + lc.ch[cc]] = (f32x2){P0m[0][cc] * PmF[cc], PmF[cc] * Q0m[0][cc] + QmF[cc]};
                        AGG128[(((size_t)b * NSU + s) * 2 + 1) * 256 + lc.ch[cc]] = (f32x2){P0m[1][cc] * PmR[cc], P0m[1][cc] * QmR[cc] + Q0m[1][cc]}; }
                }
            }
        }
        if (FINAL) {
            __syncthreads();
            for (int e = tid; e < TC * 32; e += 512) { const int i = e >> 5, cchunk = e & 31;
                const u32x4 hf4 = *(const LAS u32x4*)(lds + HY_OFF + i * RSB + cchunk * 16), hr4 = *(const LAS u32x4*)(lds + XR_OFF + i * RSB + cchunk * 16), xg4 = *(const LAS u32x4*)(lds + XG_OFF + i * RSB + cchunk * 16);
                u32x4 o;
#pragma unroll
                for (int w2 = 0; w2 < 4; ++w2) { float y2[2];
#pragma unroll
                    for (int hh = 0; hh < 2; ++hh) { const float hs = bf2f(hh ? hf4[w2] >> 16 : hf4[w2] & 0xffffu) + bf2f(hh ? hr4[w2] >> 16 : hr4[w2] & 0xffffu), xg = bf2f(hh ? xg4[w2] >> 16 : xg4[w2] & 0xffffu);
                        y2[hh] = hs * (xg * fsig(1.5957691216057308f * (xg + 0.044715f * xg * xg * xg))); }
                    o[w2] = pg8::cvt_pk_bf16(y2[0], y2[1]); }
                *(u32x4*)(P.YMIX + (size_t)(row0 + i) * D + 768 + 8 * cchunk) = o; }
        }
    }
}
}
namespace na {
constexpr float LOG2E = 1.4426950408889634f, QSCALE = 0.125f * LOG2E;
constexpr int KC_OFF = 0, VC_OFF = 32768;
constexpr int KL_OFF = 0, VL_OFF = 61440, RPB_OFF = 122880;
constexpr int LDS_END = RPB_OFF + 15 * 32 * 4;
static_assert(LDS_END <= 147456, "na LDS map");
struct Params { const bf16_t* QKL; const bf16_t* VT; const float* rpb; bf16_t* YMIX; };

struct RowState { f32x4 o[4]; float m, l; };
template <bool LOCAL>
__device__ __forceinline__ void chunk(LAS unsigned char* lds, RowState& st, const bf16x8 (&Qf)[2], int kbase, int kstride_pair, int vbase, int lane, int cq, int drbase, int kc0) {
    const int l15 = lane & 15, kg = lane >> 4;
    f32x4 S[8];
#pragma unroll
    for (int t = 0; t < 8; ++t) {
        const int krow = LOCAL ? (kbase + (t >> 1) * kstride_pair + (t & 1) * 16 * 128) : (kbase + t * 16 * 128);
        const int ka = krow + l15 * 128;
        const bf16x8 k0 = *(const LAS bf16x8*)(lds + ka + (((0 + kg) ^ (l15 & 7)) << 4));
        const bf16x8 k1 = *(const LAS bf16x8*)(lds + ka + (((4 + kg) ^ (l15 & 7)) << 4));
        f32x4 s = (f32x4){0.f, 0.f, 0.f, 0.f};
        s = __builtin_amdgcn_mfma_f32_16x16x32_bf16(k0, Qf[0], s, 0, 0, 0);
        s = __builtin_amdgcn_mfma_f32_16x16x32_bf16(k1, Qf[1], s, 0, 0, 0);
        S[t] = s;
    }
    int bidx[2][4];
    if (LOCAL) {
        const int start = min(max(cq - 8, 0), GRIDW - 16);
#pragma unroll
        for (int hh = 0; hh < 2; ++hh)
#pragma unroll
            for (int rg = 0; rg < 4; ++rg) { const int kcol = kc0 + 16 * hh + 4 * kg + rg; const bool valid = (kcol >= start) && (kcol < start + 16); bidx[hh][rg] = RPB_OFF + (drbase * 32 + (valid ? kcol - cq + 15 : 31)) * 4; }
    }
    float mx = -3.0e38f;
#pragma unroll
    for (int t = 0; t < 8; ++t) {
        if (LOCAL) {
#pragma unroll
            for (int rg = 0; rg < 4; ++rg) S[t][rg] = __builtin_fmaf(S[t][rg], QSCALE, *(const LAS float*)(lds + bidx[t & 1][rg] + (t >> 1) * 128));
        }
        mx = fmaxf(mx, fmaxf(fmaxf(S[t][0], S[t][1]), fmaxf(S[t][2], S[t][3])));
    }
    if (!LOCAL) mx *= QSCALE;
    mx = fmaxf(mx, __shfl_xor(mx, 16)); mx = fmaxf(mx, __shfl_xor(mx, 32));
    const float mn = fmaxf(st.m, mx), alpha = __builtin_amdgcn_exp2f(st.m - mn);
    st.m = mn; st.l *= alpha;
#pragma unroll
    for (int dt = 0; dt < 4; ++dt) st.o[dt] *= alpha;
    float ls = 0.f;
#pragma unroll
    for (int t = 0; t < 8; ++t)
#pragma unroll
        for (int rg = 0; rg < 4; ++rg) { const float p = __builtin_amdgcn_exp2f(LOCAL ? S[t][rg] - mn : __builtin_fmaf(S[t][rg], QSCALE, -mn)); S[t][rg] = p; ls += p; }
    st.l += ls;
#pragma unroll
    for (int j = 0; j < 4; ++j) {
        u32x4 pw; pw.x = pg8::cvt_pk_bf16(S[2 * j][0], S[2 * j][1]); pw.y = pg8::cvt_pk_bf16(S[2 * j][2], S[2 * j][3]); pw.z = pg8::cvt_pk_bf16(S[2 * j + 1][0], S[2 * j + 1][1]); pw.w = pg8::cvt_pk_bf16(S[2 * j + 1][2], S[2 * j + 1][3]);
        const bf16x8 Pf = __builtin_bit_cast(bf16x8, pw);
        const int vgb = vbase + j * 4096;
#pragma unroll
        for (int dt = 0; dt < 4; ++dt) { const int d = 16 * dt + l15, x = 2 * ((d >> 2) & 3);
            const u32x2 v0 = *(const LAS u32x2*)(lds + vgb + d * 64 + (((0 + kg) ^ x) << 3));
            const u32x2 v1 = *(const LAS u32x2*)(lds + vgb + d * 64 + (((4 + kg) ^ x) << 3));
            const u32x4 vw = (u32x4){v0.x, v0.y, v1.x, v1.y};
            st.o[dt] = __builtin_amdgcn_mfma_f32_16x16x32_bf16(__builtin_bit_cast(bf16x8, vw), Pf, st.o[dt], 0, 0, 0); }
    }
}
__device__ __forceinline__ void glds16(const void* g, LAS unsigned char* l) { __builtin_amdgcn_global_load_lds((const unsigned*)g, (LAS unsigned*)l, 16, 0, 0); }
__device__ __forceinline__ void stage_ctx(LAS unsigned char* lds, const Params& P, int b, int h) {
    const int tids = opaque_i(threadIdx.x), wv = __builtin_amdgcn_readfirstlane(tids >> 6), lane = tids & 63;
#pragma unroll
    for (int it = 0; it < 4; ++it) { const int e = (it * 8 + wv) * 64 + lane, key = e >> 3, c = (e & 7) ^ (key & 7);
        glds16(P.QKL + (size_t)(NLAT + b * CTXL + key) * NQKL + 512 + h * 64 + 8 * c, lds + KC_OFF + (it * 8 + wv) * 1024); }
#pragma unroll
    for (int it = 0; it < 4; ++it) { const int e = (it * 8 + wv) * 64 + lane, g32 = e >> 8, d = (e >> 2) & 63, j8l = (e & 3) ^ ((d >> 2) & 3);
        glds16(P.VT + (size_t)(h * 64 + d) * MT + NLAT + b * CTXL + 32 * g32 + 8 * j8l, lds + VC_OFF + (it * 8 + wv) * 1024); }
}
__device__ __forceinline__ void load_q(const Params& P, int row, int h, int lane, bf16x8 (&Qf)[2]) {
    const bf16_t* qp = P.QKL + (size_t)row * NQKL + h * 64 + 8 * (lane >> 4);
    Qf[0] = *(const bf16x8*)(qp); Qf[1] = *(const bf16x8*)(qp + 32);
}
__device__ __forceinline__ void finish_row(const Params& P, RowState& st, int row, int h, int lane) {
    float l = st.l; l += __shfl_xor(l, 16); l += __shfl_xor(l, 32);
    const float inv = 1.0f / l;
    bf16_t* op = P.YMIX + (size_t)row * D + 256 + h * 64 + 4 * (lane >> 4);
#pragma unroll
    for (int dt = 0; dt < 4; ++dt) { const f32x4 o = st.o[dt] * inv; u32x2 w; w.x = pg8::cvt_pk_bf16(o[0], o[1]); w.y = pg8::cvt_pk_bf16(o[2], o[3]); *(u32x2*)(op + 16 * dt) = w; }
}
__device__ __forceinline__ void init_row(RowState& st) {
#pragma unroll
    for (int dt = 0; dt < 4; ++dt) st.o[dt] = (f32x4){0.f, 0.f, 0.f, 0.f};
    st.m = -1.0e30f; st.l = 0.f;
}
__device__ __forceinline__ void latent_unit(LAS unsigned char* lds, const Params& P, int u, int pm = 0) {
    const int b = u >> 8, h = (u >> 5) & 7, n = (u >> 3) & 3, rr = u & 7, r0 = 32 * rr;
    const int tid = opaque_i(threadIdx.x), lane = tid & 63, w = tid >> 6, l15 = lane & 15;
    const int kc0 = n == 0 ? 0 : (n == 1 ? 8 : (n == 2 ? 24 : 32)), cq = 16 * n + l15;
    __syncthreads();
    stage_ctx(lds, P, b, h);
    __syncthreads();
    RowState st[4]; bf16x8 Qf[2][2];
    load_q(P, b * SEQ + (r0 + w) * GRIDW + cq, h, lane, Qf[0]);
#pragma unroll
    for (int g = 0; g < 4; ++g) { init_row(st[g]);
        load_q(P, b * SEQ + (r0 + 8 * ((g + 1) & 3) + w) * GRIDW + cq, h, lane, Qf[(g + 1) & 1]);
#pragma unroll 1
        for (int cc = 0; cc < 2; ++cc) {
#ifdef MK_NA_PM
            if (pm & 2) continue;
#endif
            chunk<false>(lds, st[g], Qf[g & 1], KC_OFF + cc * 128 * 128, 0, VC_OFF + cc * 4 * 4096, lane, 0, 0, 0); } }
    __syncthreads();
    for (int e = tid; e < 15 * 32; e += 512) { const int dr = e >> 5, dc = e & 31; *(LAS float*)(lds + RPB_OFF + e * 4) = dc < 31 ? P.rpb[(h * 15 + dr) * 31 + dc] * LOG2E : -1.0e30f; }
#pragma unroll
    for (int g = 0; g < 4; ++g) {
        const int rg0 = r0 + 8 * g, lo = max(rg0 - 4, 0), hi = min(rg0 + 10, GROWS - 1), nrows = hi - lo + 1;
        if (g > 0) __syncthreads();
        { const int wv = __builtin_amdgcn_readfirstlane(tid >> 6);
          for (int it = 0; it < nrows / 2; ++it) { const int e = (it * 8 + wv) * 64 + lane, key = e >> 3, kr = key >> 5, col = key & 31, c = (e & 7) ^ (key & 7);
              glds16(P.QKL + (size_t)(b * SEQ + (lo + kr) * GRIDW + kc0 + col) * NQKL + 512 + h * 64 + 8 * c, lds + KL_OFF + (it * 8 + wv) * 1024); }
          for (int it = 0; it < nrows / 2; ++it) { const int e = (it * 8 + wv) * 64 + lane, kr = e >> 8, d = (e >> 2) & 63, j8 = (e & 3) ^ ((d >> 2) & 3);
              glds16(P.VT + (size_t)(h * 64 + d) * MT + b * SEQ + (lo + kr) * GRIDW + kc0 + 8 * j8, lds + VL_OFF + (it * 8 + wv) * 1024); }
          if (nrows & 1) {
              const int it = nrows / 2;
              if (wv < 4) { const int e = (it * 8 + wv) * 64 + lane, key = e >> 3, kr = key >> 5, col = key & 31, c = (e & 7) ^ (key & 7);
                  glds16(P.QKL + (size_t)(b * SEQ + (lo + kr) * GRIDW + kc0 + col) * NQKL + 512 + h * 64 + 8 * c, lds + KL_OFF + (it * 8 + wv) * 1024);
                  const int e2 = e, kr2 = e2 >> 8, d = (e2 >> 2) & 63, j8 = (e2 & 3) ^ ((d >> 2) & 3);
                  glds16(P.VT + (size_t)(h * 64 + d) * MT + b * SEQ + (lo + kr2) * GRIDW + kc0 + 8 * j8, lds + VL_OFF + (it * 8 + wv) * 1024); } } }
        __syncthreads();
        const int r = rg0 + w, rs = min(max(r - 4, 0), GROWS - 8), row = b * SEQ + r * GRIDW + cq;
        if (g < 3) load_q(P, b * SEQ + (r0 + 8 * (g + 1) + w) * GRIDW + cq, h, lane, Qf[(g + 1) & 1]);
#pragma unroll 1
        for (int cc = 0; cc < 2; ++cc) { const int krel = rs - lo + 4 * cc;
#ifdef MK_NA_PM
            if (pm & 4) continue;
#endif
            chunk<true>(lds, st[g], Qf[g & 1], KL_OFF + krel * 32 * 128, 32 * 128, VL_OFF + krel * 4096, lane, cq, rs + 4 * cc - r + 7, kc0); }
        finish_row(P, st[g], row, h, lane);
    }
}
__device__ __forceinline__ void ctx_unit(LAS unsigned char* lds, const Params& P, int u) {
    const int b = u >> 4, h = (u >> 1) & 7, half = u & 1, tidc = opaque_i(threadIdx.x), lane = tidc & 63, w = tidc >> 6;
    __syncthreads();
    stage_ctx(lds, P, b, h);
    __syncthreads();
    RowState st; bf16x8 Qf[2]; init_row(st);
    const int row = NLAT + b * CTXL + 128 * half + 16 * w + (lane & 15);
    load_q(P, row, h, lane, Qf);
#pragma unroll 1
    for (int cc = 0; cc < 2; ++cc) chunk<false>(lds, st, Qf, KC_OFF + cc * 128 * 128, 0, VC_OFF + cc * 4 * 4096, lane, 0, 0, 0);
    finish_row(P, st, row, h, lane);
}
}

#include <hip/hip_cooperative_groups.h>
namespace cg = cooperative_groups;
constexpr int NPHASE = 2 + 8 * DEPTH;
constexpr int FEARLY = 496;

struct MKArgs { const float* in[31]; float* out; unsigned char* ws; int ph_lo, ph_hi; };

#define XB_TMO      128
#define XB_XCNT(j)  (256  + 64 * (j))
#define XB_XSUB(j)  (1280 + 64 * (j))
#define XB_XGEN(j)  (2304 + 64 * (j))
#define XB_TOP      3328
#define XB_TOPGEN   3392
#define XCD_BAR_WORDS 3456
#define XB_SPIN_CAP (1u << 22)

__device__ __forceinline__ unsigned xb_ld(unsigned* p)              { return __hip_atomic_load(p, __ATOMIC_RELAXED, __HIP_MEMORY_SCOPE_AGENT); }
__device__ __forceinline__ unsigned xb_add(unsigned* p, unsigned v) { return __hip_atomic_fetch_add(p, v, __ATOMIC_RELAXED, __HIP_MEMORY_SCOPE_AGENT); }
__device__ __forceinline__ unsigned xb_xcc_id() { return (unsigned)__builtin_amdgcn_s_getreg((3 << 11) | 20) & 0xFu; }
#define XB_SPIN(cond, bar) do { unsigned _sp = 0; while (cond) { __builtin_amdgcn_s_sleep(1); \
    if ((++_sp & 255u) == 0u) { if (xb_ld(&(bar)[XB_TMO])) break; if (_sp > XB_SPIN_CAP) { atomicAdd(&(bar)[XB_TMO], 1u); break; } } } } while (0)

struct XcdBarrier {
    unsigned* bar; unsigned x;
    volatile LAS unsigned* st;
};

__device__ __forceinline__ XcdBarrier xcd_barrier_post(unsigned* bar, volatile LAS unsigned* st) {
    XcdBarrier b; b.bar = bar; b.x = xb_xcc_id(); b.st = st;
    if (threadIdx.x == 0) (void)xb_add(&bar[XB_XCNT(b.x)], 1u);
    return b;
}
__device__ __forceinline__ void xcd_barrier_complete(unsigned* bar, unsigned x, unsigned& nloc, unsigned& nx) {
    const unsigned G = gridDim.x * gridDim.y * gridDim.z;
    unsigned sum, cnt, mine, sp = 0u;
    for (;;) {
        sum = 0u; cnt = 0u; mine = 0u;
#pragma unroll
        for (unsigned j = 0; j < 16; ++j) { const unsigned c = xb_ld(&bar[XB_XCNT(j)]); sum += c; cnt += (c > 0u) ? 1u : 0u; mine = (j == x) ? c : mine; }
        if (sum == G) break;
        __builtin_amdgcn_s_sleep(1);
        if ((++sp & 255u) == 0u) { if (xb_ld(&bar[XB_TMO])) break; if (sp > XB_SPIN_CAP) { atomicAdd(&bar[XB_TMO], 1u); break; } }
    }
    nloc = mine > 0u ? mine : 1u; nx = cnt > 0u ? cnt : 1u;
}

__device__ __forceinline__ void xcd_barrier(const XcdBarrier& b) {
    asm volatile("s_waitcnt vmcnt(0)" ::: "memory");
    __syncthreads();
    if (threadIdx.x == 0) {
        unsigned* bar = b.bar;
        __builtin_amdgcn_s_waitcnt(0);
        unsigned nloc = b.st[0], nx = b.st[1];
        if (nloc == 0u) { xcd_barrier_complete(bar, b.x, nloc, nx); b.st[0] = nloc; b.st[1] = nx; }
        const unsigned old = xb_add(&bar[XB_XSUB(b.x)], 1u);
        const unsigned gen = old / nloc;
        if (old + 1u == (gen + 1u) * nloc) {
            __builtin_amdgcn_fence(__ATOMIC_RELEASE, "agent");
            asm volatile("s_waitcnt vmcnt(0)" ::: "memory");
            const unsigned og = xb_add(&bar[XB_TOP], 1u);
            const unsigned tg = og / nx;
            if (og + 1u == (tg + 1u) * nx) xb_add(&bar[XB_TOPGEN], 1u);
            else XB_SPIN(xb_ld(&bar[XB_TOPGEN]) == tg, bar);
            __builtin_amdgcn_fence(__ATOMIC_ACQUIRE, "agent");
            xb_add(&bar[XB_XGEN(b.x)], 1u);
            asm volatile("s_waitcnt vmcnt(0)" ::: "memory");
        } else {
            XB_SPIN(xb_ld(&bar[XB_XGEN(b.x)]) == gen, bar);
            __builtin_amdgcn_fence(__ATOMIC_ACQUIRE, "agent");
            asm volatile("s_waitcnt vmcnt(0)" ::: "memory");
        }
    }
    __syncthreads();
}


namespace mk {
struct Ctx { LAS unsigned char* lds; int tid, lane, wave, G, bx; };

__device__ __forceinline__ void p_weights(const Ctx& c, const MKArgs& a) {
    LAS float* scr = (LAS float*)c.lds + c.wave * 64 * 33;
    for (int it = c.bx * 8 + c.wave; it < (c.G == 256 ? WI_IN : DEPTH * WI_LAYER); it += c.G * 8) wconv_item(it, a.in[10], a.in[11], a.in[29], a.in[30], a.ws, scr, c.lane);
    bf16_t* LW = (bf16_t*)(a.ws + WS_LW);
    for (int gid = c.bx * 512 + c.tid; gid < DEPTH * 2 * 4 * 2 * 64 * 64; gid += c.G * 512) {
        const int i = gid & 63, o = (gid >> 6) & 63, ty = (gid >> 12) & 1, nb = (gid >> 13) & 3, dir = (gid >> 15) & 1, l = gid >> 16;
        const float* src = ty == 0 ? a.in[24] : a.in[26];
        LW[gid] = (bf16_t)f2bf(src[((((size_t)l * 2 + dir) * 4 + nb) * 64 + i) * 64 + o]); }
}
__device__ __forceinline__ void p_weights_late(const Ctx& c, const MKArgs& a, int first_block, int it_lo, int it_hi) {
    if (c.bx < first_block) return;
    LAS float* scr = (LAS float*)c.lds + c.wave * 64 * 33;
    for (int it = it_lo + (c.bx - first_block) * 8 + c.wave; it < it_hi; it += (c.G - first_block) * 8) wconv_item(it, a.in[10], a.in[11], a.in[29], a.in[30], a.ws, scr, c.lane);
}
__device__ __forceinline__ void p_mod(const Ctx& c, const MKArgs& a, int l_lo, int l_hi, int first_block = 0) {
    LAS float* sc = (LAS float*)(c.lds + 67584); LAS float* red = sc + 3 * D;
    const float* cvec = a.in[1]; const float* cctx = a.in[3]; const float* ada_w = a.in[4]; const float* ada_b = a.in[5]; float* MOD = (float*)(a.ws + WS_MOD);
    for (int i = c.tid; i < 3 * D; i += 512) { const int cd = i / D, k = i % D; const float v = cd < 2 ? cvec[cd * D + k] : cctx[k]; sc[i] = v / (1.0f + expf(-v)); }
    __syncthreads();
    for (int item = l_lo * 96 + (c.bx - first_block); c.bx >= first_block && item < l_hi * 96; item += c.G - first_block) {
        const int l = item / 96, n = (item % 96) * 64 + c.lane;
        const float* w = ada_w + (size_t)l * D * 6 * D + (size_t)(128 * c.wave) * 6 * D + n;
        float a0 = 0.f, a1 = 0.f, a2 = 0.f;
#pragma unroll 32
        for (int k = 0; k < 128; ++k) { const float wv = w[(size_t)k * 6 * D]; const int kk = 128 * c.wave + k; a0 += sc[kk] * wv; a1 += sc[D + kk] * wv; a2 += sc[2 * D + kk] * wv; }
        red[(c.wave * 3 + 0) * 64 + c.lane] = a0; red[(c.wave * 3 + 1) * 64 + c.lane] = a1; red[(c.wave * 3 + 2) * 64 + c.lane] = a2;
        __syncthreads();
        if (c.tid < 192) { const int cd = c.tid >> 6, ln = c.tid & 63; float s = ada_b[l * 6 * D + (item % 96) * 64 + ln];
#pragma unroll
            for (int w8 = 0; w8 < 8; ++w8) s += red[(w8 * 3 + cd) * 64 + ln];
            MOD[(size_t)(l * 3 + cd) * 6 * D + (item % 96) * 64 + ln] = s; }
        __syncthreads();
    }
}
__device__ __forceinline__ void p_filt_h2(const Ctx& c, const MKArgs& a, int l_lo, int l_hi, int first_block = 0) {
    LAS float* z = (LAS float*)(c.lds + 90112); LAS float* h1 = z + 8 * 36;
    const float* w1 = a.in[14]; const float* b1 = a.in[15]; const float* w2 = a.in[16]; const float* b2 = a.in[17]; const float* freq = a.in[19]; float* H2 = (float*)(a.ws + WS_H2);
    const int pl = c.tid >> 6, j = c.tid & 63;
    float W1c[33], W2c[64], b1v = 0.f, b2v = 0.f, f0 = 0.f, f1 = 0.f; int lcur = -1;
    for (int item = l_lo * (FPOS / 8) + (c.bx - first_block); c.bx >= first_block && item < l_hi * (FPOS / 8); item += c.G - first_block) {
        const int l = item / (FPOS / 8), p0 = (item % (FPOS / 8)) * 8, p = p0 + pl;
        if (l != lcur) { lcur = l;
#pragma unroll
            for (int i = 0; i < 33; ++i) W1c[i] = w1[l * 33 * 64 + i * 64 + j];
#pragma unroll
            for (int i = 0; i < 64; ++i) W2c[i] = w2[l * 64 * 64 + i * 64 + j];
            b1v = b1[l * 64 + j]; b2v = b2[l * 64 + j]; f0 = freq[(l * 2 + 0) * 64 + j]; f1 = freq[(l * 2 + 1) * 64 + j]; }
        const float t = p < SEQ ? (float)p / (float)SEQ : (float)(p - SEQ) / (float)CTXL;
        if (j < 33) { float v; if (j == 0) v = t; else { const int bnd = j <= 16 ? j : j - 16; float s, cs; sincospif(2.0f * t * (float)bnd, &s, &cs); v = j <= 16 ? cs : s; } z[pl * 36 + j] = v; }
        __syncthreads();
        float acc = b1v;
#pragma unroll
        for (int i4 = 0; i4 < 8; ++i4) { const f32x4 zv = *(const LAS f32x4*)(z + pl * 36 + 4 * i4); acc += zv[0] * W1c[4 * i4] + zv[1] * W1c[4 * i4 + 1] + zv[2] * W1c[4 * i4 + 2] + zv[3] * W1c[4 * i4 + 3]; }
        acc += z[pl * 36 + 32] * W1c[32];
        h1[pl * 64 + j] = sinf(f0 * acc);
        __syncthreads();
        float a2 = b2v;
#pragma unroll
        for (int i4 = 0; i4 < 16; ++i4) { const f32x4 hv = *(const LAS f32x4*)(h1 + pl * 64 + 4 * i4); a2 += hv[0] * W2c[4 * i4] + hv[1] * W2c[4 * i4 + 1] + hv[2] * W2c[4 * i4 + 2] + hv[3] * W2c[4 * i4 + 3]; }
        H2[((size_t)l * FPOS + p) * 64 + j] = sinf(f1 * a2);
    }
    __syncthreads();
}
__device__ __forceinline__ void p_filt_k(const Ctx& c, const MKArgs& a, int l, bool with_ctx, int first_block = 0) {
    const int half = c.tid >> 8, t256 = c.tid & 255;
    LAS float* hs = (LAS float*)(c.lds + half * 34816); LAS float* wsm = hs + 64 * 68;
    const float* H2l = (const float*)(a.ws + WS_H2) + (size_t)l * FPOS * 64; const float* w3l = a.in[18] + (size_t)l * 64 * 1024;
    bf16_t* KFB = (bf16_t*)(a.ws + WS_KF); float* KFC = (float*)(a.ws + WS_KFC);
    const int nlat = (SEQ / 64) * 16, total = nlat + (with_ctx ? (CTXL / 64) * 16 : 0);
    if (c.bx < first_block) return;
    for (int it0 = 2 * (c.bx - first_block); it0 < total; it0 += 2 * (c.G - first_block)) {
        const int item = it0 + half; const bool live = item < total; int bxi = live ? item : 0;
        const bool isctx = bxi >= nlat; if (isctx) bxi -= nlat;
        const int L = isctx ? CTXL : SEQ; const int pt = bxi / 16, ct = bxi % 16, p0 = pt * 64, c0 = ct * 64;
        const float* Hs = H2l + (size_t)(isctx ? SEQ : 0) * 64;
        __syncthreads();
        { float hv_[16], wv_[16];
#pragma unroll
          for (int i16 = 0; i16 < 16; ++i16) { const int i = t256 + 256 * i16, r = i >> 6, cc = i & 63; hv_[i16] = Hs[(size_t)(p0 + r) * 64 + cc]; wv_[i16] = w3l[r * 1024 + c0 + cc]; }
#pragma unroll
          for (int i16 = 0; i16 < 16; ++i16) { const int i = t256 + 256 * i16, r = i >> 6, cc = i & 63; hs[cc * 68 + r] = hv_[i16]; wsm[r * 68 + cc] = wv_[i16]; } }
        __syncthreads();
        const int tx = t256 & 15, ty = t256 >> 4;
        float acc[4][4];
#pragma unroll
        for (int x = 0; x < 4; ++x)
#pragma unroll
            for (int y = 0; y < 4; ++y) acc[x][y] = 0.f;
#pragma unroll 8
        for (int j = 0; j < 64; ++j) {
            const f32x4 hv = *(const LAS f32x4*)(hs + j * 68 + 4 * tx), wv = *(const LAS f32x4*)(wsm + j * 68 + 4 * ty);
#pragma unroll
            for (int x = 0; x < 4; ++x)
#pragma unroll
                for (int y = 0; y < 4; ++y) acc[x][y] += hv[x] * wv[y];
        }
        if (live) {
#pragma unroll
            for (int y = 0; y < 4; ++y) { const int col = c0 + 4 * ty + y, ch = col & 255;
                const float d0 = 15.350567286626973f, d1 = 3.0701134573253946f; const float delta = d0 + (d1 - d0) * ((float)ch / 255.0f);
                f32x4 o;
#pragma unroll
                for (int x = 0; x < 4; ++x) { const float t = (float)(p0 + 4 * tx + x) / (float)L; o[x] = acc[x][y] * expf(-t * delta); }
                if (isctx) *(f32x4*)(KFC + (size_t)col * L + p0 + 4 * tx) = o;
                else { u32x2 w; w.x = pg8::cvt_pk_bf16(o[0], o[1]); w.y = pg8::cvt_pk_bf16(o[2], o[3]); *(u32x2*)(KFB + (size_t)col * L + p0 + 4 * tx) = w; } }
        }
    }
    __syncthreads();
}
__device__ __forceinline__ void p_rownorm0(const Ctx& c, const MKArgs& a) {
    const float* x = a.in[0]; const float* ctx = a.in[2]; const float* g = a.in[6]; const float* MOD0 = (const float*)(a.ws + WS_MOD); bf16_t* H = (bf16_t*)(a.ws + WS_H);
    const int lane = c.lane;
    for (int row0 = 2 * (c.bx * 8 + c.wave); row0 < MT; row0 += 2 * c.G * 8) {
        f32x4 v[2][4]; float ss[2] = {0.f, 0.f}; int cond[2];
#pragma unroll
        for (int r = 0; r < 2; ++r) { const int row = row0 + r; const bool isctx = row >= NLAT; cond[r] = isctx ? 2 : row / SEQ;
            const float* xr = isctx ? ctx + (size_t)(row - NLAT) * D : x + (size_t)row * D;
#pragma unroll
            for (int j = 0; j < 4; ++j) v[r][j] = __builtin_nontemporal_load((const f32x4*)(xr + 4 * lane + 256 * j)); }
#pragma unroll
        for (int r = 0; r < 2; ++r)
#pragma unroll
            for (int j = 0; j < 4; ++j) ss[r] += v[r][j][0] * v[r][j][0] + v[r][j][1] * v[r][j][1] + v[r][j][2] * v[r][j][2] + v[r][j][3] * v[r][j][3];
#pragma unroll
        for (int o = 1; o < 64; o <<= 1) { ss[0] += __shfl_xor(ss[0], o); ss[1] += __shfl_xor(ss[1], o); }
#pragma unroll
        for (int r = 0; r < 2; ++r) { const float rinv = 1.0f / sqrtf(ss[r] * (1.0f / D) + 1e-6f);
            const float* sh = MOD0 + (size_t)cond[r] * 6 * D; const float* sc = sh + D;
#pragma unroll
            for (int j = 0; j < 4; ++j) { const int col = 4 * lane + 256 * j; const f32x4 gv = *(const f32x4*)(g + col), scv = *(const f32x4*)(sc + col), shv = *(const f32x4*)(sh + col);
                float o[4];
#pragma unroll
                for (int e = 0; e < 4; ++e) o[e] = v[r][j][e] * rinv * gv[e] * (1.0f + scv[e]) + shv[e];
                u32x2 w; w.x = pg8::cvt_pk_bf16(o[0], o[1]); w.y = pg8::cvt_pk_bf16(o[2], o[3]); *(u32x2*)(H + (size_t)(row0 + r) * D + col) = w; } }
    }
}
__device__ __forceinline__ void p_rowpass(const Ctx& c, const bf16_t* Y, const float* xin_lat, const float* xin_ctx, float* xout_lat, float* xout_ctx, const float* g_post, const float* modp, int gate_idx,
                                          const float* g_next, const float* modn, int nidx, bf16_t* H, int nrows) {
    LAS float* VA = (LAS float*)c.lds; LAS float* VB = VA + 3 * D; LAS float* VC = VB + 3 * D;
    __syncthreads();
    for (int i = c.tid; i < 3 * D; i += 512) { const int cd = i / D, col = i % D;
        VA[i] = modp[(size_t)cd * 6 * D + gate_idx * D + col] * g_post[col];
        if (g_next) { VB[i] = g_next[col] * (1.0f + modn[(size_t)cd * 6 * D + (nidx + 1) * D + col]); VC[i] = modn[(size_t)cd * 6 * D + nidx * D + col]; } }
    __syncthreads();
    const int lane = c.lane;
    constexpr int NR = 2;
    for (int row0 = NR * (c.bx * 8 + c.wave); row0 < nrows; row0 += NR * c.G * 8) {
        float y[NR][4][4]; f32x4 xv[NR][4]; float ss[NR]; int cond[NR]; float* xo[NR];
#pragma unroll
        for (int r = 0; r < NR; ++r) { ss[r] = 0.f; const int row = row0 + r; const bool isctx = row >= NLAT; cond[r] = isctx ? 2 : row / SEQ;
            const float* xi = isctx ? xin_ctx + (size_t)(row - NLAT) * D : xin_lat + (size_t)row * D;
            xo[r] = isctx ? xout_ctx + (size_t)(row - NLAT) * D : xout_lat + (size_t)row * D;
#pragma unroll
            for (int j = 0; j < 4; ++j) { const u32x2 w = __builtin_nontemporal_load((const u32x2*)(Y + (size_t)row * D + 4 * lane + 256 * j)); xv[r][j] = __builtin_nontemporal_load((const f32x4*)(xi + 4 * lane + 256 * j));
                y[r][j][0] = bf2f(w.x & 0xffffu); y[r][j][1] = bf2f(w.x >> 16); y[r][j][2] = bf2f(w.y & 0xffffu); y[r][j][3] = bf2f(w.y >> 16); } }
#pragma unroll
        for (int r = 0; r < NR; ++r)
#pragma unroll
            for (int j = 0; j < 4; ++j) ss[r] += y[r][j][0] * y[r][j][0] + y[r][j][1] * y[r][j][1] + y[r][j][2] * y[r][j][2] + y[r][j][3] * y[r][j][3];
#pragma unroll
        for (int o = 1; o < 64; o <<= 1) {
#pragma unroll
            for (int r = 0; r < NR; ++r) ss[r] += __shfl_xor(ss[r], o); }
        float s2[NR];
#pragma unroll
        for (int r = 0; r < NR; ++r) { s2[r] = 0.f; const float rinv = 1.0f / sqrtf(ss[r] * (1.0f / D) + 1e-6f);
#pragma unroll
            for (int j = 0; j < 4; ++j) { const int col = 4 * lane + 256 * j; const f32x4 av = *(const LAS f32x4*)(VA + cond[r] * D + col);
#pragma unroll
                for (int e = 0; e < 4; ++e) { xv[r][j][e] += av[e] * (y[r][j][e] * rinv); s2[r] += xv[r][j][e] * xv[r][j][e]; }
                __builtin_nontemporal_store(xv[r][j], (f32x4*)(xo[r] + col)); } }
        if (g_next) {
#pragma unroll
            for (int o = 1; o < 64; o <<= 1) {
#pragma unroll
                for (int r = 0; r < NR; ++r) s2[r] += __shfl_xor(s2[r], o); }
#pragma unroll
            for (int r = 0; r < NR; ++r) { const float r2 = 1.0f / sqrtf(s2[r] * (1.0f / D) + 1e-6f);
#pragma unroll
                for (int j = 0; j < 4; ++j) { const int col = 4 * lane + 256 * j; const f32x4 bv = *(const LAS f32x4*)(VB + cond[r] * D + col), cv = *(const LAS f32x4*)(VC + cond[r] * D + col);
                    u32x2 w; w.x = pg8::cvt_pk_bf16(xv[r][j][0] * r2 * bv[0] + cv[0], xv[r][j][1] * r2 * bv[1] + cv[1]); w.y = pg8::cvt_pk_bf16(xv[r][j][2] * r2 * bv[2] + cv[2], xv[r][j][3] * r2 * bv[3] + cv[3]);
                    *(u32x2*)(H + (size_t)(row0 + r) * D + col) = w; } }
        }
    }
    __syncthreads();
}
__device__ __forceinline__ float conv3_at(const bf16_t* rowp, int s, int Lseq, float w0, float w1, float w2, float bias) {
    float v = bias + w1 * bf2f(rowp[s]);
    if (s > 0) v += w0 * bf2f(rowp[s - 1]);
    if (s + 1 < Lseq) v += w2 * bf2f(rowp[s + 1]);
    return v;
}
__device__ __forceinline__ void hy_ctx_unit(const Ctx& cx, int c, const bf16_t* PTV, const float* KFC, const float* cw, const float* cb, const float* hbias, bf16_t* YMIX) {
    LAS float* zin = (LAS float*)cx.lds; LAS float* kc = zin + 512; LAS float* red = kc + 512;
    const int tid = cx.tid, b = tid >> 8, t = tid & 255, lane = tid & 63, wave = tid >> 6;
    const bf16_t* base = PTV + NLAT + b * CTXL;
    float zcur = conv3_at(base + (size_t)c * MT, t, CTXL, cw[c], cw[768 + c], cw[1536 + c], cb[c]);
    for (int order = 0; order < 2; ++order) {
        __syncthreads();
        zin[b * 256 + t] = zcur;
        const float* kf = KFC + (size_t)((order * 2 + 0) * 256 + c) * CTXL; const float* kb = KFC + (size_t)((order * 2 + 1) * 256 + c) * CTXL;
        float kv = 0.f; if (tid >= 1) { const int d = tid - 256; kv = d >= 0 ? kf[d] : kb[-d]; } kc[tid] = kv;
        const float s = wave_sum(fabsf(kv)); if (lane == 0) red[wave] = s;
        __syncthreads();
        float tot = 0.f;
#pragma unroll
        for (int i = 0; i < 8; ++i) tot += red[i];
        float acc = 0.f;
        for (int s2 = 0; s2 < 256; ++s2) acc += kc[t - s2 + 256] * zin[b * 256 + s2];
        const int grow = (order == 0 ? 256 : 512) + c;
        const float gate = conv3_at(base + (size_t)grow * MT, t, CTXL, cw[grow], cw[768 + grow], cw[1536 + grow], cb[grow]);
        zcur = gate * (acc / tot + hbias[order * 256 + c] * zcur);
    }
    YMIX[(size_t)(NLAT + b * CTXL + t) * D + c] = (bf16_t)f2bf(zcur);
    __syncthreads();
}
}

__global__ void __launch_bounds__(512, 2) mk_fwd(MKArgs a) {
    extern __shared__ __attribute__((aligned(16))) unsigned char lds_raw[];
    cg::grid_group grid = cg::this_grid();
    mk::Ctx c; c.lds = (LAS unsigned char*)lds_raw; c.tid = threadIdx.x; c.lane = c.tid & 63; c.wave = __builtin_amdgcn_readfirstlane(c.tid >> 6); c.G = gridDim.x; c.bx = blockIdx.x;
#define FRESH() do { c.tid = opaque_i(threadIdx.x); c.lane = c.tid & 63; c.wave = __builtin_amdgcn_readfirstlane(c.tid >> 6); } while (0)
    unsigned char* ws = a.ws; float* out = a.out;
    bf16_t* Win_t = (bf16_t*)(ws + WS_WIN); bf16_t* Wout_t = (bf16_t*)(ws + WS_WOUT); bf16_t* Wgu_t = (bf16_t*)(ws + WS_WGU); bf16_t* Wdn_t = (bf16_t*)(ws + WS_WDN);
    float* MOD = (float*)(ws + WS_MOD); float* XC = (float*)(ws + WS_XC);
    bf16_t* H = (bf16_t*)(ws + WS_H); bf16_t* Y = (bf16_t*)(ws + WS_Y); bf16_t* PTV = (bf16_t*)(ws + WS_PTV); bf16_t* QKL = (bf16_t*)(ws + WS_QKL); bf16_t* ACT = (bf16_t*)(ws + WS_ACT);
    bf16_t* YMIX = (bf16_t*)(ws + WS_YMIX); fft::spec_t* KFS = (fft::spec_t*)(ws + WS_H); f32x2* HSCR = (f32x2*)(ws + WS_KF);
    const int lo = a.ph_lo, hi = a.ph_hi;
    unsigned* barw = (unsigned*)(ws + WS_CTL);
    if (lo > hi) grid.sync();
    if (c.tid < 16) ((LAS unsigned*)(c.lds + MK_LDS_BYTES - 64))[c.tid] = 0u;
    __syncthreads();
    XcdBarrier xbar; xbar.bar = barw; xbar.x = 0; xbar.st = (volatile LAS unsigned*)(c.lds + MK_LDS_BYTES - 64);
    if (hi - lo > 1) xbar = xcd_barrier_post(barw, (volatile LAS unsigned*)(c.lds + MK_LDS_BYTES - 64));
    pg8::Epi E;
#define IN(k) (lo <= (k) && (k) < hi)
#define SEAM(k) do { if (IN(k) && IN((k) + 1)) xcd_barrier(xbar); } while (0)
#ifndef MK_DUP
#define MK_DUP 0
#endif
#ifndef MK_DUP2
#define MK_DUP2 0
#endif
#ifndef MK_DUPN
#define MK_DUPN 1
#endif
#define REP2(b) for (int rep2_ = 0; rep2_ <= (int)((l == 1) && (((unsigned)(MK_DUP2) >> (b)) & 1u)) * MK_DUPN; ++rep2_)
#define REP(k) for (int rep_ = 0; rep_ <= (int)(((unsigned)(MK_DUP) >> (k)) & 1u); ++rep_)
    if (IN(0)) REP(0) { FRESH(); mk::p_weights(c, a); __syncthreads(); mk::p_mod(c, a, 0, DEPTH); mk::p_filt_h2(c, a, 0, (c.G == 256) ? 1 : DEPTH); }
    SEAM(0);
#ifdef MK_XSYNC
    if (lo == 0 && hi == NPHASE) for (int i_ = 0; i_ < MK_XSYNC; ++i_) xcd_barrier(xbar);
#endif
    if (IN(1)) REP(1) { FRESH();
#pragma unroll 1
        for (int stg = 0; stg < 2; ++stg) { if ((stg ^ ((c.bx >> 3) & 1)) == 0) mk::p_rownorm0(c, a); else mk::p_filt_k(c, a, 0, true); } }
    SEAM(1);
#pragma unroll 1
    for (int l = 0; l < DEPTH; ++l) {
        const int pb = 2 + 8 * l; const bool lastl = (l == DEPTH - 1);
        const float* modl = MOD + (size_t)l * 3 * 6 * D;
        const int nrows = lastl ? NLAT : MT;
        if (IN(pb + 0)) REP(pb + 0) {
            pg8::Sched S; const bf16_t* W = Win_t + (size_t)l * INW * D;
            const bf16_t* Hin = (l == 0) ? H : YMIX;
            S.ph.s0 = pg8::GSeg{W, Hin, PTV, NPTV / 256, MT / 256, MT, 0}; S.ph.s1 = pg8::GSeg{Hin, W + (size_t)NPTV * D, QKL, MT / 256, NQKL / 256, NQKL, 0};
            S.ph.n0 = (NPTV / 256) * (MT / 256); S.ph.total = S.ph.n0 + (MT / 256) * (NQKL / 256); S.ph.K = D; S.ph.pad = 0; S.G = c.G; S.c = c.bx;
            pg8::gemm_phase(c.lds, S, E);
            if (l == 0 && c.G == 256) { FRESH(); mk::p_weights_late(c, a, 150, WI_IN, WI_LAYER); }
        }
        SEAM(pb + 0);
        if (IN(pb + 1)) REP(pb + 1) {
            const bf16_t* KF = (const bf16_t*)(ws + WS_KF);
            const int rot = (c.bx >> 3) % 3;
#pragma unroll 1
            for (int stg = 0; stg < 3; ++stg) { const int which = (stg + rot) % 3;
                __syncthreads();
                if (which == 0) {
                    REP2(0) for (int u = (l == 0 || c.G != 256) ? c.bx : (c.bx >= 16 ? FEARLY + c.bx - 16 : 512); u < 512; u += c.G)     { const int order = u >> 8, ch = u & 255;
                        fft::filter_unit(c.lds, KF + (size_t)((order * 2 + 0) * 256 + ch) * SEQ, KF + (size_t)((order * 2 + 1) * 256 + ch) * SEQ, KFS + ((size_t)order * 256 + ch) * 2 * SEQ); }
                } else if (which == 1) {
                    na::Params np{QKL, PTV + (size_t)768 * MT, a.in[21] + (size_t)l * 8 * 15 * 31, YMIX}; const int nunits = lastl ? 512 : 544;
                    REP2(1) { for (int u = c.bx; u < 512; u += c.G) na::latent_unit(c.lds, np, u
#ifdef MK_NA_PM
                            , (rep2_ < (int)((l == 1) && ((MK_DUP2 >> 1) & 1u)) * MK_DUPN) ? MK_NA_PM : 0
#endif
                            );
                        if (nunits > 512) for (int u = c.bx - 8; u >= 0 && u < 32; u += c.G) na::ctx_unit(c.lds, np, u); }
                } else {
                    lru::Params lp{QKL, (const bf16_t*)(ws + WS_LW) + (size_t)l * 2 * 4 * 2 * 64 * 64, a.in[22] + (size_t)l * 4 * 256, a.in[23] + (size_t)l * 256, a.in[25] + (size_t)l * 512, a.in[27] + (size_t)l * 512,
                                    a.in[28] + (size_t)l * 512, (f32x2*)(ws + WS_AGG), YMIX};
                    REP2(2) for (int su = c.bx; su < 264; su += c.G) lru::super_unit<false>(c.lds, lp, su);
                }
            }
            if (!lastl) { __syncthreads(); FRESH();
                for (int u = c.bx; u < 256; u += c.G) mk::hy_ctx_unit(c, u, PTV, (const float*)(ws + WS_KFC), a.in[12] + (size_t)l * 3 * 768, a.in[13] + (size_t)l * 768, a.in[20] + (size_t)l * 512, YMIX); }
        }
        SEAM(pb + 1);
        if (IN(pb + 2)) REP(pb + 2) {
            unsigned* Zs = (unsigned*)HSCR + (size_t)c.bx * SEQ; unsigned* Rs = (unsigned*)HSCR + (size_t)(256 + c.bx) * SEQ;
#pragma unroll 1
            for (int stg = 0; stg < 2; ++stg) { const int which = stg ^ ((c.bx >> 3) & 1);
                __syncthreads();
                if (which == 0) {
                    REP2(3) for (int u = c.bx; u < 256; u += c.G) { const int ch = (c.G == 256) ? (u & 7) * 32 + (u >> 3) : u;
                        fft::hyena_unit(c.lds, ch, PTV, KFS + (size_t)ch * 2 * SEQ, (size_t)256 * 2 * SEQ, a.in[12] + (size_t)l * 3 * 768, a.in[13] + (size_t)l * 768, a.in[20] + (size_t)l * 512, Zs, Rs, YMIX
#ifdef MK_HY_PM
                            , (rep2_ < (int)((l == 1) && ((MK_DUP2 >> 3) & 1u)) * MK_DUPN) ? MK_HY_PM : 0
#endif
                            ); }
                } else {
                    lru::Params lp{QKL, (const bf16_t*)(ws + WS_LW) + (size_t)l * 2 * 4 * 2 * 64 * 64, a.in[22] + (size_t)l * 4 * 256, a.in[23] + (size_t)l * 256, a.in[25] + (size_t)l * 512, a.in[27] + (size_t)l * 512,
                                    a.in[28] + (size_t)l * 512, (f32x2*)(ws + WS_AGG), YMIX};
                    REP2(4) for (int su = c.bx; su < (lastl ? 256 : 264); su += c.G) lru::super_unit<true>(c.lds, lp, su);
                }
            }
        }
        SEAM(pb + 2);
        if (IN(pb + 3)) REP(pb + 3) {
            pg8::Sched S; const int nMt = (lastl ? NLAT : MT) / 256; S.ph.s0 = pg8::GSeg{YMIX, Wout_t + (size_t)l * D * D, Y, nMt, D / 256, D, 0}; S.ph.s1 = S.ph.s0; S.ph.n0 = S.ph.total = nMt * (D / 256); S.ph.K = D; S.ph.pad = 0; S.G = c.G; S.c = c.bx;
            pg8::gemm_phase(c.lds, S, E);
            if (l == 0 && c.G == 256) { FRESH(); mk::p_weights_late(c, a, 8, WI_LAYER, DEPTH * WI_LAYER); __syncthreads(); mk::p_filt_h2(c, a, 1, DEPTH, 8); }
        }
        SEAM(pb + 3);
        if (IN(pb + 4)) { FRESH();
#ifdef MK_DUP_RP
            if (l == 1) mk::p_rowpass(c, YMIX, a.in[0], XC, (float*)(ws + WS_PTV), (float*)(ws + WS_PTV) + (size_t)NLAT * D, a.in[7] + (size_t)l * D, modl, 2, a.in[8] + (size_t)l * D, modl, 3, (bf16_t*)(ws + WS_KF), NLAT);
#endif
            mk::p_rowpass(c, Y, l == 0 ? a.in[0] : out, l == 0 ? a.in[2] : XC, out, XC, a.in[7] + (size_t)l * D, modl, 2, a.in[8] + (size_t)l * D, modl, 3, H, nrows);
            if (!lastl && c.G != 256) mk::p_filt_k(c, a, l + 1, false);
        }
        SEAM(pb + 4);
        if (IN(pb + 5)) REP(pb + 5) {
            pg8::Sched S; const int nMt = (lastl ? NLAT : MT) / 256; S.ph.s0 = pg8::GSeg{H, Wgu_t + (size_t)l * 2 * DFF * D, ACT, nMt, 2 * DFF / 256, DFF, 1}; S.ph.s1 = S.ph.s0; S.ph.n0 = S.ph.total = nMt * (2 * DFF / 256); S.ph.K = D; S.ph.pad = 0; S.G = c.G; S.c = c.bx;
            pg8::gemm_phase(c.lds, S, E);
            if (!lastl && c.G == 256) { FRESH(); mk::p_filt_k(c, a, l + 1, false, 44); }
        }
        SEAM(pb + 5);
        if (IN(pb + 6)) REP(pb + 6) {
            pg8::Sched S; const int nMt = (lastl ? NLAT : MT) / 256; S.ph.s0 = pg8::GSeg{ACT, Wdn_t + (size_t)l * D * DFF, Y, nMt, D / 256, D, 0}; S.ph.s1 = S.ph.s0; S.ph.n0 = S.ph.total = nMt * (D / 256); S.ph.K = DFF; S.ph.pad = 0; S.G = c.G; S.c = c.bx;
            pg8::gemm_phase(c.lds, S, E);
            if (!lastl && c.G == 256 && c.bx >= 8) {
                const bf16_t* KF = (const bf16_t*)(ws + WS_KF);
                for (int u = 2 * (c.bx - 8); u < 2 * (c.bx - 8) + 2; ++u) { const int order = u >> 8, ch = u & 255;
                    fft::filter_unit(c.lds, KF + (size_t)((order * 2 + 0) * 256 + ch) * SEQ, KF + (size_t)((order * 2 + 1) * 256 + ch) * SEQ, KFS + ((size_t)order * 256 + ch) * 2 * SEQ); }
            }
        }
        SEAM(pb + 6);
        if (IN(pb + 7)) { FRESH();
            mk::p_rowpass(c, Y, out, XC, out, XC, a.in[9] + (size_t)l * D, modl, 5, lastl ? (const float*)nullptr : a.in[6] + (size_t)(l + 1) * D, lastl ? modl : modl + 3 * 6 * D, 0, YMIX, nrows);
        }
        SEAM(pb + 7);
    }
#undef IN
#undef SEAM
#undef REP
#undef REP2
}

#ifndef MK_N_LAUNCHES
#define MK_N_LAUNCHES 1
#endif
extern "C" void kernel_launch(void* const* d_in, const int* in_sizes, int n_in, void* d_out, int out_size, void* d_ws, size_t ws_size, hipStream_t stream) {
    static int grid = 0;
    if (grid == 0) {
        if (n_in != 31 || in_sizes[0] != NLAT * D || out_size != NLAT * D || ws_size < WS_END) { fprintf(stderr, "kernel_launch: unexpected shapes (n_in %d, in0 %d, out %d, ws %zu)\n", n_in, n_in > 0 ? in_sizes[0] : -1, out_size, ws_size); grid = -1; return; }
        if (hipFuncSetAttribute((const void*)mk_fwd, hipFuncAttributeMaxDynamicSharedMemorySize, MK_LDS_BYTES) != hipSuccess) { fprintf(stderr, "kernel_launch: hipFuncSetAttribute failed\n"); grid = -1; return; }
        int dev = 0, cus = 0, per_cu = 0;
        hipGetDevice(&dev); hipDeviceGetAttribute(&cus, hipDeviceAttributeMultiprocessorCount, dev);
        hipOccupancyMaxActiveBlocksPerMultiprocessor(&per_cu, (const void*)mk_fwd, 512, MK_LDS_BYTES);
        if (per_cu < 1) { fprintf(stderr, "kernel_launch: occupancy query says %d workgroups per CU\n", per_cu); per_cu = 1; }
        grid = cus * per_cu; if (grid > 256) grid = 256;
        (void)hipGetLastError();
    }
    if (grid < 0) return;
    MKArgs a{};
    for (int i = 0; i < 31; ++i) a.in[i] = (const float*)d_in[i];
    a.out = (float*)d_out; a.ws = (unsigned char*)d_ws;
    if (MK_N_LAUNCHES == 1) {
        a.ph_lo = 0; a.ph_hi = NPHASE;
        if (hipMemsetAsync((char*)d_ws + WS_CTL, 0, XCD_BAR_WORDS * 4, stream) != hipSuccess) { fprintf(stderr, "kernel_launch: hipMemsetAsync of the barrier words failed\n"); return; }
        void* args[] = {&a};
        const hipError_t e = hipLaunchCooperativeKernel((const void*)mk_fwd, dim3(grid), dim3(512), args, MK_LDS_BYTES, stream);
        if (e != hipSuccess) fprintf(stderr, "kernel_launch: cooperative launch failed: %s (grid %d)\n", hipGetErrorString(e), grid);
    } else {
        for (int p = 0; p < NPHASE; ++p) { a.ph_lo = p; a.ph_hi = p + 1; hipLaunchKernelGGL(mk_fwd, dim3(grid), dim3(512), MK_LDS_BYTES, stream, a); }
    }
}
```

```cpp
#include <hip/hip_runtime.h>
#include <cstdio>
#include <cstdint>
#include <cmath>

#define LAS __attribute__((address_space(3)))
typedef unsigned short bf16_t;
typedef short bf16x8 __attribute__((ext_vector_type(8)));
typedef float f32x4 __attribute__((ext_vector_type(4)));
typedef float f32x2 __attribute__((ext_vector_type(2)));
typedef unsigned u32x4 __attribute__((ext_vector_type(4)));
typedef unsigned u32x2 __attribute__((ext_vector_type(2)));

constexpr int D = 1024, NB = 2, SEQ = 16384, DEPTH = 2, GRIDW = 64, GROWS = 256, CTXL = 256;
constexpr int NLAT = NB * SEQ, NCTX = NB * CTXL, MT = NLAT + NCTX;
constexpr int HYW = 256, NAW = 512, NHEAD = 8, DH = 64, LRW = 256, INW = 2816, DFF = 2816;
constexpr int NPTV = 1280;
constexpr int NQKL = 1536;
constexpr int FPOS = SEQ + CTXL;

constexpr size_t MiB = 1u << 20;
constexpr size_t WS_CTL = 0;
constexpr size_t WS_WIN = 1 * MiB, WS_WOUT = 12 * MiB, WS_WGU = 16 * MiB, WS_WDN = 38 * MiB;
constexpr size_t WS_MOD = 49 * MiB;
constexpr size_t WS_XC = 50 * MiB;
constexpr size_t WS_H2 = 52 * MiB;
constexpr size_t WS_KN = 61 * MiB;
constexpr size_t WS_H = 64 * MiB;
constexpr size_t WS_Y = 129 * MiB;
constexpr size_t WS_PTV = 194 * MiB;
constexpr size_t WS_QKL = WS_PTV + (size_t)NPTV * MT * 2;
constexpr size_t WS_ACT = WS_PTV;
constexpr size_t WS_YMIX = 373 * MiB;
constexpr size_t WS_KF = 438 * MiB;
constexpr size_t WS_KFC = 502 * MiB;
constexpr size_t WS_AGG = 504 * MiB;
constexpr size_t WS_LW = 62 * MiB;
constexpr size_t WS_YHT = 470 * MiB;
constexpr size_t WS_END = 508 * MiB;
constexpr size_t WS_HF = WS_H, WS_HR = WS_H + (size_t)MT * LRW * 4;
constexpr size_t WS_Z1 = WS_Y;
static_assert(WS_QKL + (size_t)MT * NQKL * 2 <= WS_YMIX && WS_ACT + (size_t)MT * DFF * 2 <= WS_YMIX, "ws map");
static_assert(WS_HR + (size_t)MT * LRW * 4 <= WS_Y && WS_Z1 + (size_t)256 * 2 * SEQ * 4 <= WS_PTV, "ws map");

__device__ __forceinline__ int opaque_i(int v) { asm volatile("" : "+v"(v)); return v; }
__device__ __forceinline__ unsigned f2bf(float f) { unsigned u = __float_as_uint(f); return (u + 0x7fffu + ((u >> 16) & 1u)) >> 16; }
__device__ __forceinline__ unsigned pk2(float lo, float hi) { return f2bf(lo) | (f2bf(hi) << 16); }
__device__ __forceinline__ float bf2f(unsigned h) { return __uint_as_float(h << 16); }
__device__ __forceinline__ float wave_sum(float v) {
#pragma unroll
    for (int o = 1; o < 64; o <<= 1) v += __shfl_xor(v, o);
    return v;
}
__device__ __forceinline__ float wave_max(float v) {
#pragma unroll
    for (int o = 1; o < 64; o <<= 1) v = fmaxf(v, __shfl_xor(v, o));
    return v;
}
__device__ __forceinline__ float silu_f(float g) { return g * __builtin_amdgcn_rcpf(1.0f + __builtin_amdgcn_exp2f(-1.44269504089f * g)); }
__device__ __forceinline__ float sigmoid_f(float g) { return 1.0f / (1.0f + expf(-g)); }
__device__ __forceinline__ float gelu_tanh(float x) { const float u = 0.7978845608028654f * (x + 0.044715f * x * x * x); return 0.5f * x * (1.0f + tanhf(u)); }

namespace pg8 {
constexpr int BM = 256, BK = 64, HALF = 128, HTB = HALF * BK * 2, STAGE_BYTES = 8 * HTB;
#ifndef MK_WGM
#define MK_WGM 8
#endif
constexpr int WGM = MK_WGM;
__host__ __device__ __forceinline__ int lds_byte(int r, int c) { const int st = (r >> 4) * 2 + (c >> 5), rr = r & 15, cc = c & 31, ob = rr * 64 + cc * 2; return st * 1024 + (ob ^ (((ob >> 9) & 1) << 5)); }
__host__ __device__ __forceinline__ void stage_rc(int b, int& R, int& C) { const int st = b / 1024, sb = b % 1024, swz = sb ^ (((sb >> 9) & 1) << 5); R = (st >> 1) * 16 + swz / 64; C = (st & 1) * 32 + (swz % 64) / 2; }
__host__ __device__ __forceinline__ int perm32(int rho) { const int n = rho >> 4, i = rho & 15; return 8 * (i >> 2) + 4 * n + (i & 3); }

struct GSeg { const bf16_t* A; const bf16_t* B; bf16_t* C; int nM, nN, ldc, epi; };
struct GPhase { GSeg s0, s1; int n0, total, K, pad; };
struct Unit { const char* a; const char* b; bf16_t* C; int ldc, epi, pm, pn; };

struct Sched {
    GPhase ph; int G, c;
    __device__ __forceinline__ bool next(int i, Unit& u) const {
        const long L = (long)i * G + c; if (L >= ph.total) return false;
        int wgid = (int)L; { const int nwg = ph.total, q = nwg / 8, r = nwg % 8, xcd = wgid % 8, off = wgid / 8; wgid = (xcd < r ? xcd * (q + 1) : r * (q + 1) + (xcd - r) * q) + off; }
        const bool first = wgid < ph.n0; if (!first) wgid -= ph.n0;
        const bf16_t* A = first ? ph.s0.A : ph.s1.A; const bf16_t* B = first ? ph.s0.B : ph.s1.B; bf16_t* C = first ? ph.s0.C : ph.s1.C;
        const int nM = first ? ph.s0.nM : ph.s1.nM, nN = first ? ph.s0.nN : ph.s1.nN;
        u.ldc = first ? ph.s0.ldc : ph.s1.ldc; u.epi = first ? ph.s0.epi : ph.s1.epi; u.C = C;
        const int nig = WGM * nN, gid = wgid / nig, fm = gid * WGM, gsz = (nM - fm) < WGM ? (nM - fm) : WGM;
        u.pm = fm + ((wgid % nig) % gsz); u.pn = (wgid % nig) / gsz;
        u.a = (const char*)A + (size_t)u.pm * BM * ph.K * 2; u.b = (const char*)B + (size_t)u.pn * BM * ph.K * 2;
        return true;
    }
};

__device__ __forceinline__ unsigned cvt_pk_bf16(float lo, float hi) { unsigned r; asm volatile("v_cvt_pk_bf16_f32 %0, %1, %2" : "=v"(r) : "v"(lo), "v"(hi)); return r; }

struct Epi {
    __device__ __forceinline__ void operator()(const f32x4 (&acc)[2][2][4][2], const Unit& u, int wr, int wc, int fr, int fq) const {
        const int row0 = u.pm * BM + wr * 64 + fr;
        if (u.epi == 0) {
            const int col0 = u.pn * BM + wc * 32 + 8 * fq;
#pragma unroll
            for (int ai = 0; ai < 2; ++ai)
#pragma unroll
                for (int m = 0; m < 4; ++m) { bf16_t* rowp = u.C + (size_t)(row0 + ai * HALF + m * 16) * u.ldc + col0;
#pragma unroll
                    for (int bj = 0; bj < 2; ++bj) { const f32x4 v0 = acc[ai][bj][m][0], v1 = acc[ai][bj][m][1];
                        u32x4 w; w.x = cvt_pk_bf16(v0[0], v0[1]); w.y = cvt_pk_bf16(v0[2], v0[3]); w.z = cvt_pk_bf16(v1[0], v1[1]); w.w = cvt_pk_bf16(v1[2], v1[3]);
                        *(u32x4*)(rowp + bj * HALF) = w; } }
        } else {
            const int col0 = u.pn * HALF + wc * 32 + 8 * fq;
#pragma unroll
            for (int ai = 0; ai < 2; ++ai)
#pragma unroll
                for (int m = 0; m < 4; ++m) { bf16_t* rowp = u.C + (size_t)(row0 + ai * HALF + m * 16) * u.ldc + col0;
                    const f32x4 g0 = acc[ai][0][m][0], g1 = acc[ai][0][m][1], u0 = acc[ai][1][m][0], u1 = acc[ai][1][m][1];
                    u32x4 w; w.x = cvt_pk_bf16(silu_f(g0[0]) * u0[0], silu_f(g0[1]) * u0[1]); w.y = cvt_pk_bf16(silu_f(g0[2]) * u0[2], silu_f(g0[3]) * u0[3]);
                    w.z = cvt_pk_bf16(silu_f(g1[0]) * u1[0], silu_f(g1[1]) * u1[1]); w.w = cvt_pk_bf16(silu_f(g1[2]) * u1[2], silu_f(g1[3]) * u1[3]);
                    *(u32x4*)rowp = w; }
        }
    }
};

__device__ __forceinline__ void gemm_phase(LAS unsigned char* lds, const Sched& S, const Epi& E) {
    const int tid = opaque_i(threadIdx.x), wid = __builtin_amdgcn_readfirstlane(tid >> 6), lane = tid & 63, wr = wid >> 2, wc = wid & 3, fr = lane & 15, fq = lane >> 4;
    const int K = S.ph.K, nt = K / BK;
    unsigned voffA[2], voffB[2];
#pragma unroll
    for (int i = 0; i < 2; ++i) { int R, C; stage_rc(tid * 16 + i * 8192, R, C); const int Rb = (R & ~31) + perm32(R & 31);
        voffA[i] = (unsigned)(R * K + C) * 2u; voffB[i] = (unsigned)(Rb * K + C) * 2u; }
    const size_t kstep = (size_t)(BK * 2);
    const size_t hstep = (size_t)HALF * K * 2;
    const unsigned ldsw = (unsigned)wid * 1024u;
    const int aoff = lds_byte(wr * 64 + fr, fq * 8), boff = lds_byte(wc * 32 + fr, fq * 8);
#define PG8_SA(b, h) (((b) * 2 + (h)) * HTB)
#define PG8_SB(b, h) ((4 + (b) * 2 + (h)) * HTB)
#define PG8_STAGE(bufoff, gbase, voff) do { _Pragma("unroll") for (int _i = 0; _i < 2; ++_i) \
        __builtin_amdgcn_global_load_lds((const unsigned*)((const char*)(gbase) + (voff)[_i]), (LAS unsigned*)(lds + (bufoff) + ldsw + _i * 8192), 16, 0, 0); } while (0)
#define PG8_LDA(dst, b, h) do { _Pragma("unroll") for (int m = 0; m < 4; ++m) _Pragma("unroll") for (int k = 0; k < 2; ++k) dst[m][k] = *(const LAS bf16x8*)(lds + PG8_SA(b, h) + aoff + m * 2048 + k * 1024); } while (0)
#define PG8_LDB(dst, b, h) do { _Pragma("unroll") for (int n = 0; n < 2; ++n) _Pragma("unroll") for (int k = 0; k < 2; ++k) dst[n][k] = *(const LAS bf16x8*)(lds + PG8_SB(b, h) + boff + n * 2048 + k * 1024); } while (0)
#define PG8_MMA(ai, bj, At, Bt) do { __builtin_amdgcn_s_setprio(1); _Pragma("unroll") for (int m = 0; m < 4; ++m) _Pragma("unroll") for (int n = 0; n < 2; ++n) _Pragma("unroll") for (int k = 0; k < 2; ++k) \
        acc[ai][bj][m][n] = __builtin_amdgcn_mfma_f32_16x16x32_bf16(Bt[n][k], At[m][k], acc[ai][bj][m][n], 0, 0, 0); __builtin_amdgcn_s_setprio(0); } while (0)
#define PG8_WAIT_V(n) asm volatile("s_waitcnt vmcnt(" #n ")" ::: "memory")
#define PG8_WAIT_L(n) asm volatile("s_waitcnt lgkmcnt(" #n ")" ::: "memory")
#define PG8_BAR __builtin_amdgcn_s_barrier()
#define PG8_SCHED __builtin_amdgcn_sched_barrier(0)
    Unit cur, nxt; int ui = 0;
    if (!S.next(0, cur)) return;
    f32x4 acc[2][2][4][2];
#pragma unroll
    for (int a = 0; a < 2; ++a)
#pragma unroll
        for (int b = 0; b < 2; ++b)
#pragma unroll
            for (int m = 0; m < 4; ++m)
#pragma unroll
                for (int n = 0; n < 2; ++n) acc[a][b][m][n] = (f32x4){0.f, 0.f, 0.f, 0.f};
    bf16x8 At[4][2], B0[2][2], B1[2][2];
    const char* cA = cur.a; const char* cB = cur.b;
    PG8_STAGE(PG8_SB(0, 0), cB, voffB); PG8_STAGE(PG8_SB(0, 1), cB + hstep, voffB); PG8_STAGE(PG8_SA(0, 0), cA, voffA); PG8_STAGE(PG8_SA(0, 1), cA + hstep, voffA);
    if (wr == 1) PG8_BAR;
    PG8_WAIT_V(2); PG8_BAR;
    PG8_STAGE(PG8_SB(1, 0), cB + kstep, voffB); PG8_STAGE(PG8_SA(1, 0), cA + kstep, voffA); PG8_STAGE(PG8_SB(1, 1), cB + hstep + kstep, voffB);
    PG8_WAIT_V(6); PG8_BAR;
    for (;;) {
        const bool has_next = S.next(ui + 1, nxt);
        const char* nA = has_next ? nxt.a : cA; const char* nB = has_next ? nxt.b : cB;
        for (int t = 0; t < nt; t += 2) {
            const bool last = (t == nt - 2);
            const char* a1 = cA + (size_t)(t + 1) * kstep;
            const char* a2 = last ? nA : cA + (size_t)(t + 2) * kstep; const char* b2 = last ? nB : cB + (size_t)(t + 2) * kstep;
            const char* a3 = a2 + kstep; const char* b3 = b2 + kstep;
            PG8_LDB(B0, 0, 0); PG8_LDB(B1, 0, 1); PG8_SCHED; PG8_LDA(At, 0, 0); PG8_STAGE(PG8_SA(1, 1), a1 + hstep, voffA);
            PG8_WAIT_V(8); PG8_WAIT_L(0); PG8_BAR; PG8_MMA(0, 0, At, B0); PG8_MMA(0, 1, At, B1); PG8_BAR; PG8_SCHED;
            PG8_LDA(At, 0, 1); PG8_STAGE(PG8_SB(0, 0), b2, voffB); PG8_STAGE(PG8_SB(0, 1), b2 + hstep, voffB); PG8_STAGE(PG8_SA(0, 0), a2, voffA);
            PG8_WAIT_V(8); PG8_WAIT_L(0); PG8_BAR; PG8_MMA(1, 0, At, B0); PG8_MMA(1, 1, At, B1); PG8_BAR; PG8_SCHED;
            PG8_LDB(B0, 1, 0); PG8_LDB(B1, 1, 1); PG8_SCHED; PG8_LDA(At, 1, 0); PG8_STAGE(PG8_SA(0, 1), a2 + hstep, voffA);
            PG8_WAIT_V(8); PG8_WAIT_L(0); PG8_BAR; PG8_MMA(0, 0, At, B0); PG8_MMA(0, 1, At, B1); PG8_BAR; PG8_SCHED;
            PG8_LDA(At, 1, 1); PG8_STAGE(PG8_SB(1, 0), b3, voffB); PG8_STAGE(PG8_SB(1, 1), b3 + hstep, voffB); PG8_STAGE(PG8_SA(1, 0), a3, voffA);
            PG8_WAIT_V(8); PG8_WAIT_L(0); PG8_BAR; PG8_MMA(1, 0, At, B0); PG8_MMA(1, 1, At, B1); PG8_BAR; PG8_SCHED;
        }
        if (wr == 0) PG8_BAR;
        E(acc, cur, wr, wc, fr, fq);
        if (!has_next) break;
#pragma unroll
        for (int a = 0; a < 2; ++a)
#pragma unroll
            for (int b = 0; b < 2; ++b)
#pragma unroll
                for (int m = 0; m < 4; ++m)
#pragma unroll
                    for (int n = 0; n < 2; ++n) acc[a][b][m][n] = (f32x4){0.f, 0.f, 0.f, 0.f};
        cur = nxt; cA = nA; cB = nB; ++ui;
        if (wr == 1) PG8_BAR;
    }
    PG8_WAIT_V(0);
    PG8_BAR;
#undef PG8_SA
#undef PG8_SB
#undef PG8_STAGE
#undef PG8_LDA
#undef PG8_LDB
#undef PG8_MMA
#undef PG8_WAIT_V
#undef PG8_WAIT_L
#undef PG8_BAR
#undef PG8_SCHED
}
}
__device__ __forceinline__ int wrowmap(int kind, int n0) {
    if (kind == 0) { if (n0 < 768) return n0; if (n0 < 1792) return 1280 + (n0 - 768); if (n0 < 2304) return 768 + (n0 - 1792); return n0; }
    if (kind == 2) { if (n0 < DFF) return 256 * (n0 / 128) + (n0 % 128); const int m = n0 - DFF; return 256 * (m / 128) + 128 + (m % 128); }
    return n0;
}
__device__ __forceinline__ void transpose_item(const float* W, int K, int N, bf16_t* WT, int kind, LAS float* scr, int item, int lane) {
    const int nblk = N / 32, kb = item / nblk, nb = item % nblk, k0 = 64 * kb, n0 = 32 * nb, r0 = wrowmap(kind, n0);
    float wv[32];
#pragma unroll
    for (int i = 0; i < 32; ++i) { const int kk = 2 * i + (lane >> 5); wv[i] = W[(size_t)(k0 + kk) * N + n0 + (lane & 31)]; }
#pragma unroll
    for (int i = 0; i < 32; ++i) { const int kk = 2 * i + (lane >> 5); scr[kk * 33 + (lane & 31)] = wv[i]; }
    asm volatile("s_waitcnt lgkmcnt(0)" ::: "memory");
    const int c = lane & 7;
#pragma unroll
    for (int j = 0; j < 4; ++j) { const int n = (lane >> 3) + 8 * j; const LAS float* s = scr + (8 * c) * 33 + n;
        u32x4 o; o.x = pk2(s[0 * 33], s[1 * 33]); o.y = pk2(s[2 * 33], s[3 * 33]); o.z = pk2(s[4 * 33], s[5 * 33]); o.w = pk2(s[6 * 33], s[7 * 33]);
        *(u32x4*)(WT + (size_t)(r0 + n) * K + k0 + 8 * c) = o; }
    asm volatile("s_waitcnt lgkmcnt(0)" ::: "memory");
}
constexpr int WI_IN = (D / 64) * (INW / 32), WI_OUT = (D / 64) * (D / 32), WI_GU = (D / 64) * (2 * DFF / 32), WI_DN = (DFF / 64) * (D / 32), WI_LAYER = WI_IN + WI_OUT + WI_GU + WI_DN;
__device__ __forceinline__ void wconv_item(int it, const float* w_in, const float* w_out, const float* w_gu, const float* w_dn, unsigned char* ws, LAS float* scr, int lane) {
    const int l = it / WI_LAYER; int r = it % WI_LAYER;
    if (r < WI_IN) { transpose_item(w_in + (size_t)l * D * INW, D, INW, (bf16_t*)(ws + WS_WIN) + (size_t)l * INW * D, 0, scr, r, lane); return; } r -= WI_IN;
    if (r < WI_OUT) { transpose_item(w_out + (size_t)l * D * D, D, D, (bf16_t*)(ws + WS_WOUT) + (size_t)l * D * D, 1, scr, r, lane); return; } r -= WI_OUT;
    if (r < WI_GU) { transpose_item(w_gu + (size_t)l * D * 2 * DFF, D, 2 * DFF, (bf16_t*)(ws + WS_WGU) + (size_t)l * 2 * DFF * D, 2, scr, r, lane); return; } r -= WI_GU;
    transpose_item(w_dn + (size_t)l * DFF * D, DFF, D, (bf16_t*)(ws + WS_WDN) + (size_t)l * D * DFF, 1, scr, r, lane);
}
static __device__ constexpr float C32T[16] = {1.000000000e+00f, 9.807852804e-01f, 9.238795325e-01f, 8.314696123e-01f, 7.071067812e-01f, 5.555702330e-01f, 3.826834324e-01f, 1.950903220e-01f, 0.0f, -1.950903220e-01f, -3.826834324e-01f, -5.555702330e-01f, -7.071067812e-01f, -8.314696123e-01f, -9.238795325e-01f, -9.807852804e-01f};
static __device__ constexpr float S32T[16] = {0.000000000e+00f, 1.950903220e-01f, 3.826834324e-01f, 5.555702330e-01f, 7.071067812e-01f, 8.314696123e-01f, 9.238795325e-01f, 9.807852804e-01f, 1.000000000e+00f, 9.807852804e-01f, 9.238795325e-01f, 8.314696123e-01f, 7.071067812e-01f, 5.555702330e-01f, 3.826834324e-01f, 1.950903220e-01f};
static __device__ constexpr float C64T[32] = {1.000000000e+00f, 9.951847267e-01f, 9.807852804e-01f, 9.569403357e-01f, 9.238795325e-01f, 8.819212643e-01f, 8.314696123e-01f, 7.730104534e-01f, 7.071067812e-01f, 6.343932842e-01f, 5.555702330e-01f, 4.713967368e-01f, 3.826834324e-01f, 2.902846773e-01f, 1.950903220e-01f, 9.801714033e-02f, 0.0f, -9.801714033e-02f, -1.950903220e-01f, -2.902846773e-01f, -3.826834324e-01f, -4.713967368e-01f, -5.555702330e-01f, -6.343932842e-01f, -7.071067812e-01f, -7.730104534e-01f, -8.314696123e-01f, -8.819212643e-01f, -9.238795325e-01f, -9.569403357e-01f, -9.807852804e-01f, -9.951847267e-01f};
static __device__ constexpr float S64T[32] = {0.000000000e+00f, 9.801714033e-02f, 1.950903220e-01f, 2.902846773e-01f, 3.826834324e-01f, 4.713967368e-01f, 5.555702330e-01f, 6.343932842e-01f, 7.071067812e-01f, 7.730104534e-01f, 8.314696123e-01f, 8.819212643e-01f, 9.238795325e-01f, 9.569403357e-01f, 9.807852804e-01f, 9.951847267e-01f, 1.000000000e+00f, 9.951847267e-01f, 9.807852804e-01f, 9.569403357e-01f, 9.238795325e-01f, 8.819212643e-01f, 8.314696123e-01f, 7.730104534e-01f, 7.071067812e-01f, 6.343932842e-01f, 5.555702330e-01f, 4.713967368e-01f, 3.826834324e-01f, 2.902846773e-01f, 1.950903220e-01f, 9.801714033e-02f};

namespace fft {
constexpr int L = SEQ, N2 = 2 * SEQ;
constexpr int XSLOTS = 17904;
constexpr int LDS_X_BYTES = XSLOTS * 8;
constexpr int LDS_RED = LDS_X_BYTES;
typedef LAS f32x2* xptr;
typedef unsigned spec_t;
__device__ __forceinline__ unsigned pack_h2(float lo, float hi) { typedef _Float16 h2v __attribute__((ext_vector_type(2))); const h2v v = {(_Float16)lo, (_Float16)hi}; return __builtin_bit_cast(unsigned, v); }
__device__ __forceinline__ f32x2 unpack_h2(unsigned w) { typedef _Float16 h2v __attribute__((ext_vector_type(2))); const h2v v = __builtin_bit_cast(h2v, w); return (f32x2){(float)v.x, (float)v.y}; }
__device__ __forceinline__ f32x2 cmul(f32x2 a, f32x2 b) { return (f32x2){a.x * b.x - a.y * b.y, a.x * b.y + a.y * b.x}; }
__device__ __forceinline__ f32x2 cmulc(f32x2 a, f32x2 b) { return (f32x2){a.x * b.x + a.y * b.y, a.y * b.x - a.x * b.y}; }
__device__ __forceinline__ f32x2 expi(float x) { float s, c; sincospif(x, &s, &c); return (f32x2){c, s}; }
constexpr __host__ __device__ int bitrev(int j, int R) { int r = 0; for (int b = 1; b < R; b <<= 1) { r = (r << 1) | (j & 1); j >>= 1; } return r; }

template <int R, int S, bool INV> struct Stage {
    static __device__ __forceinline__ void run(f32x2 (&a)[R]) {
#pragma unroll
        for (int base = 0; base < R; base += 2 * S)
#pragma unroll
            for (int k = 0; k < S; ++k) {
                const int i0 = base + k, i1 = i0 + S, ti = k * (16 / S);
                const f32x2 u = a[i0], v = a[i1]; a[i0] = u + v; const f32x2 d = u - v;
                if (ti == 0) a[i1] = d;
                else if (ti == 8) a[i1] = INV ? (f32x2){-d.y, d.x} : (f32x2){d.y, -d.x};
                else { const float c = C32T[ti], s = S32T[ti]; a[i1] = INV ? (f32x2){d.x * c - d.y * s, d.x * s + d.y * c} : (f32x2){d.x * c + d.y * s, d.y * c - d.x * s}; }
            }
        if constexpr (S > 1) Stage<R, S / 2, INV>::run(a);
    }
};
template <int R, bool INV> __device__ __forceinline__ void dft(f32x2 (&a)[R]) {
    Stage<R, R / 2, INV>::run(a);
    f32x2 t[R];
#pragma unroll
    for (int j = 0; j < R; ++j) t[j] = a[bitrev(j, R)];
#pragma unroll
    for (int j = 0; j < R; ++j) a[j] = t[j];
}
template <int R, bool CONJ> __device__ __forceinline__ void twiddle(f32x2 (&a)[R], f32x2 w) {
    f32x2 tw[R]; tw[0] = (f32x2){1.f, 0.f}; tw[1] = w;
#pragma unroll
    for (int j = 2; j < R; ++j) tw[j] = cmul(tw[j >> 1], tw[j - (j >> 1)]);
#pragma unroll
    for (int j = 1; j < R; ++j) a[j] = CONJ ? cmulc(a[j], tw[j]) : cmul(a[j], tw[j]);
}
__device__ __forceinline__ void bar() { __syncthreads(); }
__device__ __forceinline__ int opaque(int v) { return opaque_i(v); }

__device__ __forceinline__ void fwd12(xptr X, int tid) {
    f32x2 a[32];
    { const int p0 = tid + (tid >> 4);
#pragma unroll
      for (int q = 0; q < 32; ++q) a[q] = X[p0 + 560 * q];
      dft<32, false>(a); twiddle<32, false>(a, expi(-(float)opaque(tid) * (1.0f / 8192.0f)));
#pragma unroll
      for (int q = 0; q < 32; ++q) X[p0 + 560 * q] = a[q]; }
    bar();
    { const int blk = tid >> 4, np = tid & 15, p0 = 560 * blk + np;
#pragma unroll
      for (int q = 0; q < 32; ++q) a[q] = X[p0 + 17 * q];
      dft<32, false>(a); twiddle<32, false>(a, expi(-(float)opaque(np) * (1.0f / 256.0f)));
#pragma unroll
      for (int q = 0; q < 32; ++q) X[p0 + 17 * q] = a[q]; }
    bar();
}
__device__ __forceinline__ void inv21(xptr X, int tid, f32x2 (&a)[32]) {
    { const int blk = tid >> 4, np = tid & 15, p0 = 560 * blk + np;
#pragma unroll
      for (int q = 0; q < 32; ++q) a[q] = X[p0 + 17 * q];
      twiddle<32, true>(a, expi(-(float)opaque(np) * (1.0f / 256.0f))); dft<32, true>(a);
#pragma unroll
      for (int q = 0; q < 32; ++q) X[p0 + 17 * q] = a[q]; }
    bar();
    { const int p0 = tid + (tid >> 4);
#pragma unroll
      for (int q = 0; q < 32; ++q) a[q] = X[p0 + 560 * q];
      twiddle<32, true>(a, expi(-(float)opaque(tid) * (1.0f / 8192.0f))); dft<32, true>(a); }
}
template <int MODE> __device__ __forceinline__ void pass3(xptr X, int tid, spec_t* G, float scale) {
    u32x2 kv[2][8];
    if (MODE == 1) {
#pragma unroll
        for (int gi = 0; gi < 2; ++gi)
#pragma unroll
            for (int j2 = 0; j2 < 8; ++j2) kv[gi][j2] = *(const u32x2*)(G + j2 * 2048 + 2 * (tid + 512 * gi));
    }
#pragma unroll
    for (int gi = 0; gi < 2; ++gi) {
        const int g = tid + 512 * gi, p0 = 17 * g + 16 * (g >> 5);
        f32x2 a[16];
#pragma unroll
        for (int q = 0; q < 16; ++q) a[q] = X[p0 + q];
        dft<16, false>(a);
        if (MODE == 0) {
#pragma unroll
            for (int j = 0; j < 16; j += 2) { u32x2 o; o.x = pack_h2(a[j].x * scale, a[j].y * scale); o.y = pack_h2(a[j + 1].x * scale, a[j + 1].y * scale); *(u32x2*)(G + (j >> 1) * 2048 + 2 * g) = o; }
        } else {
#pragma unroll
            for (int j = 0; j < 16; j += 2) { const u32x2 k2 = kv[gi][j >> 1]; a[j] = cmul(a[j], unpack_h2(k2.x)); a[j + 1] = cmul(a[j + 1], unpack_h2(k2.y)); }
            dft<16, true>(a);
#pragma unroll
            for (int q = 0; q < 16; ++q) X[p0 + q] = a[q];
        }
        asm volatile("" ::: "memory");
    }
    if (MODE == 1) bar();
}
__device__ __forceinline__ f32x2 wN(f32x2 base, int q) { return cmul(base, (f32x2){C64T[q], -S64T[q]}); }

__device__ __forceinline__ void filter_unit(LAS unsigned char* lds, const bf16_t* kf, const bf16_t* kb, spec_t* KFo) {
    xptr X = (xptr)lds; LAS float* red = (LAS float*)(lds + LDS_RED);
    const int tid = opaque_i(threadIdx.x), p0 = tid + (tid >> 4);
    const f32x2 base = expi(-(float)tid * (1.0f / 16384.0f));
    float nrm = 0.f;
    {   float fv[32], bv[32];
#pragma unroll
        for (int q = 0; q < 32; ++q) { const int n = tid + 512 * q; fv[q] = bf2f(kf[n]); bv[q] = bf2f(kb[n >= 1 ? L - n : 0]); }
#pragma unroll
        for (int q = 0; q < 32; ++q) { const int n = tid + 512 * q; const float f = fv[q], b = n >= 1 ? bv[q] : 0.f; nrm += fabsf(f) + fabsf(b); X[p0 + 560 * q] = (f32x2){f + b, 0.f}; } }
    nrm = wave_sum(nrm); if ((tid & 63) == 0) red[tid >> 6] = nrm;
    bar();
    float tot = 0.f;
#pragma unroll
    for (int i = 0; i < 8; ++i) tot += red[i];
    const float scale = 1.0f / tot;
    fwd12(X, tid); pass3<0>(X, tid, KFo, scale);
    bar();
    asm volatile("" ::: "memory");
    {   float fv[32], bv[32];
        const int tq = opaque(tid);
#pragma unroll
        for (int q = 0; q < 32; ++q) { const int n = tq + 512 * q; fv[q] = bf2f(kf[n]); bv[q] = bf2f(kb[n >= 1 ? L - n : 0]); }
#pragma unroll
        for (int q = 0; q < 32; ++q) { const int n = tq + 512 * q; const float d = fv[q] - (n >= 1 ? bv[q] : 0.f); const f32x2 w = wN(base, q); X[p0 + 560 * q] = (f32x2){d * w.x, d * w.y}; } }
    bar();
    fwd12(X, tid); pass3<0>(X, tid, KFo + L, scale);
    bar();
}

__device__ __forceinline__ void stage_row(LAS unsigned char* lds, const bf16_t* row, int tid_) {
    const int tid = opaque(tid_), wv = __builtin_amdgcn_readfirstlane(tid >> 6), lane = tid & 63;
#pragma unroll
    for (int it = 0; it < 8; ++it) { const int e = (it * 8 + wv) * 64 + lane, b = e >> 11, ck = e & 2047;
        __builtin_amdgcn_global_load_lds((const unsigned*)(row + (size_t)b * SEQ + 8 * ck), (LAS unsigned*)(lds + (it * 8 + wv) * 1024), 16, 0, 0); }
}
__device__ __forceinline__ f32x2 conv3_lds(const LAS bf16_t* S, int n, float w0, float w1, float w2, float wb) {
    const int nm = n > 0 ? n - 1 : 0, np = n + 1 < SEQ ? n + 1 : SEQ - 1; const float wm = n > 0 ? w0 : 0.f, wp = n + 1 < SEQ ? w2 : 0.f;
    const float a0 = wb + w1 * bf2f(S[n]) + wm * bf2f(S[nm]) + wp * bf2f(S[np]);
    const float a1 = wb + w1 * bf2f(S[SEQ + n]) + wm * bf2f(S[SEQ + nm]) + wp * bf2f(S[SEQ + np]);
    return (f32x2){a0, a1};
}
__device__ __forceinline__ void hyena_unit(LAS unsigned char* lds, int c, const bf16_t* PTV, const spec_t* KFc, size_t ostride, const float* cw, const float* cb, const float* hbias,
                                           unsigned* Zs, unsigned* Rs, bf16_t* YMIX, int pm = 0) {
    xptr X = (xptr)lds;
    const int tid = opaque_i(threadIdx.x), p0 = tid + (tid >> 4);
#ifdef MK_HY_EXTRA
    for (int xr_ = 0; xr_ < MK_HY_EXTRA; ++xr_) {
        f32x2 dmy[32];
        bar(); fwd12(X, tid); pass3<1>(X, tid, KFc, 1.f); inv21(X, tid, dmy);
#pragma unroll
        for (int q = 0; q < 32; ++q) asm volatile("" :: "v"(dmy[q].x), "v"(dmy[q].y));
        bar();
    }
#endif
    f32x2 a[32];
    { const float w0 = cw[c], w1 = cw[768 + c], w2 = cw[1536 + c], wb = cb[c];
      bar(); stage_row(lds, PTV + (size_t)c * MT, tid); bar();
      const int t0 = opaque(tid);
#pragma unroll
      for (int q0 = 0; q0 < 32; q0 += 8) {
#pragma unroll
          for (int q = q0; q < q0 + 8; ++q) a[q] = conv3_lds((const LAS bf16_t*)lds, t0 + 512 * q, w0, w1, w2, wb);
          asm volatile("" ::: "memory"); }
      bar(); }
#pragma unroll 1
    for (int order = 0; order < 2; ++order) {
        const spec_t* Ke = KFc + (size_t)order * ostride; const spec_t* Ko = Ke + L;
        { const int t1 = opaque(tid);
#pragma unroll
          for (int q = 0; q < 32; ++q) { const unsigned zp = pg8::cvt_pk_bf16(a[q].x, a[q].y); Zs[t1 + 512 * q] = zp; X[p0 + 560 * q] = (f32x2){bf2f(zp & 0xffffu), bf2f(zp >> 16)}; } }
        bar();
#ifdef MK_HY_PM
        if (!(pm & 2))
#endif
        { fwd12(X, tid); pass3<1>(X, tid, const_cast<spec_t*>(Ke), 1.f); inv21(X, tid, a); }
        { const int t2 = opaque(tid);
#pragma unroll
          for (int q = 0; q < 32; ++q) Rs[t2 + 512 * q] = pg8::cvt_pk_bf16(a[q].x, a[q].y); }
        asm volatile("" ::: "memory");
        const int t3 = opaque(tid); const f32x2 base1 = expi(-(float)t3 * (1.0f / 16384.0f));
#pragma unroll
        for (int q = 0; q < 32; ++q) { const unsigned zp = Zs[t3 + 512 * q]; a[q] = (f32x2){bf2f(zp & 0xffffu), bf2f(zp >> 16)}; }
#pragma unroll
        for (int q = 0; q < 32; ++q) X[p0 + 560 * q] = cmul(a[q], wN(base1, q));
        bar();
#ifdef MK_HY_PM
        if (!(pm & 2))
#endif
        { fwd12(X, tid); pass3<1>(X, tid, const_cast<spec_t*>(Ko), 1.f); inv21(X, tid, a); }
        const int grow = (order == 0 ? 256 : 512) + c;
        const float g0 = cw[grow], g1 = cw[768 + grow], g2 = cw[1536 + grow], gb = cb[grow], hb = hbias[order * 256 + c];
        { const int t4 = opaque(tid); const f32x2 base2 = expi(-(float)t4 * (1.0f / 16384.0f));
#pragma unroll
          for (int q0 = 0; q0 < 32; q0 += 16) { unsigned r1p[16];
#pragma unroll
              for (int q = 0; q < 16; ++q) r1p[q] = Rs[t4 + 512 * (q0 + q)];
#pragma unroll
              for (int q = 0; q < 16; ++q) a[q0 + q] = (f32x2){bf2f(r1p[q] & 0xffffu), bf2f(r1p[q] >> 16)} + cmulc(a[q0 + q], wN(base2, q0 + q));
              asm volatile("" ::: "memory"); } }
        bar();
        stage_row(lds, PTV + (size_t)grow * MT, tid);
        bar();
        { const int t5 = opaque(tid);
#pragma unroll
          for (int q0 = 0; q0 < 32; q0 += 16) { unsigned zqp[16];
#pragma unroll
              for (int q = 0; q < 16; ++q) zqp[q] = Zs[t5 + 512 * (q0 + q)];
#pragma unroll
              for (int q = 0; q < 16; ++q) { const f32x2 gt = conv3_lds((const LAS bf16_t*)lds, t5 + 512 * (q0 + q), g0, g1, g2, gb);
                  a[q0 + q] = (f32x2){gt.x * (a[q0 + q].x * (1.0f / (float)N2) + hb * bf2f(zqp[q] & 0xffffu)), gt.y * (a[q0 + q].y * (1.0f / (float)N2) + hb * bf2f(zqp[q] >> 16))}; }
              asm volatile("" ::: "memory"); } }
        bar();
    }
    { bf16_t* yp = YMIX + (size_t)c * MT + tid;
#pragma unroll
      for (int q = 0; q < 32; ++q) { const unsigned pw_ = pg8::cvt_pk_bf16(a[q].x, a[q].y); yp[0] = (bf16_t)(pw_ & 0xffffu); yp[SEQ] = (bf16_t)(pw_ >> 16); yp += 512; asm volatile("" : "+v"(yp)); } }
}
}

constexpr int MK_LDS_BYTES = 147456;
static_assert(fft::LDS_RED + 64 <= MK_LDS_BYTES, "LDS map");
namespace lru {
constexpr int TC = 64, NCH = 260, NSU = 130;
constexpr int RS = 264, RSB = RS * 2;
constexpr int XR_OFF = 0, XR_BYTES = (TC + 3) * RSB;
constexpr int XG_OFF = XR_OFF + XR_BYTES;
constexpr int HY_OFF = XG_OFF + TC * RSB;
constexpr int CW_OFF = HY_OFF + TC * RSB;
constexpr int CAR_OFF = CW_OFF + 5 * 1024;
constexpr int U_OFF = CAR_OFF + 4 * 1024;
constexpr int LDS_END = U_OFF + TC * RSB;
static_assert(LDS_END <= 147456 - 64 && (U_OFF % 16) == 0 && (XG_OFF % 16) == 0 && (HY_OFF % 16) == 0 && (CW_OFF % 16) == 0, "lru LDS map");
constexpr float LOG2E = 1.4426950408889634f;
struct Params {
    const bf16_t* QKL; const bf16_t* LW;
    const float *cw, *cb, *ba, *bi, *lam;
    f32x2* AGG;
    bf16_t* YMIX;
};
__device__ __forceinline__ int chunk_row0(int b, int k) { return k < 4 ? NLAT + b * CTXL + 64 * k : b * SEQ + 64 * (k - 4); }
__device__ __forceinline__ float fsig(float x) { return __builtin_amdgcn_rcpf(1.0f + __builtin_amdgcn_exp2f(-LOG2E * x)); }

struct LaneConst { int ch[2]; };
struct DirConst { bf16x8 Bf[2][2][2]; float ba[2], bi[2], sp2[2]; };
__device__ __forceinline__ void load_dir(const Params& P, int dir, int n, int hf, int l15, int kg, const LaneConst& lc, DirConst& dc) {
#pragma unroll
    for (int ty = 0; ty < 2; ++ty)
#pragma unroll
        for (int cc = 0; cc < 2; ++cc)
#pragma unroll
            for (int ks = 0; ks < 2; ++ks) dc.Bf[ty][cc][ks] = *(const bf16x8*)(P.LW + ((((size_t)dir * 4 + n) * 2 + ty) * 64 + 32 * hf + 16 * cc + l15) * 64 + 32 * ks + 8 * kg);
#pragma unroll
    for (int cc = 0; cc < 2; ++cc) { dc.ba[cc] = P.ba[dir * 256 + lc.ch[cc]]; dc.bi[cc] = P.bi[dir * 256 + lc.ch[cc]]; dc.sp2[cc] = -8.0f * LOG2E * log1pf(expf(-P.lam[dir * 256 + lc.ch[cc]])); }
}
template <bool FINAL, int DIR>
__device__ __forceinline__ void tile_dir(LAS unsigned char* lds, const LaneConst& lc, const DirConst& dc, int n, int lane, int ss, LAS bf16_t* Hs, float (&car)[2], float (&Pm)[2], float (&Qm)[2]) {
    const int l15 = lane & 15, kg = lane >> 4;
    const LAS bf16_t* UU = (const LAS bf16_t*)(lds + U_OFF);
    bf16x8 Af[2];
#pragma unroll
    for (int ks = 0; ks < 2; ++ks) Af[ks] = *(const LAS bf16x8*)(UU + (16 * ss + l15) * RS + 64 * n + 32 * ks + 8 * kg);
#pragma unroll
    for (int cc = 0; cc < 2; ++cc) {
        f32x4 ar = (f32x4){0.f, 0.f, 0.f, 0.f}, ai = ar;
        ar = __builtin_amdgcn_mfma_f32_16x16x32_bf16(Af[0], dc.Bf[0][cc][0], ar, 0, 0, 0); ar = __builtin_amdgcn_mfma_f32_16x16x32_bf16(Af[1], dc.Bf[0][cc][1], ar, 0, 0, 0);
        ai = __builtin_amdgcn_mfma_f32_16x16x32_bf16(Af[0], dc.Bf[1][cc][0], ai, 0, 0, 0); ai = __builtin_amdgcn_mfma_f32_16x16x32_bf16(Af[1], dc.Bf[1][cc][1], ai, 0, 0, 0);
        const int ch = lc.ch[cc];
        float av[4], bv[4];
#pragma unroll
        for (int rg = 0; rg < 4; ++rg) { const int r = 16 * ss + 4 * kg + rg;
            const float u = bf2f(UU[r * RS + ch]);
            const float rgt = fsig(ar[rg] + dc.ba[cc]), igt = fsig(ai[rg] + dc.bi[cc]);
            const float x2 = rgt * dc.sp2[cc]; const float a = __builtin_amdgcn_exp2f(x2), a2 = a * a;
            av[rg] = a; bv[rg] = __builtin_amdgcn_sqrtf(fmaxf(1.0f - a2, 0.f)) * (igt * u); }
        float Pl = 1.f, Ql = 0.f;
#pragma unroll
        for (int i = 0; i < 4; ++i) { const int rg = DIR == 0 ? i : 3 - i; Ql = av[rg] * Ql + bv[rg]; Pl *= av[rg]; }
        const int pos = DIR == 0 ? kg : 3 - kg;
        { const int src = DIR == 0 ? lane - 16 : lane + 16; const float Pp = __shfl(Pl, src), Qp = __shfl(Ql, src); if (pos >= 1) { Ql = Pl * Qp + Ql; Pl = Pl * Pp; } }
        { const int src = DIR == 0 ? lane - 32 : lane + 32; const float Pp = __shfl(Pl, src), Qp = __shfl(Ql, src); if (pos >= 2) { Ql = Pl * Qp + Ql; Pl = Pl * Pp; } }
        const int lastsrc = DIR == 0 ? l15 + 48 : l15;
        const float Pt = __shfl(Pl, lastsrc), Qt = __shfl(Ql, lastsrc);
        if (FINAL) {
            const int src = DIR == 0 ? lane - 16 : lane + 16; float Pe = __shfl(Pl, src), Qe = __shfl(Ql, src); if (pos == 0) { Pe = 1.f; Qe = 0.f; }
            float h = Pe * car[cc] + Qe;
#pragma unroll
            for (int i = 0; i < 4; ++i) { const int rg = DIR == 0 ? i : 3 - i; h = av[rg] * h + bv[rg]; Hs[(16 * ss + 4 * kg + rg) * RS + ch] = (bf16_t)pg8::cvt_pk_bf16(h, h); }
            car[cc] = Pt * car[cc] + Qt;
        } else { Qm[cc] = Pt * Qm[cc] + Qt; Pm[cc] = Pt * Pm[cc]; }
    }
}
__device__ __forceinline__ void load_chunk(LAS unsigned char* lds, const Params& P, int b, int k, bool with_xg, int tid) {
    const int Ls = k < 4 ? CTXL : SEQ, kk = k < 4 ? k : k - 4, seq0 = k < 4 ? NLAT + b * CTXL : b * SEQ, t0 = 64 * kk - 2;
    {   u32x4 vr[5];
#pragma unroll
        for (int i5 = 0; i5 < 5; ++i5) { const int e = tid + 512 * i5, i = e >> 5, cchunk = e & 31, t = t0 + i;
            vr[i5] = (u32x4){0u, 0u, 0u, 0u};
            if (e < (TC + 3) * 32 && t >= 0 && t < Ls) vr[i5] = *(const u32x4*)(P.QKL + (size_t)(seq0 + t) * NQKL + 1024 + 8 * cchunk); }
#pragma unroll
        for (int i5 = 0; i5 < 5; ++i5) { const int e = tid + 512 * i5, i = e >> 5, cchunk = e & 31; if (e < (TC + 3) * 32) *(LAS u32x4*)(lds + XR_OFF + i * RSB + cchunk * 16) = vr[i5]; }
        asm volatile("" ::: "memory"); }
    if (with_xg) { u32x4 vg[4];
#pragma unroll
        for (int i4 = 0; i4 < 4; ++i4) { const int e = tid + 512 * i4, i = e >> 5, cchunk = e & 31; vg[i4] = *(const u32x4*)(P.QKL + (size_t)(seq0 + 64 * kk + i) * NQKL + 1280 + 8 * cchunk); }
#pragma unroll
        for (int i4 = 0; i4 < 4; ++i4) { const int e = tid + 512 * i4, i = e >> 5, cchunk = e & 31; *(LAS u32x4*)(lds + XG_OFF + i * RSB + cchunk * 16) = vg[i4]; }
    }
}
template <bool FINAL>
__device__ __forceinline__ void super_unit(LAS unsigned char* lds, const Params& P, int su) {
    const int tid = opaque_i(threadIdx.x), lane = tid & 63, wid = tid >> 6, n = wid >> 1, hf = wid & 1, l15 = lane & 15, kg = lane >> 4;
    const bool isctx = su >= 256; const int b = isctx ? (su - 256) >> 2 : su >> 7, s = isctx ? ((su - 256) & 3) >> 1 : 2 + (su & 127), k0 = isctx ? (su - 256) & 3 : 2 * s, nchk = isctx ? 1 : 2;
    LAS float* CW = (LAS float*)(lds + CW_OFF); LAS float* CAR = (LAS float*)(lds + CAR_OFF);
    f32x2* AGG64 = P.AGG; f32x2* AGG128 = P.AGG + (size_t)2 * NCH * 2 * 256;
    __syncthreads();
    for (int e = tid; e < 5 * 256; e += 512) CW[e] = e < 1024 ? P.cw[e] : P.cb[e - 1024];
    if (FINAL) {
        const int dir = tid >> 8, ch = tid & 255;
        const f32x2* a64 = AGG64 + ((size_t)b * NCH * 2 + dir) * 256 + ch;
        const f32x2* a128 = AGG128 + ((size_t)b * NSU * 2 + dir) * 256 + ch;
        const int nc = isctx ? (dir == 0 ? k0 : 3 - k0) : 4;
        const int npos = nc + (isctx ? 0 : (dir == 0 ? s - 2 : 129 - s));
        float h = 0.f;
#pragma unroll 1
        for (int p0 = 0; p0 < 132; p0 += 33) {
            if (p0 >= npos) break;
            f32x2 v[33];
#pragma unroll
            for (int i = 0; i < 33; ++i) { const int p = p0 + i, pc = p < npos ? p : 0;
                const f32x2* src = pc < nc ? a64 + (size_t)(dir == 0 ? pc : 3 - pc) * 512 : a128 + (size_t)(dir == 0 ? 2 + (pc - nc) : 129 - (pc - nc)) * 512;
                v[i] = *src; }
#pragma unroll
            for (int i = 0; i < 33; ++i) { const bool live = p0 + i < npos; h = (live ? v[i].x : 1.f) * h + (live ? v[i].y : 0.f); }
        }
        if (dir == 0) CAR[0 * 512 + ch] = h;
        else if (isctx) CAR[0 * 512 + 256 + ch] = h;
        else { CAR[1 * 512 + 256 + ch] = h; const f32x2 v = AGG64[(((size_t)b * NCH + k0 + 1) * 2 + 1) * 256 + ch]; CAR[0 * 512 + 256 + ch] = v.x * h + v.y; }
    }
    LaneConst lc;
#pragma unroll
    for (int cc = 0; cc < 2; ++cc) lc.ch[cc] = 64 * n + 32 * hf + 16 * cc + l15;
    float car0[2] = {0.f, 0.f};
    float P0m[2][2], Q0m[2][2];
#pragma unroll 1
    for (int j = 0; j < nchk; ++j) {
        const int k = k0 + j, row0 = chunk_row0(b, k);
        if (j > 0) __syncthreads();
#ifdef MK_LRU_XL
        if (!FINAL) for (int xl_ = 0; xl_ < MK_LRU_XL; ++xl_) { load_chunk(lds, P, b, k, FINAL, tid); __syncthreads(); }
#endif
        load_chunk(lds, P, b, k, FINAL, tid);
        __syncthreads();
        {
            const int cg8 = 8 * (tid & 31); const LAS float* CWr = (const LAS float*)(lds + CW_OFF); const LAS bf16_t* XRr = (const LAS bf16_t*)(lds + XR_OFF);
            f32x4 wl[5], wh[5];
#pragma unroll
            for (int kx = 0; kx < 5; ++kx) { wl[kx] = *(const LAS f32x4*)(CWr + kx * 256 + cg8); wh[kx] = *(const LAS f32x4*)(CWr + kx * 256 + cg8 + 4); }
#pragma unroll
            for (int i = 0; i < 4; ++i) { const int tok = (tid >> 5) + 16 * i; f32x4 lo = wl[4], hi = wh[4];
#pragma unroll
                for (int kx = 0; kx < 4; ++kx) { const u32x4 xw = *(const LAS u32x4*)(XRr + (tok + kx) * RS + cg8);
                    lo[0] += wl[kx][0] * bf2f(xw.x & 0xffffu); lo[1] += wl[kx][1] * bf2f(xw.x >> 16); lo[2] += wl[kx][2] * bf2f(xw.y & 0xffffu); lo[3] += wl[kx][3] * bf2f(xw.y >> 16);
                    hi[0] += wh[kx][0] * bf2f(xw.z & 0xffffu); hi[1] += wh[kx][1] * bf2f(xw.z >> 16); hi[2] += wh[kx][2] * bf2f(xw.w & 0xffffu); hi[3] += wh[kx][3] * bf2f(xw.w >> 16); }
                u32x4 pw; pw.x = pg8::cvt_pk_bf16(lo[0], lo[1]); pw.y = pg8::cvt_pk_bf16(lo[2], lo[3]); pw.z = pg8::cvt_pk_bf16(hi[0], hi[1]); pw.w = pg8::cvt_pk_bf16(hi[2], hi[3]);
                *(LAS u32x4*)(lds + U_OFF + tok * RSB + cg8 * 2) = pw; }
        }
        __syncthreads();
        {
            float carF[2], carR[2], PmF[2] = {1.f, 1.f}, QmF[2] = {0.f, 0.f}, PmR[2] = {1.f, 1.f}, QmR[2] = {0.f, 0.f};
            if (FINAL) {
#pragma unroll
                for (int cc = 0; cc < 2; ++cc) { carF[cc] = j == 1 ? car0[cc] : CAR[0 * 256 + lc.ch[cc]]; carR[cc] = CAR[j * 512 + 256 + lc.ch[cc]]; }
            } else { carF[0] = carF[1] = carR[0] = carR[1] = 0.f; }
            LAS bf16_t* H0 = (LAS bf16_t*)(lds + HY_OFF); LAS bf16_t* H1 = (LAS bf16_t*)(lds + XR_OFF);
            {   DirConst dc0, dc1; load_dir(P, 0, n, hf, l15, kg, lc, dc0); load_dir(P, 1, n, hf, l15, kg, lc, dc1);
#ifdef MK_LRU_XS
                if (!FINAL) for (int xs_ = 0; xs_ < MK_LRU_XS; ++xs_) { float c1_[2] = {0.f, 0.f}, c2_[2] = {0.f, 0.f}, p1_[2] = {1.f, 1.f}, q1_[2] = {0.f, 0.f}, p2_[2] = {1.f, 1.f}, q2_[2] = {0.f, 0.f};
#pragma unroll 1
                    for (int sx = 0; sx < 4; ++sx) { tile_dir<false, 0>(lds, lc, dc0, n, lane, sx, H0, c1_, p1_, q1_); tile_dir<false, 1>(lds, lc, dc1, n, lane, 3 - sx, H1, c2_, p2_, q2_); }
                    asm volatile("" :: "v"(p1_[0]), "v"(q1_[0]), "v"(p2_[1]), "v"(q2_[1])); }
#endif
#pragma unroll 1
                for (int sx = 0; sx < 4; ++sx) { tile_dir<FINAL, 0>(lds, lc, dc0, n, lane, sx, H0, carF, PmF, QmF); tile_dir<FINAL, 1>(lds, lc, dc1, n, lane, 3 - sx, H1, carR, PmR, QmR); } }
            if (FINAL) { car0[0] = carF[0]; car0[1] = carF[1]; }
            else {
#pragma unroll
                for (int cc = 0; cc < 2; ++cc) {
                    if (kg == 0) { AGG64[(((size_t)b * NCH + k) * 2 + 0) * 256 + lc.ch[cc]] = (f32x2){PmF[cc], QmF[cc]}; AGG64[(((size_t)b * NCH + k) * 2 + 1) * 256 + lc.ch[cc]] = (f32x2){PmR[cc], QmR[cc]}; }
                    if (j == 0) { P0m[0][cc] = PmF[cc]; Q0m[0][cc] = QmF[cc]; P0m[1][cc] = PmR[cc]; Q0m[1][cc] = QmR[cc]; }
                    else if (kg == 0) {
                        AGG128[(((size_t)b * NSU + s) * 2 + 0) * 256 + lc.ch[cc]] = (f32x2){P0m[0][cc] * PmF[cc], PmF[cc] * Q0m[0][cc] + QmF[cc]};
                        AGG128[(((size_t)b * NSU + s) * 2 + 1) * 256 + lc.ch[cc]] = (f32x2){P0m[1][cc] * PmR[cc], P0m[1][cc] * QmR[cc] + Q0m[1][cc]}; }
                }
            }
        }
        if (FINAL) {
            __syncthreads();
            for (int e = tid; e < TC * 32; e += 512) { const int i = e >> 5, cchunk = e & 31;
                const u32x4 hf4 = *(const LAS u32x4*)(lds + HY_OFF + i * RSB + cchunk * 16), hr4 = *(const LAS u32x4*)(lds + XR_OFF + i * RSB + cchunk * 16), xg4 = *(const LAS u32x4*)(lds + XG_OFF + i * RSB + cchunk * 16);
                u32x4 o;
#pragma unroll
                for (int w2 = 0; w2 < 4; ++w2) { float y2[2];
#pragma unroll
                    for (int hh = 0; hh < 2; ++hh) { const float hs = bf2f(hh ? hf4[w2] >> 16 : hf4[w2] & 0xffffu) + bf2f(hh ? hr4[w2] >> 16 : hr4[w2] & 0xffffu), xg = bf2f(hh ? xg4[w2] >> 16 : xg4[w2] & 0xffffu);
                        y2[hh] = hs * (xg * fsig(1.5957691216057308f * (xg + 0.044715f * xg * xg * xg))); }
                    o[w2] = pg8::cvt_pk_bf16(y2[0], y2[1]); }
                *(u32x4*)(P.YMIX + (size_t)(row0 + i) * D + 768 + 8 * cchunk) = o; }
        }
    }
}
}
namespace na {
constexpr float LOG2E = 1.4426950408889634f, QSCALE = 0.125f * LOG2E;
constexpr int KC_OFF = 0, VC_OFF = 32768;
constexpr int KL_OFF = 0, VL_OFF = 61440, RPB_OFF = 122880;
constexpr int LDS_END = RPB_OFF + 15 * 32 * 4;
static_assert(LDS_END <= 147456, "na LDS map");
struct Params { const bf16_t* QKL; const bf16_t* VT; const float* rpb; bf16_t* YMIX; };

struct RowState { f32x4 o[4]; float m, l; };
template <bool LOCAL>
__device__ __forceinline__ void chunk(LAS unsigned char* lds, RowState& st, const bf16x8 (&Qf)[2], int kbase, int kstride_pair, int vbase, int lane, int cq, int drbase, int kc0) {
    const int l15 = lane & 15, kg = lane >> 4;
    f32x4 S[8];
#pragma unroll
    for (int t = 0; t < 8; ++t) {
        const int krow = LOCAL ? (kbase + (t >> 1) * kstride_pair + (t & 1) * 16 * 128) : (kbase + t * 16 * 128);
        const int ka = krow + l15 * 128;
        const bf16x8 k0 = *(const LAS bf16x8*)(lds + ka + (((0 + kg) ^ (l15 & 7)) << 4));
        const bf16x8 k1 = *(const LAS bf16x8*)(lds + ka + (((4 + kg) ^ (l15 & 7)) << 4));
        f32x4 s = (f32x4){0.f, 0.f, 0.f, 0.f};
        s = __builtin_amdgcn_mfma_f32_16x16x32_bf16(k0, Qf[0], s, 0, 0, 0);
        s = __builtin_amdgcn_mfma_f32_16x16x32_bf16(k1, Qf[1], s, 0, 0, 0);
        S[t] = s;
    }
    int bidx[2][4];
    if (LOCAL) {
        const int start = min(max(cq - 8, 0), GRIDW - 16);
#pragma unroll
        for (int hh = 0; hh < 2; ++hh)
#pragma unroll
            for (int rg = 0; rg < 4; ++rg) { const int kcol = kc0 + 16 * hh + 4 * kg + rg; const bool valid = (kcol >= start) && (kcol < start + 16); bidx[hh][rg] = RPB_OFF + (drbase * 32 + (valid ? kcol - cq + 15 : 31)) * 4; }
    }
    float mx = -3.0e38f;
#pragma unroll
    for (int t = 0; t < 8; ++t) {
        if (LOCAL) {
#pragma unroll
            for (int rg = 0; rg < 4; ++rg) S[t][rg] = __builtin_fmaf(S[t][rg], QSCALE, *(const LAS float*)(lds + bidx[t & 1][rg] + (t >> 1) * 128));
        }
        mx = fmaxf(mx, fmaxf(fmaxf(S[t][0], S[t][1]), fmaxf(S[t][2], S[t][3])));
    }
    if (!LOCAL) mx *= QSCALE;
    mx = fmaxf(mx, __shfl_xor(mx, 16)); mx = fmaxf(mx, __shfl_xor(mx, 32));
    const float mn = fmaxf(st.m, mx), alpha = __builtin_amdgcn_exp2f(st.m - mn);
    st.m = mn; st.l *= alpha;
#pragma unroll
    for (int dt = 0; dt < 4; ++dt) st.o[dt] *= alpha;
    float ls = 0.f;
#pragma unroll
    for (int t = 0; t < 8; ++t)
#pragma unroll
        for (int rg = 0; rg < 4; ++rg) { const float p = __builtin_amdgcn_exp2f(LOCAL ? S[t][rg] - mn : __builtin_fmaf(S[t][rg], QSCALE, -mn)); S[t][rg] = p; ls += p; }
    st.l += ls;
#pragma unroll
    for (int j = 0; j < 4; ++j) {
        u32x4 pw; pw.x = pg8::cvt_pk_bf16(S[2 * j][0], S[2 * j][1]); pw.y = pg8::cvt_pk_bf16(S[2 * j][2], S[2 * j][3]); pw.z = pg8::cvt_pk_bf16(S[2 * j + 1][0], S[2 * j + 1][1]); pw.w = pg8::cvt_pk_bf16(S[2 * j + 1][2], S[2 * j + 1][3]);
        const bf16x8 Pf = __builtin_bit_cast(bf16x8, pw);
        const int vgb = vbase + j * 4096;
#pragma unroll
        for (int dt = 0; dt < 4; ++dt) { const int d = 16 * dt + l15, x = 2 * ((d >> 2) & 3);
            const u32x2 v0 = *(const LAS u32x2*)(lds + vgb + d * 64 + (((0 + kg) ^ x) << 3));
            const u32x2 v1 = *(const LAS u32x2*)(lds + vgb + d * 64 + (((4 + kg) ^ x) << 3));
            const u32x4 vw = (u32x4){v0.x, v0.y, v1.x, v1.y};
            st.o[dt] = __builtin_amdgcn_mfma_f32_16x16x32_bf16(__builtin_bit_cast(bf16x8, vw), Pf, st.o[dt], 0, 0, 0); }
    }
}
__device__ __forceinline__ void glds16(const void* g, LAS unsigned char* l) { __builtin_amdgcn_global_load_lds((const unsigned*)g, (LAS unsigned*)l, 16, 0, 0); }
__device__ __forceinline__ void stage_ctx(LAS unsigned char* lds, const Params& P, int b, int h) {
    const int tids = opaque_i(threadIdx.x), wv = __builtin_amdgcn_readfirstlane(tids >> 6), lane = tids & 63;
#pragma unroll
    for (int it = 0; it < 4; ++it) { const int e = (it * 8 + wv) * 64 + lane, key = e >> 3, c = (e & 7) ^ (key & 7);
        glds16(P.QKL + (size_t)(NLAT + b * CTXL + key) * NQKL + 512 + h * 64 + 8 * c, lds + KC_OFF + (it * 8 + wv) * 1024); }
#pragma unroll
    for (int it = 0; it < 4; ++it) { const int e = (it * 8 + wv) * 64 + lane, g32 = e >> 8, d = (e >> 2) & 63, j8l = (e & 3) ^ ((d >> 2) & 3);
        glds16(P.VT + (size_t)(h * 64 + d) * MT + NLAT + b * CTXL + 32 * g32 + 8 * j8l, lds + VC_OFF + (it * 8 + wv) * 1024); }
}
__device__ __forceinline__ void load_q(const Params& P, int row, int h, int lane, bf16x8 (&Qf)[2]) {
    const bf16_t* qp = P.QKL + (size_t)row * NQKL + h * 64 + 8 * (lane >> 4);
    Qf[0] = *(const bf16x8*)(qp); Qf[1] = *(const bf16x8*)(qp + 32);
}
__device__ __forceinline__ void finish_row(const Params& P, RowState& st, int row, int h, int lane) {
    float l = st.l; l += __shfl_xor(l, 16); l += __shfl_xor(l, 32);
    const float inv = 1.0f / l;
    bf16_t* op = P.YMIX + (size_t)row * D + 256 + h * 64 + 4 * (lane >> 4);
#pragma unroll
    for (int dt = 0; dt < 4; ++dt) { const f32x4 o = st.o[dt] * inv; u32x2 w; w.x = pg8::cvt_pk_bf16(o[0], o[1]); w.y = pg8::cvt_pk_bf16(o[2], o[3]); *(u32x2*)(op + 16 * dt) = w; }
}
__device__ __forceinline__ void init_row(RowState& st) {
#pragma unroll
    for (int dt = 0; dt < 4; ++dt) st.o[dt] = (f32x4){0.f, 0.f, 0.f, 0.f};
    st.m = -1.0e30f; st.l = 0.f;
}
__device__ __forceinline__ void latent_unit(LAS unsigned char* lds, const Params& P, int u, int pm = 0) {
    const int b = u >> 8, h = (u >> 5) & 7, n = (u >> 3) & 3, rr = u & 7, r0 = 32 * rr;
    const int tid = opaque_i(threadIdx.x), lane = tid & 63, w = tid >> 6, l15 = lane & 15;
    const int kc0 = n == 0 ? 0 : (n == 1 ? 8 : (n == 2 ? 24 : 32)), cq = 16 * n + l15;
    __syncthreads();
    stage_ctx(lds, P, b, h);
    __syncthreads();
    RowState st[4]; bf16x8 Qf[2][2];
    load_q(P, b * SEQ + (r0 + w) * GRIDW + cq, h, lane, Qf[0]);
#pragma unroll
    for (int g = 0; g < 4; ++g) { init_row(st[g]);
        load_q(P, b * SEQ + (r0 + 8 * ((g + 1) & 3) + w) * GRIDW + cq, h, lane, Qf[(g + 1) & 1]);
#pragma unroll 1
        for (int cc = 0; cc < 2; ++cc) {
#ifdef MK_NA_PM
            if (pm & 2) continue;
#endif
            chunk<false>(lds, st[g], Qf[g & 1], KC_OFF + cc * 128 * 128, 0, VC_OFF + cc * 4 * 4096, lane, 0, 0, 0); } }
    __syncthreads();
    for (int e = tid; e < 15 * 32; e += 512) { const int dr = e >> 5, dc = e & 31; *(LAS float*)(lds + RPB_OFF + e * 4) = dc < 31 ? P.rpb[(h * 15 + dr) * 31 + dc] * LOG2E : -1.0e30f; }
#pragma unroll
    for (int g = 0; g < 4; ++g) {
        const int rg0 = r0 + 8 * g, lo = max(rg0 - 4, 0), hi = min(rg0 + 10, GROWS - 1), nrows = hi - lo + 1;
        if (g > 0) __syncthreads();
        { const int wv = __builtin_amdgcn_readfirstlane(tid >> 6);
          for (int it = 0; it < nrows / 2; ++it) { const int e = (it * 8 + wv) * 64 + lane, key = e >> 3, kr = key >> 5, col = key & 31, c = (e & 7) ^ (key & 7);
              glds16(P.QKL + (size_t)(b * SEQ + (lo + kr) * GRIDW + kc0 + col) * NQKL + 512 + h * 64 + 8 * c, lds + KL_OFF + (it * 8 + wv) * 1024); }
          for (int it = 0; it < nrows / 2; ++it) { const int e = (it * 8 + wv) * 64 + lane, kr = e >> 8, d = (e >> 2) & 63, j8 = (e & 3) ^ ((d >> 2) & 3);
              glds16(P.VT + (size_t)(h * 64 + d) * MT + b * SEQ + (lo + kr) * GRIDW + kc0 + 8 * j8, lds + VL_OFF + (it * 8 + wv) * 1024); }
          if (nrows & 1) {
              const int it = nrows / 2;
              if (wv < 4) { const int e = (it * 8 + wv) * 64 + lane, key = e >> 3, kr = key >> 5, col = key & 31, c = (e & 7) ^ (key & 7);
                  glds16(P.QKL + (size_t)(b * SEQ + (lo + kr) * GRIDW + kc0 + col) * NQKL + 512 + h * 64 + 8 * c, lds + KL_OFF + (it * 8 + wv) * 1024);
                  const int e2 = e, kr2 = e2 >> 8, d = (e2 >> 2) & 63, j8 = (e2 & 3) ^ ((d >> 2) & 3);
                  glds16(P.VT + (size_t)(h * 64 + d) * MT + b * SEQ + (lo + kr2) * GRIDW + kc0 + 8 * j8, lds + VL_OFF + (it * 8 + wv) * 1024); } } }
        __syncthreads();
        const int r = rg0 + w, rs = min(max(r - 4, 0), GROWS - 8), row = b * SEQ + r * GRIDW + cq;
        if (g < 3) load_q(P, b * SEQ + (r0 + 8 * (g + 1) + w) * GRIDW + cq, h, lane, Qf[(g + 1) & 1]);
#pragma unroll 1
        for (int cc = 0; cc < 2; ++cc) { const int krel = rs - lo + 4 * cc;
#ifdef MK_NA_PM
            if (pm & 4) continue;
#endif
            chunk<true>(lds, st[g], Qf[g & 1], KL_OFF + krel * 32 * 128, 32 * 128, VL_OFF + krel * 4096, lane, cq, rs + 4 * cc - r + 7, kc0); }
        finish_row(P, st[g], row, h, lane);
    }
}
__device__ __forceinline__ void ctx_unit(LAS unsigned char* lds, const Params& P, int u) {
    const int b = u >> 4, h = (u >> 1) & 7, half = u & 1, tidc = opaque_i(threadIdx.x), lane = tidc & 63, w = tidc >> 6;
    __syncthreads();
    stage_ctx(lds, P, b, h);
    __syncthreads();
    RowState st; bf16x8 Qf[2]; init_row(st);
    const int row = NLAT + b * CTXL + 128 * half + 16 * w + (lane & 15);
    load_q(P, row, h, lane, Qf);
#pragma unroll 1
    for (int cc = 0; cc < 2; ++cc) chunk<false>(lds, st, Qf, KC_OFF + cc * 128 * 128, 0, VC_OFF + cc * 4 * 4096, lane, 0, 0, 0);
    finish_row(P, st, row, h, lane);
}
}

#include <hip/hip_cooperative_groups.h>
namespace cg = cooperative_groups;
constexpr int NPHASE = 2 + 9 * DEPTH;
constexpr int FEARLY = 496;

struct MKArgs { const float* in[31]; float* out; unsigned char* ws; int ph_lo, ph_hi; };

#define XB_TMO      128
#define XB_XCNT(j)  (256  + 64 * (j))
#define XB_XSUB(j)  (1280 + 64 * (j))
#define XB_XGEN(j)  (2304 + 64 * (j))
#define XB_TOP      3328
#define XB_TOPGEN   3392
#define XCD_BAR_WORDS 3456
#define XB_SPIN_CAP (1u << 22)

__device__ __forceinline__ unsigned xb_ld(unsigned* p)              { return __hip_atomic_load(p, __ATOMIC_RELAXED, __HIP_MEMORY_SCOPE_AGENT); }
__device__ __forceinline__ unsigned xb_add(unsigned* p, unsigned v) { return __hip_atomic_fetch_add(p, v, __ATOMIC_RELAXED, __HIP_MEMORY_SCOPE_AGENT); }
__device__ __forceinline__ unsigned xb_xcc_id() { return (unsigned)__builtin_amdgcn_s_getreg((3 << 11) | 20) & 0xFu; }
#define XB_SPIN(cond, bar) do { unsigned _sp = 0; while (cond) { __builtin_amdgcn_s_sleep(1); \
    if ((++_sp & 255u) == 0u) { if (xb_ld(&(bar)[XB_TMO])) break; if (_sp > XB_SPIN_CAP) { atomicAdd(&(bar)[XB_TMO], 1u); break; } } } } while (0)

struct XcdBarrier {
    unsigned* bar; unsigned x;
    volatile LAS unsigned* st;
};

__device__ __forceinline__ XcdBarrier xcd_barrier_post(unsigned* bar, volatile LAS unsigned* st) {
    XcdBarrier b; b.bar = bar; b.x = xb_xcc_id(); b.st = st;
    if (threadIdx.x == 0) (void)xb_add(&bar[XB_XCNT(b.x)], 1u);
    return b;
}
__device__ __forceinline__ void xcd_barrier_complete(unsigned* bar, unsigned x, unsigned& nloc, unsigned& nx) {
    const unsigned G = gridDim.x * gridDim.y * gridDim.z;
    unsigned sum, cnt, mine, sp = 0u;
    for (;;) {
        sum = 0u; cnt = 0u; mine = 0u;
#pragma unroll
        for (unsigned j = 0; j < 16; ++j) { const unsigned c = xb_ld(&bar[XB_XCNT(j)]); sum += c; cnt += (c > 0u) ? 1u : 0u; mine = (j == x) ? c : mine; }
        if (sum == G) break;
        __builtin_amdgcn_s_sleep(1);
        if ((++sp & 255u) == 0u) { if (xb_ld(&bar[XB_TMO])) break; if (sp > XB_SPIN_CAP) { atomicAdd(&bar[XB_TMO], 1u); break; } }
    }
    nloc = mine > 0u ? mine : 1u; nx = cnt > 0u ? cnt : 1u;
}

__device__ __forceinline__ void xcd_barrier(const XcdBarrier& b) {
    asm volatile("s_waitcnt vmcnt(0)" ::: "memory");
    __syncthreads();
    if (threadIdx.x == 0) {
        unsigned* bar = b.bar;
        __builtin_amdgcn_s_waitcnt(0);
        unsigned nloc = b.st[0], nx = b.st[1];
        if (nloc == 0u) { xcd_barrier_complete(bar, b.x, nloc, nx); b.st[0] = nloc; b.st[1] = nx; }
        const unsigned old = xb_add(&bar[XB_XSUB(b.x)], 1u);
        const unsigned gen = old / nloc;
        if (old + 1u == (gen + 1u) * nloc) {
            __builtin_amdgcn_fence(__ATOMIC_RELEASE, "agent");
            asm volatile("s_waitcnt vmcnt(0)" ::: "memory");
            const unsigned og = xb_add(&bar[XB_TOP], 1u);
            const unsigned tg = og / nx;
            if (og + 1u == (tg + 1u) * nx) xb_add(&bar[XB_TOPGEN], 1u);
            else XB_SPIN(xb_ld(&bar[XB_TOPGEN]) == tg, bar);
            __builtin_amdgcn_fence(__ATOMIC_ACQUIRE, "agent");
            xb_add(&bar[XB_XGEN(b.x)], 1u);
            asm volatile("s_waitcnt vmcnt(0)" ::: "memory");
        } else {
            XB_SPIN(xb_ld(&bar[XB_XGEN(b.x)]) == gen, bar);
            __builtin_amdgcn_fence(__ATOMIC_ACQUIRE, "agent");
            asm volatile("s_waitcnt vmcnt(0)" ::: "memory");
        }
    }
    __syncthreads();
}


namespace mk {
struct Ctx { LAS unsigned char* lds; int tid, lane, wave, G, bx; };

__device__ __forceinline__ void p_weights(const Ctx& c, const MKArgs& a) {
    LAS float* scr = (LAS float*)c.lds + c.wave * 64 * 33;
    for (int it = c.bx * 8 + c.wave; it < (c.G == 256 ? WI_IN : DEPTH * WI_LAYER); it += c.G * 8) wconv_item(it, a.in[10], a.in[11], a.in[29], a.in[30], a.ws, scr, c.lane);
    bf16_t* LW = (bf16_t*)(a.ws + WS_LW);
    for (int gid = c.bx * 512 + c.tid; gid < DEPTH * 2 * 4 * 2 * 64 * 64; gid += c.G * 512) {
        const int i = gid & 63, o = (gid >> 6) & 63, ty = (gid >> 12) & 1, nb = (gid >> 13) & 3, dir = (gid >> 15) & 1, l = gid >> 16;
        const float* src = ty == 0 ? a.in[24] : a.in[26];
        LW[gid] = (bf16_t)f2bf(src[((((size_t)l * 2 + dir) * 4 + nb) * 64 + i) * 64 + o]); }
}
__device__ __forceinline__ void p_weights_late(const Ctx& c, const MKArgs& a, int first_block, int it_lo, int it_hi) {
    if (c.bx < first_block) return;
    LAS float* scr = (LAS float*)c.lds + c.wave * 64 * 33;
    for (int it = it_lo + (c.bx - first_block) * 8 + c.wave; it < it_hi; it += (c.G - first_block) * 8) wconv_item(it, a.in[10], a.in[11], a.in[29], a.in[30], a.ws, scr, c.lane);
}
__device__ __forceinline__ void p_mod(const Ctx& c, const MKArgs& a, int l_lo, int l_hi, int first_block = 0) {
    LAS float* sc = (LAS float*)(c.lds + 67584); LAS float* red = sc + 3 * D;
    const float* cvec = a.in[1]; const float* cctx = a.in[3]; const float* ada_w = a.in[4]; const float* ada_b = a.in[5]; float* MOD = (float*)(a.ws + WS_MOD);
    for (int i = c.tid; i < 3 * D; i += 512) { const int cd = i / D, k = i % D; const float v = cd < 2 ? cvec[cd * D + k] : cctx[k]; sc[i] = v / (1.0f + expf(-v)); }
    __syncthreads();
    for (int item = l_lo * 96 + (c.bx - first_block); c.bx >= first_block && item < l_hi * 96; item += c.G - first_block) {
        const int l = item / 96, n = (item % 96) * 64 + c.lane;
        const float* w = ada_w + (size_t)l * D * 6 * D + (size_t)(128 * c.wave) * 6 * D + n;
        float a0 = 0.f, a1 = 0.f, a2 = 0.f;
#pragma unroll 32
        for (int k = 0; k < 128; ++k) { const float wv = w[(size_t)k * 6 * D]; const int kk = 128 * c.wave + k; a0 += sc[kk] * wv; a1 += sc[D + kk] * wv; a2 += sc[2 * D + kk] * wv; }
        red[(c.wave * 3 + 0) * 64 + c.lane] = a0; red[(c.wave * 3 + 1) * 64 + c.lane] = a1; red[(c.wave * 3 + 2) * 64 + c.lane] = a2;
        __syncthreads();
        if (c.tid < 192) { const int cd = c.tid >> 6, ln = c.tid & 63; float s = ada_b[l * 6 * D + (item % 96) * 64 + ln];
#pragma unroll
            for (int w8 = 0; w8 < 8; ++w8) s += red[(w8 * 3 + cd) * 64 + ln];
            MOD[(size_t)(l * 3 + cd) * 6 * D + (item % 96) * 64 + ln] = s; }
        __syncthreads();
    }
}
__device__ __forceinline__ void p_filt_h2(const Ctx& c, const MKArgs& a, int l_lo, int l_hi, int first_block = 0) {
    LAS float* z = (LAS float*)(c.lds + 90112); LAS float* h1 = z + 8 * 36;
    const float* w1 = a.in[14]; const float* b1 = a.in[15]; const float* w2 = a.in[16]; const float* b2 = a.in[17]; const float* freq = a.in[19]; float* H2 = (float*)(a.ws + WS_H2);
    const int pl = c.tid >> 6, j = c.tid & 63;
    float W1c[33], W2c[64], b1v = 0.f, b2v = 0.f, f0 = 0.f, f1 = 0.f; int lcur = -1;
    for (int item = l_lo * (FPOS / 8) + (c.bx - first_block); c.bx >= first_block && item < l_hi * (FPOS / 8); item += c.G - first_block) {
        const int l = item / (FPOS / 8), p0 = (item % (FPOS / 8)) * 8, p = p0 + pl;
        if (l != lcur) { lcur = l;
#pragma unroll
            for (int i = 0; i < 33; ++i) W1c[i] = w1[l * 33 * 64 + i * 64 + j];
#pragma unroll
            for (int i = 0; i < 64; ++i) W2c[i] = w2[l * 64 * 64 + i * 64 + j];
            b1v = b1[l * 64 + j]; b2v = b2[l * 64 + j]; f0 = freq[(l * 2 + 0) * 64 + j]; f1 = freq[(l * 2 + 1) * 64 + j]; }
        const float t = p < SEQ ? (float)p / (float)SEQ : (float)(p - SEQ) / (float)CTXL;
        if (j < 33) { float v; if (j == 0) v = t; else { const int bnd = j <= 16 ? j : j - 16; float s, cs; sincospif(2.0f * t * (float)bnd, &s, &cs); v = j <= 16 ? cs : s; } z[pl * 36 + j] = v; }
        __syncthreads();
        float acc = b1v;
#pragma unroll
        for (int i4 = 0; i4 < 8; ++i4) { const f32x4 zv = *(const LAS f32x4*)(z + pl * 36 + 4 * i4); acc += zv[0] * W1c[4 * i4] + zv[1] * W1c[4 * i4 + 1] + zv[2] * W1c[4 * i4 + 2] + zv[3] * W1c[4 * i4 + 3]; }
        acc += z[pl * 36 + 32] * W1c[32];
        h1[pl * 64 + j] = sinf(f0 * acc);
        __syncthreads();
        float a2 = b2v;
#pragma unroll
        for (int i4 = 0; i4 < 16; ++i4) { const f32x4 hv = *(const LAS f32x4*)(h1 + pl * 64 + 4 * i4); a2 += hv[0] * W2c[4 * i4] + hv[1] * W2c[4 * i4 + 1] + hv[2] * W2c[4 * i4 + 2] + hv[3] * W2c[4 * i4 + 3]; }
        H2[((size_t)l * FPOS + p) * 64 + j] = sinf(f1 * a2);
    }
    __syncthreads();
}
__device__ __forceinline__ void p_filt_k(const Ctx& c, const MKArgs& a, int l, bool with_ctx, int first_block = 0) {
    const int half = c.tid >> 8, t256 = c.tid & 255;
    LAS float* hs = (LAS float*)(c.lds + half * 34816); LAS float* wsm = hs + 64 * 68;
    const float* H2l = (const float*)(a.ws + WS_H2) + (size_t)l * FPOS * 64; const float* w3l = a.in[18] + (size_t)l * 64 * 1024;
    bf16_t* KFB = (bf16_t*)(a.ws + WS_KF); float* KFC = (float*)(a.ws + WS_KFC);
    const int nlat = (SEQ / 64) * 16, total = nlat + (with_ctx ? (CTXL / 64) * 16 : 0);
    if (c.bx < first_block) return;
    for (int it0 = 2 * (c.bx - first_block); it0 < total; it0 += 2 * (c.G - first_block)) {
        const int item = it0 + half; const bool live = item < total; int bxi = live ? item : 0;
        const bool isctx = bxi >= nlat; if (isctx) bxi -= nlat;
        const int L = isctx ? CTXL : SEQ; const int pt = bxi / 16, ct = bxi % 16, p0 = pt * 64, c0 = ct * 64;
        const float* Hs = H2l + (size_t)(isctx ? SEQ : 0) * 64;
        __syncthreads();
        { float hv_[16], wv_[16];
#pragma unroll
          for (int i16 = 0; i16 < 16; ++i16) { const int i = t256 + 256 * i16, r = i >> 6, cc = i & 63; hv_[i16] = Hs[(size_t)(p0 + r) * 64 + cc]; wv_[i16] = w3l[r * 1024 + c0 + cc]; }
#pragma unroll
          for (int i16 = 0; i16 < 16; ++i16) { const int i = t256 + 256 * i16, r = i >> 6, cc = i & 63; hs[cc * 68 + r] = hv_[i16]; wsm[r * 68 + cc] = wv_[i16]; } }
        __syncthreads();
        const int tx = t256 & 15, ty = t256 >> 4;
        float acc[4][4];
#pragma unroll
        for (int x = 0; x < 4; ++x)
#pragma unroll
            for (int y = 0; y < 4; ++y) acc[x][y] = 0.f;
#pragma unroll 8
        for (int j = 0; j < 64; ++j) {
            const f32x4 hv = *(const LAS f32x4*)(hs + j * 68 + 4 * tx), wv = *(const LAS f32x4*)(wsm + j * 68 + 4 * ty);
#pragma unroll
            for (int x = 0; x < 4; ++x)
#pragma unroll
                for (int y = 0; y < 4; ++y) acc[x][y] += hv[x] * wv[y];
        }
        if (live) {
#pragma unroll
            for (int y = 0; y < 4; ++y) { const int col = c0 + 4 * ty + y, ch = col & 255;
                const float d0 = 15.350567286626973f, d1 = 3.0701134573253946f; const float delta = d0 + (d1 - d0) * ((float)ch / 255.0f);
                f32x4 o;
#pragma unroll
                for (int x = 0; x < 4; ++x) { const float t = (float)(p0 + 4 * tx + x) / (float)L; o[x] = acc[x][y] * expf(-t * delta); }
                if (isctx) *(f32x4*)(KFC + (size_t)col * L + p0 + 4 * tx) = o;
                else { u32x2 w; w.x = pg8::cvt_pk_bf16(o[0], o[1]); w.y = pg8::cvt_pk_bf16(o[2], o[3]); *(u32x2*)(KFB + (size_t)col * L + p0 + 4 * tx) = w; } }
        }
    }
    __syncthreads();
}
__device__ __forceinline__ void p_rownorm0(const Ctx& c, const MKArgs& a) {
    const float* x = a.in[0]; const float* ctx = a.in[2]; const float* g = a.in[6]; const float* MOD0 = (const float*)(a.ws + WS_MOD); bf16_t* H = (bf16_t*)(a.ws + WS_H);
    const int lane = c.lane;
    for (int row0 = 2 * (c.bx * 8 + c.wave); row0 < MT; row0 += 2 * c.G * 8) {
        f32x4 v[2][4]; float ss[2] = {0.f, 0.f}; int cond[2];
#pragma unroll
        for (int r = 0; r < 2; ++r) { const int row = row0 + r; const bool isctx = row >= NLAT; cond[r] = isctx ? 2 : row / SEQ;
            const float* xr = isctx ? ctx + (size_t)(row - NLAT) * D : x + (size_t)row * D;
#pragma unroll
            for (int j = 0; j < 4; ++j) v[r][j] = __builtin_nontemporal_load((const f32x4*)(xr + 4 * lane + 256 * j)); }
#pragma unroll
        for (int r = 0; r < 2; ++r)
#pragma unroll
            for (int j = 0; j < 4; ++j) ss[r] += v[r][j][0] * v[r][j][0] + v[r][j][1] * v[r][j][1] + v[r][j][2] * v[r][j][2] + v[r][j][3] * v[r][j][3];
#pragma unroll
        for (int o = 1; o < 64; o <<= 1) { ss[0] += __shfl_xor(ss[0], o); ss[1] += __shfl_xor(ss[1], o); }
#pragma unroll
        for (int r = 0; r < 2; ++r) { const float rinv = 1.0f / sqrtf(ss[r] * (1.0f / D) + 1e-6f);
            const float* sh = MOD0 + (size_t)cond[r] * 6 * D; const float* sc = sh + D;
#pragma unroll
            for (int j = 0; j < 4; ++j) { const int col = 4 * lane + 256 * j; const f32x4 gv = *(const f32x4*)(g + col), scv = *(const f32x4*)(sc + col), shv = *(const f32x4*)(sh + col);
                float o[4];
#pragma unroll
                for (int e = 0; e < 4; ++e) o[e] = v[r][j][e] * rinv * gv[e] * (1.0f + scv[e]) + shv[e];
                u32x2 w; w.x = pg8::cvt_pk_bf16(o[0], o[1]); w.y = pg8::cvt_pk_bf16(o[2], o[3]); *(u32x2*)(H + (size_t)(row0 + r) * D + col) = w; } }
    }
}
__device__ __forceinline__ void p_rowpass(const Ctx& c, const bf16_t* Y, const float* xin_lat, const float* xin_ctx, float* xout_lat, float* xout_ctx, const float* g_post, const float* modp, int gate_idx,
                                          const float* g_next, const float* modn, int nidx, bf16_t* H, int nrows) {
    LAS float* VA = (LAS float*)c.lds; LAS float* VB = VA + 3 * D; LAS float* VC = VB + 3 * D;
    __syncthreads();
    for (int i = c.tid; i < 3 * D; i += 512) { const int cd = i / D, col = i % D;
        VA[i] = modp[(size_t)cd * 6 * D + gate_idx * D + col] * g_post[col];
        if (g_next) { VB[i] = g_next[col] * (1.0f + modn[(size_t)cd * 6 * D + (nidx + 1) * D + col]); VC[i] = modn[(size_t)cd * 6 * D + nidx * D + col]; } }
    __syncthreads();
    const int lane = c.lane;
    constexpr int NR = 2;
    for (int row0 = NR * (c.bx * 8 + c.wave); row0 < nrows; row0 += NR * c.G * 8) {
        float y[NR][4][4]; f32x4 xv[NR][4]; float ss[NR]; int cond[NR]; float* xo[NR];
#pragma unroll
        for (int r = 0; r < NR; ++r) { ss[r] = 0.f; const int row = row0 + r; const bool isctx = row >= NLAT; cond[r] = isctx ? 2 : row / SEQ;
            const float* xi = isctx ? xin_ctx + (size_t)(row - NLAT) * D : xin_lat + (size_t)row * D;
            xo[r] = isctx ? xout_ctx + (size_t)(row - NLAT) * D : xout_lat + (size_t)row * D;
#pragma unroll
            for (int j = 0; j < 4; ++j) { const u32x2 w = __builtin_nontemporal_load((const u32x2*)(Y + (size_t)row * D + 4 * lane + 256 * j)); xv[r][j] = __builtin_nontemporal_load((const f32x4*)(xi + 4 * lane + 256 * j));
                y[r][j][0] = bf2f(w.x & 0xffffu); y[r][j][1] = bf2f(w.x >> 16); y[r][j][2] = bf2f(w.y & 0xffffu); y[r][j][3] = bf2f(w.y >> 16); } }
#pragma unroll
        for (int r = 0; r < NR; ++r)
#pragma unroll
            for (int j = 0; j < 4; ++j) ss[r] += y[r][j][0] * y[r][j][0] + y[r][j][1] * y[r][j][1] + y[r][j][2] * y[r][j][2] + y[r][j][3] * y[r][j][3];
#pragma unroll
        for (int o = 1; o < 64; o <<= 1) {
#pragma unroll
            for (int r = 0; r < NR; ++r) ss[r] += __shfl_xor(ss[r], o); }
        float s2[NR];
#pragma unroll
        for (int r = 0; r < NR; ++r) { s2[r] = 0.f; const float rinv = 1.0f / sqrtf(ss[r] * (1.0f / D) + 1e-6f);
#pragma unroll
            for (int j = 0; j < 4; ++j) { const int col = 4 * lane + 256 * j; const f32x4 av = *(const LAS f32x4*)(VA + cond[r] * D + col);
#pragma unroll
                for (int e = 0; e < 4; ++e) { xv[r][j][e] += av[e] * (y[r][j][e] * rinv); s2[r] += xv[r][j][e] * xv[r][j][e]; }
                __builtin_nontemporal_store(xv[r][j], (f32x4*)(xo[r] + col)); } }
        if (g_next) {
#pragma unroll
            for (int o = 1; o < 64; o <<= 1) {
#pragma unroll
                for (int r = 0; r < NR; ++r) s2[r] += __shfl_xor(s2[r], o); }
#pragma unroll
            for (int r = 0; r < NR; ++r) { const float r2 = 1.0f / sqrtf(s2[r] * (1.0f / D) + 1e-6f);
#pragma unroll
                for (int j = 0; j < 4; ++j) { const int col = 4 * lane + 256 * j; const f32x4 bv = *(const LAS f32x4*)(VB + cond[r] * D + col), cv = *(const LAS f32x4*)(VC + cond[r] * D + col);
                    u32x2 w; w.x = pg8::cvt_pk_bf16(xv[r][j][0] * r2 * bv[0] + cv[0], xv[r][j][1] * r2 * bv[1] + cv[1]); w.y = pg8::cvt_pk_bf16(xv[r][j][2] * r2 * bv[2] + cv[2], xv[r][j][3] * r2 * bv[3] + cv[3]);
                    *(u32x2*)(H + (size_t)(row0 + r) * D + col) = w; } }
        }
    }
    __syncthreads();
}
__device__ __forceinline__ void p_hy_transpose(const Ctx& c, const bf16_t* YHT, bf16_t* YMIX) {
    constexpr int PITCH = 272;
    for (int item = c.bx; item < NLAT / 128; item += c.G) {
        const int tok0 = item * 128;
        __syncthreads();
        { u32x4 v[8];
#pragma unroll
          for (int i = 0; i < 8; ++i) { const int e = c.tid + 512 * i, ch = e >> 4, pc = e & 15; v[i] = *(const u32x4*)(YHT + (size_t)ch * MT + tok0 + 8 * pc); }
#pragma unroll
          for (int i = 0; i < 8; ++i) { const int e = c.tid + 512 * i, ch = e >> 4, pc = e & 15; *(LAS u32x4*)(c.lds + ch * PITCH + pc * 16) = v[i]; } }
        __syncthreads();
        const int tok = c.tid >> 2, qt = c.tid & 3;
#pragma unroll
        for (int s8 = 0; s8 < 8; ++s8) { const int ch0 = 64 * qt + 8 * s8; unsigned h[8];
#pragma unroll
            for (int j = 0; j < 8; ++j) h[j] = *(const LAS bf16_t*)(c.lds + (ch0 + j) * PITCH + tok * 2);
            u32x4 o; o.x = h[0] | (h[1] << 16); o.y = h[2] | (h[3] << 16); o.z = h[4] | (h[5] << 16); o.w = h[6] | (h[7] << 16);
            *(u32x4*)(YMIX + (size_t)(tok0 + tok) * D + ch0) = o; }
    }
    __syncthreads();
}
__device__ __forceinline__ float conv3_at(const bf16_t* rowp, int s, int Lseq, float w0, float w1, float w2, float bias) {
    float v = bias + w1 * bf2f(rowp[s]);
    if (s > 0) v += w0 * bf2f(rowp[s - 1]);
    if (s + 1 < Lseq) v += w2 * bf2f(rowp[s + 1]);
    return v;
}
__device__ __forceinline__ void hy_ctx_unit(const Ctx& cx, int c, const bf16_t* PTV, const float* KFC, const float* cw, const float* cb, const float* hbias, bf16_t* YMIX) {
    LAS float* zin = (LAS float*)cx.lds; LAS float* kc = zin + 512; LAS float* red = kc + 512;
    const int tid = cx.tid, b = tid >> 8, t = tid & 255, lane = tid & 63, wave = tid >> 6;
    const bf16_t* base = PTV + NLAT + b * CTXL;
    float zcur = conv3_at(base + (size_t)c * MT, t, CTXL, cw[c], cw[768 + c], cw[1536 + c], cb[c]);
    for (int order = 0; order < 2; ++order) {
        __syncthreads();
        zin[b * 256 + t] = zcur;
        const float* kf = KFC + (size_t)((order * 2 + 0) * 256 + c) * CTXL; const float* kb = KFC + (size_t)((order * 2 + 1) * 256 + c) * CTXL;
        float kv = 0.f; if (tid >= 1) { const int d = tid - 256; kv = d >= 0 ? kf[d] : kb[-d]; } kc[tid] = kv;
        const float s = wave_sum(fabsf(kv)); if (lane == 0) red[wave] = s;
        __syncthreads();
        float tot = 0.f;
#pragma unroll
        for (int i = 0; i < 8; ++i) tot += red[i];
        float acc = 0.f;
        for (int s2 = 0; s2 < 256; ++s2) acc += kc[t - s2 + 256] * zin[b * 256 + s2];
        const int grow = (order == 0 ? 256 : 512) + c;
        const float gate = conv3_at(base + (size_t)grow * MT, t, CTXL, cw[grow], cw[768 + grow], cw[1536 + grow], cb[grow]);
        zcur = gate * (acc / tot + hbias[order * 256 + c] * zcur);
    }
    YMIX[(size_t)(NLAT + b * CTXL + t) * D + c] = (bf16_t)f2bf(zcur);
    __syncthreads();
}
}

__global__ void __launch_bounds__(512, 2) mk_fwd(MKArgs a) {
    extern __shared__ __attribute__((aligned(16))) unsigned char lds_raw[];
    cg::grid_group grid = cg::this_grid();
    mk::Ctx c; c.lds = (LAS unsigned char*)lds_raw; c.tid = threadIdx.x; c.lane = c.tid & 63; c.wave = __builtin_amdgcn_readfirstlane(c.tid >> 6); c.G = gridDim.x; c.bx = blockIdx.x;
#define FRESH() do { c.tid = opaque_i(threadIdx.x); c.lane = c.tid & 63; c.wave = __builtin_amdgcn_readfirstlane(c.tid >> 6); } while (0)
    unsigned char* ws = a.ws; float* out = a.out;
    bf16_t* Win_t = (bf16_t*)(ws + WS_WIN); bf16_t* Wout_t = (bf16_t*)(ws + WS_WOUT); bf16_t* Wgu_t = (bf16_t*)(ws + WS_WGU); bf16_t* Wdn_t = (bf16_t*)(ws + WS_WDN);
    float* MOD = (float*)(ws + WS_MOD); float* XC = (float*)(ws + WS_XC);
    bf16_t* H = (bf16_t*)(ws + WS_H); bf16_t* Y = (bf16_t*)(ws + WS_Y); bf16_t* PTV = (bf16_t*)(ws + WS_PTV); bf16_t* QKL = (bf16_t*)(ws + WS_QKL); bf16_t* ACT = (bf16_t*)(ws + WS_ACT);
    bf16_t* YMIX = (bf16_t*)(ws + WS_YMIX); fft::spec_t* KFS = (fft::spec_t*)(ws + WS_H); f32x2* HSCR = (f32x2*)(ws + WS_KF);
    const int lo = a.ph_lo, hi = a.ph_hi;
    unsigned* barw = (unsigned*)(ws + WS_CTL);
    if (lo > hi) grid.sync();
    if (c.tid < 16) ((LAS unsigned*)(c.lds + MK_LDS_BYTES - 64))[c.tid] = 0u;
    __syncthreads();
    XcdBarrier xbar; xbar.bar = barw; xbar.x = 0; xbar.st = (volatile LAS unsigned*)(c.lds + MK_LDS_BYTES - 64);
    if (hi - lo > 1) xbar = xcd_barrier_post(barw, (volatile LAS unsigned*)(c.lds + MK_LDS_BYTES - 64));
    pg8::Epi E;
#define IN(k) (lo <= (k) && (k) < hi)
#define SEAM(k) do { if (IN(k) && IN((k) + 1)) xcd_barrier(xbar); } while (0)
#ifndef MK_DUP
#define MK_DUP 0
#endif
#ifndef MK_DUP2
#define MK_DUP2 0
#endif
#ifndef MK_DUPN
#define MK_DUPN 1
#endif
#define REP2(b) for (int rep2_ = 0; rep2_ <= (int)((l == 1) && (((unsigned)(MK_DUP2) >> (b)) & 1u)) * MK_DUPN; ++rep2_)
#define REP(k) for (int rep_ = 0; rep_ <= (int)(((unsigned)(MK_DUP) >> (k)) & 1u); ++rep_)
    if (IN(0)) REP(0) { FRESH(); mk::p_weights(c, a); __syncthreads(); mk::p_mod(c, a, 0, DEPTH); mk::p_filt_h2(c, a, 0, (c.G == 256) ? 1 : DEPTH); }
    SEAM(0);
#ifdef MK_XSYNC
    if (lo == 0 && hi == NPHASE) for (int i_ = 0; i_ < MK_XSYNC; ++i_) xcd_barrier(xbar);
#endif
    if (IN(1)) REP(1) { FRESH();
#pragma unroll 1
        for (int stg = 0; stg < 2; ++stg) { if ((stg ^ ((c.bx >> 3) & 1)) == 0) mk::p_rownorm0(c, a); else mk::p_filt_k(c, a, 0, true); } }
    SEAM(1);
#pragma unroll 1
    for (int l = 0; l < DEPTH; ++l) {
        const int pb = 2 + 9 * l; const bool lastl = (l == DEPTH - 1);
        const float* modl = MOD + (size_t)l * 3 * 6 * D;
        const int nrows = lastl ? NLAT : MT;
        if (IN(pb + 0)) REP(pb + 0) {
            pg8::Sched S; const bf16_t* W = Win_t + (size_t)l * INW * D;
            const bf16_t* Hin = (l == 0) ? H : YMIX;
            S.ph.s0 = pg8::GSeg{W, Hin, PTV, NPTV / 256, MT / 256, MT, 0}; S.ph.s1 = pg8::GSeg{Hin, W + (size_t)NPTV * D, QKL, MT / 256, NQKL / 256, NQKL, 0};
            S.ph.n0 = (NPTV / 256) * (MT / 256); S.ph.total = S.ph.n0 + (MT / 256) * (NQKL / 256); S.ph.K = D; S.ph.pad = 0; S.G = c.G; S.c = c.bx;
            pg8::gemm_phase(c.lds, S, E);
            if (l == 0 && c.G == 256) { FRESH(); mk::p_weights_late(c, a, 150, WI_IN, WI_LAYER); }
        }
        SEAM(pb + 0);
        if (IN(pb + 1)) REP(pb + 1) {
            const bf16_t* KF = (const bf16_t*)(ws + WS_KF);
            const int rot = (c.bx >> 3) % 3;
#pragma unroll 1
            for (int stg = 0; stg < 3; ++stg) { const int which = (stg + rot) % 3;
                __syncthreads();
                if (which == 0) {
                    REP2(0) for (int u = (l == 0 || c.G != 256) ? c.bx : (c.bx >= 16 ? FEARLY + c.bx - 16 : 512); u < 512; u += c.G)     { const int order = u >> 8, ch = u & 255;
                        fft::filter_unit(c.lds, KF + (size_t)((order * 2 + 0) * 256 + ch) * SEQ, KF + (size_t)((order * 2 + 1) * 256 + ch) * SEQ, KFS + ((size_t)order * 256 + ch) * 2 * SEQ); }
                } else if (which == 1) {
                    na::Params np{QKL, PTV + (size_t)768 * MT, a.in[21] + (size_t)l * 8 * 15 * 31, YMIX}; const int nunits = lastl ? 512 : 544;
                    REP2(1) { for (int u = c.bx; u < 512; u += c.G) na::latent_unit(c.lds, np, u
#ifdef MK_NA_PM
                            , (rep2_ < (int)((l == 1) && ((MK_DUP2 >> 1) & 1u)) * MK_DUPN) ? MK_NA_PM : 0
#endif
                            );
                        if (nunits > 512) for (int u = c.bx - 8; u >= 0 && u < 32; u += c.G) na::ctx_unit(c.lds, np, u); }
                } else {
                    lru::Params lp{QKL, (const bf16_t*)(ws + WS_LW) + (size_t)l * 2 * 4 * 2 * 64 * 64, a.in[22] + (size_t)l * 4 * 256, a.in[23] + (size_t)l * 256, a.in[25] + (size_t)l * 512, a.in[27] + (size_t)l * 512,
                                    a.in[28] + (size_t)l * 512, (f32x2*)(ws + WS_AGG), YMIX};
                    REP2(2) for (int su = c.bx; su < 264; su += c.G) lru::super_unit<false>(c.lds, lp, su);
                }
            }
            if (!lastl) { __syncthreads(); FRESH();
                for (int u = c.bx; u < 256; u += c.G) mk::hy_ctx_unit(c, u, PTV, (const float*)(ws + WS_KFC), a.in[12] + (size_t)l * 3 * 768, a.in[13] + (size_t)l * 768, a.in[20] + (size_t)l * 512, YMIX); }
        }
        SEAM(pb + 1);
        if (IN(pb + 2)) REP(pb + 2) {
            unsigned* Zs = (unsigned*)HSCR + (size_t)c.bx * SEQ; unsigned* Rs = (unsigned*)HSCR + (size_t)(256 + c.bx) * SEQ;
            REP2(3) for (int u = c.bx; u < 256; u += c.G) { const int ch = (c.G == 256) ? (u & 7) * 32 + (u >> 3) : u;
                fft::hyena_unit(c.lds, ch, PTV, KFS + (size_t)ch * 2 * SEQ, (size_t)256 * 2 * SEQ, a.in[12] + (size_t)l * 3 * 768, a.in[13] + (size_t)l * 768, a.in[20] + (size_t)l * 512, Zs, Rs, (bf16_t*)(ws + WS_YHT)); }
        }
        SEAM(pb + 2);
        if (IN(pb + 3)) REP(pb + 3) {
#pragma unroll 1
            for (int stg = 0; stg < 2; ++stg) { const int which = stg ^ ((c.bx >> 3) & 1);
                __syncthreads();
                if (which == 0) { FRESH(); mk::p_hy_transpose(c, (const bf16_t*)(ws + WS_YHT), YMIX); }
                else {
                    lru::Params lp{QKL, (const bf16_t*)(ws + WS_LW) + (size_t)l * 2 * 4 * 2 * 64 * 64, a.in[22] + (size_t)l * 4 * 256, a.in[23] + (size_t)l * 256, a.in[25] + (size_t)l * 512, a.in[27] + (size_t)l * 512,
                                    a.in[28] + (size_t)l * 512, (f32x2*)(ws + WS_AGG), YMIX};
                    REP2(4) for (int su = c.bx; su < (lastl ? 256 : 264); su += c.G) lru::super_unit<true>(c.lds, lp, su);
                }
            }
        }
        SEAM(pb + 3);
        if (IN(pb + 4)) REP(pb + 4) {
            pg8::Sched S; const int nMt = (lastl ? NLAT : MT) / 256; S.ph.s0 = pg8::GSeg{YMIX, Wout_t + (size_t)l * D * D, Y, nMt, D / 256, D, 0}; S.ph.s1 = S.ph.s0; S.ph.n0 = S.ph.total = nMt * (D / 256); S.ph.K = D; S.ph.pad = 0; S.G = c.G; S.c = c.bx;
            pg8::gemm_phase(c.lds, S, E);
            if (l == 0 && c.G == 256) { FRESH(); mk::p_weights_late(c, a, 8, WI_LAYER, DEPTH * WI_LAYER); __syncthreads(); mk::p_filt_h2(c, a, 1, DEPTH, 8); }
        }
        SEAM(pb + 4);
        if (IN(pb + 5)) { FRESH();
#ifdef MK_DUP_RP
            if (l == 1) mk::p_rowpass(c, YMIX, a.in[0], XC, (float*)(ws + WS_PTV), (float*)(ws + WS_PTV) + (size_t)NLAT * D, a.in[7] + (size_t)l * D, modl, 2, a.in[8] + (size_t)l * D, modl, 3, (bf16_t*)(ws + WS_KF), NLAT);
#endif
            mk::p_rowpass(c, Y, l == 0 ? a.in[0] : out, l == 0 ? a.in[2] : XC, out, XC, a.in[7] + (size_t)l * D, modl, 2, a.in[8] + (size_t)l * D, modl, 3, H, nrows);
            if (!lastl && c.G != 256) mk::p_filt_k(c, a, l + 1, false);
        }
        SEAM(pb + 5);
        if (IN(pb + 6)) REP(pb + 6) {
            pg8::Sched S; const int nMt = (lastl ? NLAT : MT) / 256; S.ph.s0 = pg8::GSeg{H, Wgu_t + (size_t)l * 2 * DFF * D, ACT, nMt, 2 * DFF / 256, DFF, 1}; S.ph.s1 = S.ph.s0; S.ph.n0 = S.ph.total = nMt * (2 * DFF / 256); S.ph.K = D; S.ph.pad = 0; S.G = c.G; S.c = c.bx;
            pg8::gemm_phase(c.lds, S, E);
            if (!lastl && c.G == 256) { FRESH(); mk::p_filt_k(c, a, l + 1, false, 44); }
        }
        SEAM(pb + 6);
        if (IN(pb + 7)) REP(pb + 7) {
            pg8::Sched S; const int nMt = (lastl ? NLAT : MT) / 256; S.ph.s0 = pg8::GSeg{ACT, Wdn_t + (size_t)l * D * DFF, Y, nMt, D / 256, D, 0}; S.ph.s1 = S.ph.s0; S.ph.n0 = S.ph.total = nMt * (D / 256); S.ph.K = DFF; S.ph.pad = 0; S.G = c.G; S.c = c.bx;
            pg8::gemm_phase(c.lds, S, E);
            if (!lastl && c.G == 256 && c.bx >= 8) {
                const bf16_t* KF = (const bf16_t*)(ws + WS_KF);
                for (int u = 2 * (c.bx - 8); u < 2 * (c.bx - 8) + 2; ++u) { const int order = u >> 8, ch = u & 255;
                    fft::filter_unit(c.lds, KF + (size_t)((order * 2 + 0) * 256 + ch) * SEQ, KF + (size_t)((order * 2 + 1) * 256 + ch) * SEQ, KFS + ((size_t)order * 256 + ch) * 2 * SEQ); }
            }
        }
        SEAM(pb + 7);
        if (IN(pb + 8)) { FRESH();
            mk::p_rowpass(c, Y, out, XC, out, XC, a.in[9] + (size_t)l * D, modl, 5, lastl ? (const float*)nullptr : a.in[6] + (size_t)(l + 1) * D, lastl ? modl : modl + 3 * 6 * D, 0, YMIX, nrows);
        }
        SEAM(pb + 8);
    }
#undef IN
#undef SEAM
#undef REP
#undef REP2
}

#ifndef MK_N_LAUNCHES
#define MK_N_LAUNCHES 1
#endif
extern "C" void kernel_launch(void* const* d_in, const int* in_sizes, int n_in, void* d_out, int out_size, void* d_ws, size_t ws_size, hipStream_t stream) {
    static int grid = 0;
    if (grid == 0) {
        if (n_in != 31 || in_sizes[0] != NLAT * D || out_size != NLAT * D || ws_size < WS_END) { fprintf(stderr, "kernel_launch: unexpected shapes (n_in %d, in0 %d, out %d, ws %zu)\n", n_in, n_in > 0 ? in_sizes[0] : -1, out_size, ws_size); grid = -1; return; }
        if (hipFuncSetAttribute((const void*)mk_fwd, hipFuncAttributeMaxDynamicSharedMemorySize, MK_LDS_BYTES) != hipSuccess) { fprintf(stderr, "kernel_launch: hipFuncSetAttribute failed\n"); grid = -1; return; }
        int dev = 0, cus = 0, per_cu = 0;
        hipGetDevice(&dev); hipDeviceGetAttribute(&cus, hipDeviceAttributeMultiprocessorCount, dev);
        hipOccupancyMaxActiveBlocksPerMultiprocessor(&per_cu, (const void*)mk_fwd, 512, MK_LDS_BYTES);
        if (per_cu < 1) { fprintf(stderr, "kernel_launch: occupancy query says %d workgroups per CU\n", per_cu); per_cu = 1; }
        grid = cus * per_cu; if (grid > 256) grid = 256;
        (void)hipGetLastError();
    }
    if (grid < 0) return;
    MKArgs a{};
    for (int i = 0; i < 31; ++i) a.in[i] = (const float*)d_in[i];
    a.out = (float*)d_out; a.ws = (unsigned char*)d_ws;
    if (MK_N_LAUNCHES == 1) {
        a.ph_lo = 0; a.ph_hi = NPHASE;
        if (hipMemsetAsync((char*)d_ws + WS_CTL, 0, XCD_BAR_WORDS * 4, stream) != hipSuccess) { fprintf(stderr, "kernel_launch: hipMemsetAsync of the barrier words failed\n"); return; }
        void* args[] = {&a};
        const hipError_t e = hipLaunchCooperativeKernel((const void*)mk_fwd, dim3(grid), dim3(512), args, MK_LDS_BYTES, stream);
        if (e != hipSuccess) fprintf(stderr, "kernel_launch: cooperative launch failed: %s (grid %d)\n", hipGetErrorString(e), grid);
    } else {
        for (int p = 0; p < NPHASE; ++p) { a.ph_lo = p; a.ph_hi = p + 1; hipLaunchKernelGGL(mk_fwd, dim3(grid), dim3(512), MK_LDS_BYTES, stream, a); }
    }
}
```

```cpp
#define MK_WGM4 16
#include <hip/hip_runtime.h>
#include <cstdio>
#include <cstdint>
#include <cmath>

#define LAS __attribute__((address_space(3)))
typedef unsigned short bf16_t;
typedef short bf16x8 __attribute__((ext_vector_type(8)));
typedef float f32x4 __attribute__((ext_vector_type(4)));
typedef float f32x2 __attribute__((ext_vector_type(2)));
typedef unsigned u32x4 __attribute__((ext_vector_type(4)));
typedef unsigned u32x2 __attribute__((ext_vector_type(2)));

constexpr int D = 1024, NB = 2, SEQ = 16384, DEPTH = 2, GRIDW = 64, GROWS = 256, CTXL = 256;
constexpr int NLAT = NB * SEQ, NCTX = NB * CTXL, MT = NLAT + NCTX;
constexpr int HYW = 256, NAW = 512, NHEAD = 8, DH = 64, LRW = 256, INW = 2816, DFF = 2816;
constexpr int NPTV = 1280;
constexpr int NQKL = 1536;
constexpr int FPOS = SEQ + CTXL;

constexpr size_t MiB = 1u << 20;
constexpr size_t WS_CTL = 0;
constexpr size_t WS_WIN = 1 * MiB, WS_WOUT = 12 * MiB, WS_WGU = 16 * MiB, WS_WDN = 38 * MiB;
constexpr size_t WS_MOD = 49 * MiB;
constexpr size_t WS_XC = 50 * MiB;
constexpr size_t WS_H2 = 52 * MiB;
constexpr size_t WS_KN = 61 * MiB;
constexpr size_t WS_H = 64 * MiB;
constexpr size_t WS_Y = 129 * MiB;
constexpr size_t WS_PTV = 194 * MiB;
constexpr size_t WS_QKL = WS_PTV + (size_t)NPTV * MT * 2;
constexpr size_t WS_ACT = WS_PTV;
constexpr size_t WS_YMIX = 373 * MiB;
constexpr size_t WS_KF = 438 * MiB;
constexpr size_t WS_KFC = 502 * MiB;
constexpr size_t WS_AGG = 504 * MiB;
constexpr size_t WS_LW = 62 * MiB;
constexpr size_t WS_YHT = 470 * MiB;
constexpr size_t WS_END = 508 * MiB;
constexpr size_t WS_HF = WS_H, WS_HR = WS_H + (size_t)MT * LRW * 4;
constexpr size_t WS_Z1 = WS_Y;
static_assert(WS_QKL + (size_t)MT * NQKL * 2 <= WS_YMIX && WS_ACT + (size_t)MT * DFF * 2 <= WS_YMIX, "ws map");
static_assert(WS_HR + (size_t)MT * LRW * 4 <= WS_Y && WS_Z1 + (size_t)256 * 2 * SEQ * 4 <= WS_PTV, "ws map");

__device__ __forceinline__ int opaque_i(int v) { asm volatile("" : "+v"(v)); return v; }
__device__ __forceinline__ unsigned f2bf(float f) { unsigned u = __float_as_uint(f); return (u + 0x7fffu + ((u >> 16) & 1u)) >> 16; }
__device__ __forceinline__ unsigned pk2(float lo, float hi) { return f2bf(lo) | (f2bf(hi) << 16); }
__device__ __forceinline__ float bf2f(unsigned h) { return __uint_as_float(h << 16); }
__device__ __forceinline__ float wave_sum(float v) {
#pragma unroll
    for (int o = 1; o < 64; o <<= 1) v += __shfl_xor(v, o);
    return v;
}
__device__ __forceinline__ float wave_max(float v) {
#pragma unroll
    for (int o = 1; o < 64; o <<= 1) v = fmaxf(v, __shfl_xor(v, o));
    return v;
}
__device__ __forceinline__ float silu_f(float g) { return g * __builtin_amdgcn_rcpf(1.0f + __builtin_amdgcn_exp2f(-1.44269504089f * g)); }
__device__ __forceinline__ float sigmoid_f(float g) { return 1.0f / (1.0f + expf(-g)); }
__device__ __forceinline__ float gelu_tanh(float x) { const float u = 0.7978845608028654f * (x + 0.044715f * x * x * x); return 0.5f * x * (1.0f + tanhf(u)); }

namespace pg8 {
constexpr int BM = 256, BK = 64, HALF = 128, HTB = HALF * BK * 2, STAGE_BYTES = 8 * HTB;
#ifndef MK_WGM
#define MK_WGM 8
#endif
constexpr int WGM = MK_WGM;
__host__ __device__ __forceinline__ int lds_byte(int r, int c) { const int st = (r >> 4) * 2 + (c >> 5), rr = r & 15, cc = c & 31, ob = rr * 64 + cc * 2; return st * 1024 + (ob ^ (((ob >> 9) & 1) << 5)); }
__host__ __device__ __forceinline__ void stage_rc(int b, int& R, int& C) { const int st = b / 1024, sb = b % 1024, swz = sb ^ (((sb >> 9) & 1) << 5); R = (st >> 1) * 16 + swz / 64; C = (st & 1) * 32 + (swz % 64) / 2; }
__host__ __device__ __forceinline__ int perm32(int rho) { const int n = rho >> 4, i = rho & 15; return 8 * (i >> 2) + 4 * n + (i & 3); }

struct GSeg { const bf16_t* A; const bf16_t* B; bf16_t* C; int nM, nN, ldc, epi; };
struct GPhase { GSeg s0, s1; int n0, total, K, pad; };
struct Unit { const char* a; const char* b; bf16_t* C; int ldc, epi, pm, pn; };

struct Sched {
    GPhase ph; int G, c;
    __device__ __forceinline__ bool next(int i, Unit& u) const {
        const long L = (long)i * G + c; if (L >= ph.total) return false;
        int wgid = (int)L; { const int nwg = ph.total, q = nwg / 8, r = nwg % 8, xcd = wgid % 8, off = wgid / 8; wgid = (xcd < r ? xcd * (q + 1) : r * (q + 1) + (xcd - r) * q) + off; }
        const bool first = wgid < ph.n0; if (!first) wgid -= ph.n0;
        const bf16_t* A = first ? ph.s0.A : ph.s1.A; const bf16_t* B = first ? ph.s0.B : ph.s1.B; bf16_t* C = first ? ph.s0.C : ph.s1.C;
        const int nM = first ? ph.s0.nM : ph.s1.nM, nN = first ? ph.s0.nN : ph.s1.nN;
        u.ldc = first ? ph.s0.ldc : ph.s1.ldc; u.epi = first ? ph.s0.epi : ph.s1.epi; u.C = C;
#ifdef MK_WGM4
        const int wgm = nN <= 4 ? MK_WGM4 : WGM;
#else
        const int wgm = WGM;
#endif
        const int nig = wgm * nN, gid = wgid / nig, fm = gid * wgm, gsz = (nM - fm) < wgm ? (nM - fm) : wgm;
        u.pm = fm + ((wgid % nig) % gsz); u.pn = (wgid % nig) / gsz;
        u.a = (const char*)A + (size_t)u.pm * BM * ph.K * 2; u.b = (const char*)B + (size_t)u.pn * BM * ph.K * 2;
        return true;
    }
};

__device__ __forceinline__ unsigned cvt_pk_bf16(float lo, float hi) { unsigned r; asm volatile("v_cvt_pk_bf16_f32 %0, %1, %2" : "=v"(r) : "v"(lo), "v"(hi)); return r; }

struct Epi {
    __device__ __forceinline__ void operator()(const f32x4 (&acc)[2][2][4][2], const Unit& u, int wr, int wc, int fr, int fq) const {
        const int row0 = u.pm * BM + wr * 64 + fr;
        if (u.epi == 0) {
            const int col0 = u.pn * BM + wc * 32 + 8 * fq;
#pragma unroll
            for (int ai = 0; ai < 2; ++ai)
#pragma unroll
                for (int m = 0; m < 4; ++m) { bf16_t* rowp = u.C + (size_t)(row0 + ai * HALF + m * 16) * u.ldc + col0;
#pragma unroll
                    for (int bj = 0; bj < 2; ++bj) { const f32x4 v0 = acc[ai][bj][m][0], v1 = acc[ai][bj][m][1];
                        u32x4 w; w.x = cvt_pk_bf16(v0[0], v0[1]); w.y = cvt_pk_bf16(v0[2], v0[3]); w.z = cvt_pk_bf16(v1[0], v1[1]); w.w = cvt_pk_bf16(v1[2], v1[3]);
                        *(u32x4*)(rowp + bj * HALF) = w; } }
        } else {
            const int col0 = u.pn * HALF + wc * 32 + 8 * fq;
#pragma unroll
            for (int ai = 0; ai < 2; ++ai)
#pragma unroll
                for (int m = 0; m < 4; ++m) { bf16_t* rowp = u.C + (size_t)(row0 + ai * HALF + m * 16) * u.ldc + col0;
                    const f32x4 g0 = acc[ai][0][m][0], g1 = acc[ai][0][m][1], u0 = acc[ai][1][m][0], u1 = acc[ai][1][m][1];
                    u32x4 w; w.x = cvt_pk_bf16(silu_f(g0[0]) * u0[0], silu_f(g0[1]) * u0[1]); w.y = cvt_pk_bf16(silu_f(g0[2]) * u0[2], silu_f(g0[3]) * u0[3]);
                    w.z = cvt_pk_bf16(silu_f(g1[0]) * u1[0], silu_f(g1[1]) * u1[1]); w.w = cvt_pk_bf16(silu_f(g1[2]) * u1[2], silu_f(g1[3]) * u1[3]);
                    *(u32x4*)rowp = w; }
        }
    }
};

__device__ __forceinline__ void gemm_phase(LAS unsigned char* lds, const Sched& S, const Epi& E) {
    const int tid = opaque_i(threadIdx.x), wid = __builtin_amdgcn_readfirstlane(tid >> 6), lane = tid & 63, wr = wid >> 2, wc = wid & 3, fr = lane & 15, fq = lane >> 4;
    const int K = S.ph.K, nt = K / BK;
    unsigned voffA[2], voffB[2];
#pragma unroll
    for (int i = 0; i < 2; ++i) { int R, C; stage_rc(tid * 16 + i * 8192, R, C); const int Rb = (R & ~31) + perm32(R & 31);
        voffA[i] = (unsigned)(R * K + C) * 2u; voffB[i] = (unsigned)(Rb * K + C) * 2u; }
    const size_t kstep = (size_t)(BK * 2);
    const size_t hstep = (size_t)HALF * K * 2;
    const unsigned ldsw = (unsigned)wid * 1024u;
    const int aoff = lds_byte(wr * 64 + fr, fq * 8), boff = lds_byte(wc * 32 + fr, fq * 8);
#define PG8_SA(b, h) (((b) * 2 + (h)) * HTB)
#define PG8_SB(b, h) ((4 + (b) * 2 + (h)) * HTB)
#define PG8_STAGE(bufoff, gbase, voff) do { _Pragma("unroll") for (int _i = 0; _i < 2; ++_i) \
        __builtin_amdgcn_global_load_lds((const unsigned*)((const char*)(gbase) + (voff)[_i]), (LAS unsigned*)(lds + (bufoff) + ldsw + _i * 8192), 16, 0, 0); } while (0)
#define PG8_LDA(dst, b, h) do { _Pragma("unroll") for (int m = 0; m < 4; ++m) _Pragma("unroll") for (int k = 0; k < 2; ++k) dst[m][k] = *(const LAS bf16x8*)(lds + PG8_SA(b, h) + aoff + m * 2048 + k * 1024); } while (0)
#define PG8_LDB(dst, b, h) do { _Pragma("unroll") for (int n = 0; n < 2; ++n) _Pragma("unroll") for (int k = 0; k < 2; ++k) dst[n][k] = *(const LAS bf16x8*)(lds + PG8_SB(b, h) + boff + n * 2048 + k * 1024); } while (0)
#define PG8_MMA(ai, bj, At, Bt) do { __builtin_amdgcn_s_setprio(1); _Pragma("unroll") for (int m = 0; m < 4; ++m) _Pragma("unroll") for (int n = 0; n < 2; ++n) _Pragma("unroll") for (int k = 0; k < 2; ++k) \
        acc[ai][bj][m][n] = __builtin_amdgcn_mfma_f32_16x16x32_bf16(Bt[n][k], At[m][k], acc[ai][bj][m][n], 0, 0, 0); __builtin_amdgcn_s_setprio(0); } while (0)
#define PG8_WAIT_V(n) asm volatile("s_waitcnt vmcnt(" #n ")" ::: "memory")
#define PG8_WAIT_L(n) asm volatile("s_waitcnt lgkmcnt(" #n ")" ::: "memory")
#define PG8_BAR __builtin_amdgcn_s_barrier()
#define PG8_SCHED __builtin_amdgcn_sched_barrier(0)
    Unit cur, nxt; int ui = 0;
    if (!S.next(0, cur)) return;
    f32x4 acc[2][2][4][2];
#pragma unroll
    for (int a = 0; a < 2; ++a)
#pragma unroll
        for (int b = 0; b < 2; ++b)
#pragma unroll
            for (int m = 0; m < 4; ++m)
#pragma unroll
                for (int n = 0; n < 2; ++n) acc[a][b][m][n] = (f32x4){0.f, 0.f, 0.f, 0.f};
    bf16x8 At[4][2], B0[2][2], B1[2][2];
    const char* cA = cur.a; const char* cB = cur.b;
    PG8_STAGE(PG8_SB(0, 0), cB, voffB); PG8_STAGE(PG8_SB(0, 1), cB + hstep, voffB); PG8_STAGE(PG8_SA(0, 0), cA, voffA); PG8_STAGE(PG8_SA(0, 1), cA + hstep, voffA);
    if (wr == 1) PG8_BAR;
    PG8_WAIT_V(2); PG8_BAR;
    PG8_STAGE(PG8_SB(1, 0), cB + kstep, voffB); PG8_STAGE(PG8_SA(1, 0), cA + kstep, voffA); PG8_STAGE(PG8_SB(1, 1), cB + hstep + kstep, voffB);
    PG8_WAIT_V(6); PG8_BAR;
    for (;;) {
        const bool has_next = S.next(ui + 1, nxt);
        const char* nA = has_next ? nxt.a : cA; const char* nB = has_next ? nxt.b : cB;
        for (int t = 0; t < nt; t += 2) {
            const bool last = (t == nt - 2);
            const char* a1 = cA + (size_t)(t + 1) * kstep;
            const char* a2 = last ? nA : cA + (size_t)(t + 2) * kstep; const char* b2 = last ? nB : cB + (size_t)(t + 2) * kstep;
            const char* a3 = a2 + kstep; const char* b3 = b2 + kstep;
            PG8_LDB(B0, 0, 0); PG8_LDB(B1, 0, 1); PG8_SCHED; PG8_LDA(At, 0, 0); PG8_STAGE(PG8_SA(1, 1), a1 + hstep, voffA);
            PG8_WAIT_V(8); PG8_WAIT_L(0); PG8_BAR; PG8_MMA(0, 0, At, B0); PG8_MMA(0, 1, At, B1); PG8_BAR; PG8_SCHED;
            PG8_LDA(At, 0, 1); PG8_STAGE(PG8_SB(0, 0), b2, voffB); PG8_STAGE(PG8_SB(0, 1), b2 + hstep, voffB); PG8_STAGE(PG8_SA(0, 0), a2, voffA);
            PG8_WAIT_V(8); PG8_WAIT_L(0); PG8_BAR; PG8_MMA(1, 0, At, B0); PG8_MMA(1, 1, At, B1); PG8_BAR; PG8_SCHED;
            PG8_LDB(B0, 1, 0); PG8_LDB(B1, 1, 1); PG8_SCHED; PG8_LDA(At, 1, 0); PG8_STAGE(PG8_SA(0, 1), a2 + hstep, voffA);
            PG8_WAIT_V(8); PG8_WAIT_L(0); PG8_BAR; PG8_MMA(0, 0, At, B0); PG8_MMA(0, 1, At, B1); PG8_BAR; PG8_SCHED;
            PG8_LDA(At, 1, 1); PG8_STAGE(PG8_SB(1, 0), b3, voffB); PG8_STAGE(PG8_SB(1, 1), b3 + hstep, voffB); PG8_STAGE(PG8_SA(1, 0), a3, voffA);
            PG8_WAIT_V(8); PG8_WAIT_L(0); PG8_BAR; PG8_MMA(1, 0, At, B0); PG8_MMA(1, 1, At, B1); PG8_BAR; PG8_SCHED;
        }
        if (wr == 0) PG8_BAR;
        E(acc, cur, wr, wc, fr, fq);
        if (!has_next) break;
#pragma unroll
        for (int a = 0; a < 2; ++a)
#pragma unroll
            for (int b = 0; b < 2; ++b)
#pragma unroll
                for (int m = 0; m < 4; ++m)
#pragma unroll
                    for (int n = 0; n < 2; ++n) acc[a][b][m][n] = (f32x4){0.f, 0.f, 0.f, 0.f};
        cur = nxt; cA = nA; cB = nB; ++ui;
        if (wr == 1) PG8_BAR;
    }
    PG8_WAIT_V(0);
    PG8_BAR;
#undef PG8_SA
#undef PG8_SB
#undef PG8_STAGE
#undef PG8_LDA
#undef PG8_LDB
#undef PG8_MMA
#undef PG8_WAIT_V
#undef PG8_WAIT_L
#undef PG8_BAR
#undef PG8_SCHED
}
}
__device__ __forceinline__ int wrowmap(int kind, int n0) {
    if (kind == 0) { if (n0 < 768) return n0; if (n0 < 1792) return 1280 + (n0 - 768); if (n0 < 2304) return 768 + (n0 - 1792); return n0; }
    if (kind == 2) { if (n0 < DFF) return 256 * (n0 / 128) + (n0 % 128); const int m = n0 - DFF; return 256 * (m / 128) + 128 + (m % 128); }
    return n0;
}
__device__ __forceinline__ void transpose_item(const float* W, int K, int N, bf16_t* WT, int kind, LAS float* scr, int item, int lane) {
    const int nblk = N / 32, kb = item / nblk, nb = item % nblk, k0 = 64 * kb, n0 = 32 * nb, r0 = wrowmap(kind, n0);
    float wv[32];
#pragma unroll
    for (int i = 0; i < 32; ++i) { const int kk = 2 * i + (lane >> 5); wv[i] = W[(size_t)(k0 + kk) * N + n0 + (lane & 31)]; }
#pragma unroll
    for (int i = 0; i < 32; ++i) { const int kk = 2 * i + (lane >> 5); scr[kk * 33 + (lane & 31)] = wv[i]; }
    asm volatile("s_waitcnt lgkmcnt(0)" ::: "memory");
    const int c = lane & 7;
#pragma unroll
    for (int j = 0; j < 4; ++j) { const int n = (lane >> 3) + 8 * j; const LAS float* s = scr + (8 * c) * 33 + n;
        u32x4 o; o.x = pk2(s[0 * 33], s[1 * 33]); o.y = pk2(s[2 * 33], s[3 * 33]); o.z = pk2(s[4 * 33], s[5 * 33]); o.w = pk2(s[6 * 33], s[7 * 33]);
        *(u32x4*)(WT + (size_t)(r0 + n) * K + k0 + 8 * c) = o; }
    asm volatile("s_waitcnt lgkmcnt(0)" ::: "memory");
}
constexpr int WI_IN = (D / 64) * (INW / 32), WI_OUT = (D / 64) * (D / 32), WI_GU = (D / 64) * (2 * DFF / 32), WI_DN = (DFF / 64) * (D / 32), WI_LAYER = WI_IN + WI_OUT + WI_GU + WI_DN;
__device__ __forceinline__ void wconv_item(int it, const float* w_in, const float* w_out, const float* w_gu, const float* w_dn, unsigned char* ws, LAS float* scr, int lane) {
    const int l = it / WI_LAYER; int r = it % WI_LAYER;
    if (r < WI_IN) { transpose_item(w_in + (size_t)l * D * INW, D, INW, (bf16_t*)(ws + WS_WIN) + (size_t)l * INW * D, 0, scr, r, lane); return; } r -= WI_IN;
    if (r < WI_OUT) { transpose_item(w_out + (size_t)l * D * D, D, D, (bf16_t*)(ws + WS_WOUT) + (size_t)l * D * D, 1, scr, r, lane); return; } r -= WI_OUT;
    if (r < WI_GU) { transpose_item(w_gu + (size_t)l * D * 2 * DFF, D, 2 * DFF, (bf16_t*)(ws + WS_WGU) + (size_t)l * 2 * DFF * D, 2, scr, r, lane); return; } r -= WI_GU;
    transpose_item(w_dn + (size_t)l * DFF * D, DFF, D, (bf16_t*)(ws + WS_WDN) + (size_t)l * D * DFF, 1, scr, r, lane);
}
static __device__ constexpr float C32T[16] = {1.000000000e+00f, 9.807852804e-01f, 9.238795325e-01f, 8.314696123e-01f, 7.071067812e-01f, 5.555702330e-01f, 3.826834324e-01f, 1.950903220e-01f, 0.0f, -1.950903220e-01f, -3.826834324e-01f, -5.555702330e-01f, -7.071067812e-01f, -8.314696123e-01f, -9.238795325e-01f, -9.807852804e-01f};
static __device__ constexpr float S32T[16] = {0.000000000e+00f, 1.950903220e-01f, 3.826834324e-01f, 5.555702330e-01f, 7.071067812e-01f, 8.314696123e-01f, 9.238795325e-01f, 9.807852804e-01f, 1.000000000e+00f, 9.807852804e-01f, 9.238795325e-01f, 8.314696123e-01f, 7.071067812e-01f, 5.555702330e-01f, 3.826834324e-01f, 1.950903220e-01f};
static __device__ constexpr float C64T[32] = {1.000000000e+00f, 9.951847267e-01f, 9.807852804e-01f, 9.569403357e-01f, 9.238795325e-01f, 8.819212643e-01f, 8.314696123e-01f, 7.730104534e-01f, 7.071067812e-01f, 6.343932842e-01f, 5.555702330e-01f, 4.713967368e-01f, 3.826834324e-01f, 2.902846773e-01f, 1.950903220e-01f, 9.801714033e-02f, 0.0f, -9.801714033e-02f, -1.950903220e-01f, -2.902846773e-01f, -3.826834324e-01f, -4.713967368e-01f, -5.555702330e-01f, -6.343932842e-01f, -7.071067812e-01f, -7.730104534e-01f, -8.314696123e-01f, -8.819212643e-01f, -9.238795325e-01f, -9.569403357e-01f, -9.807852804e-01f, -9.951847267e-01f};
static __device__ constexpr float S64T[32] = {0.000000000e+00f, 9.801714033e-02f, 1.950903220e-01f, 2.902846773e-01f, 3.826834324e-01f, 4.713967368e-01f, 5.555702330e-01f, 6.343932842e-01f, 7.071067812e-01f, 7.730104534e-01f, 8.314696123e-01f, 8.819212643e-01f, 9.238795325e-01f, 9.569403357e-01f, 9.807852804e-01f, 9.951847267e-01f, 1.000000000e+00f, 9.951847267e-01f, 9.807852804e-01f, 9.569403357e-01f, 9.238795325e-01f, 8.819212643e-01f, 8.314696123e-01f, 7.730104534e-01f, 7.071067812e-01f, 6.343932842e-01f, 5.555702330e-01f, 4.713967368e-01f, 3.826834324e-01f, 2.902846773e-01f, 1.950903220e-01f, 9.801714033e-02f};

namespace fft {
constexpr int L = SEQ, N2 = 2 * SEQ;
constexpr int XSLOTS = 17904;
constexpr int LDS_X_BYTES = XSLOTS * 8;
constexpr int LDS_RED = LDS_X_BYTES;
typedef LAS f32x2* xptr;
__device__ __forceinline__ f32x2 ldx1(xptr X, int idx) { return *(volatile LAS f32x2*)(X + idx); }
typedef unsigned spec_t;
__device__ __forceinline__ unsigned pack_h2(float lo, float hi) { typedef _Float16 h2v __attribute__((ext_vector_type(2))); const h2v v = {(_Float16)lo, (_Float16)hi}; return __builtin_bit_cast(unsigned, v); }
__device__ __forceinline__ f32x2 unpack_h2(unsigned w) { typedef _Float16 h2v __attribute__((ext_vector_type(2))); const h2v v = __builtin_bit_cast(h2v, w); return (f32x2){(float)v.x, (float)v.y}; }
__device__ __forceinline__ f32x2 cmul(f32x2 a, f32x2 b) { return (f32x2){a.x * b.x - a.y * b.y, a.x * b.y + a.y * b.x}; }
__device__ __forceinline__ f32x2 cmulc(f32x2 a, f32x2 b) { return (f32x2){a.x * b.x + a.y * b.y, a.y * b.x - a.x * b.y}; }
__device__ __forceinline__ f32x2 expi(float x) { float s, c; sincospif(x, &s, &c); return (f32x2){c, s}; }
constexpr __host__ __device__ int bitrev(int j, int R) { int r = 0; for (int b = 1; b < R; b <<= 1) { r = (r << 1) | (j & 1); j >>= 1; } return r; }

template <int R, int S, bool INV> struct Stage {
    static __device__ __forceinline__ void run(f32x2 (&a)[R]) {
#pragma unroll
        for (int base = 0; base < R; base += 2 * S)
#pragma unroll
            for (int k = 0; k < S; ++k) {
                const int i0 = base + k, i1 = i0 + S, ti = k * (16 / S);
                const f32x2 u = a[i0], v = a[i1]; a[i0] = u + v; const f32x2 d = u - v;
                if (ti == 0) a[i1] = d;
                else if (ti == 8) a[i1] = INV ? (f32x2){-d.y, d.x} : (f32x2){d.y, -d.x};
                else { const float c = C32T[ti], s = S32T[ti]; a[i1] = INV ? (f32x2){d.x * c - d.y * s, d.x * s + d.y * c} : (f32x2){d.x * c + d.y * s, d.y * c - d.x * s}; }
            }
        if constexpr (S > 1) Stage<R, S / 2, INV>::run(a);
    }
};
template <int R, bool INV> __device__ __forceinline__ void dft(f32x2 (&a)[R]) {
    Stage<R, R / 2, INV>::run(a);
    f32x2 t[R];
#pragma unroll
    for (int j = 0; j < R; ++j) t[j] = a[bitrev(j, R)];
#pragma unroll
    for (int j = 0; j < R; ++j) a[j] = t[j];
}
template <int R, bool CONJ> __device__ __forceinline__ void twiddle(f32x2 (&a)[R], f32x2 w) {
    f32x2 tw[R]; tw[0] = (f32x2){1.f, 0.f}; tw[1] = w;
#pragma unroll
    for (int j = 2; j < R; ++j) tw[j] = cmul(tw[j >> 1], tw[j - (j >> 1)]);
#pragma unroll
    for (int j = 1; j < R; ++j) a[j] = CONJ ? cmulc(a[j], tw[j]) : cmul(a[j], tw[j]);
}
__device__ __forceinline__ void bar() { __syncthreads(); }
__device__ __forceinline__ int opaque(int v) { return opaque_i(v); }

__device__ __forceinline__ void fwd12(xptr X, int tid) {
    f32x2 a[32];
    { const int p0 = tid + (tid >> 4);
#pragma unroll
      for (int q = 0; q < 32; ++q) a[q] = X[p0 + 560 * q];
      dft<32, false>(a); twiddle<32, false>(a, expi(-(float)opaque(tid) * (1.0f / 8192.0f)));
#pragma unroll
      for (int q = 0; q < 32; ++q) X[p0 + 560 * q] = a[q]; }
    bar();
    { const int blk = tid >> 4, np = tid & 15, p0 = 560 * blk + np;
#pragma unroll
      for (int q = 0; q < 32; ++q) a[q] = ldx1(X, p0 + 17 * q);
      dft<32, false>(a); twiddle<32, false>(a, expi(-(float)opaque(np) * (1.0f / 256.0f)));
#pragma unroll
      for (int q = 0; q < 32; ++q) X[p0 + 17 * q] = a[q]; }
    bar();
}
__device__ __forceinline__ void inv21(xptr X, int tid, f32x2 (&a)[32]) {
    { const int blk = tid >> 4, np = tid & 15, p0 = 560 * blk + np;
#pragma unroll
      for (int q = 0; q < 32; ++q) a[q] = ldx1(X, p0 + 17 * q);
      twiddle<32, true>(a, expi(-(float)opaque(np) * (1.0f / 256.0f))); dft<32, true>(a);
#pragma unroll
      for (int q = 0; q < 32; ++q) X[p0 + 17 * q] = a[q]; }
    bar();
    { const int p0 = tid + (tid >> 4);
#pragma unroll
      for (int q = 0; q < 32; ++q) a[q] = X[p0 + 560 * q];
      twiddle<32, true>(a, expi(-(float)opaque(tid) * (1.0f / 8192.0f))); dft<32, true>(a); }
}
template <int MODE> __device__ __forceinline__ void pass3(xptr X, int tid, spec_t* G, float scale) {
    u32x2 kv[2][8];
    if (MODE == 1) {
#pragma unroll
        for (int gi = 0; gi < 2; ++gi)
#pragma unroll
            for (int j2 = 0; j2 < 8; ++j2) kv[gi][j2] = *(const u32x2*)(G + j2 * 2048 + 2 * (tid + 512 * gi));
    }
#pragma unroll
    for (int gi = 0; gi < 2; ++gi) {
        const int g = tid + 512 * gi, p0 = 17 * g + 16 * (g >> 5);
        f32x2 a[16];
#pragma unroll
        for (int q = 0; q < 16; ++q) a[q] = ldx1(X, p0 + q);
        dft<16, false>(a);
        if (MODE == 0) {
#pragma unroll
            for (int j = 0; j < 16; j += 2) { u32x2 o; o.x = pack_h2(a[j].x * scale, a[j].y * scale); o.y = pack_h2(a[j + 1].x * scale, a[j + 1].y * scale); *(u32x2*)(G + (j >> 1) * 2048 + 2 * g) = o; }
        } else {
#pragma unroll
            for (int j = 0; j < 16; j += 2) { const u32x2 k2 = kv[gi][j >> 1]; a[j] = cmul(a[j], unpack_h2(k2.x)); a[j + 1] = cmul(a[j + 1], unpack_h2(k2.y)); }
            dft<16, true>(a);
#pragma unroll
            for (int q = 0; q < 16; ++q) X[p0 + q] = a[q];
        }
        asm volatile("" ::: "memory");
    }
    if (MODE == 1) bar();
}
__device__ __forceinline__ f32x2 wN(f32x2 base, int q) { return cmul(base, (f32x2){C64T[q], -S64T[q]}); }

__device__ __forceinline__ void filter_unit(LAS unsigned char* lds, const bf16_t* kf, const bf16_t* kb, spec_t* KFo) {
    xptr X = (xptr)lds; LAS float* red = (LAS float*)(lds + LDS_RED);
    const int tid = opaque_i(threadIdx.x), p0 = tid + (tid >> 4);
    const f32x2 base = expi(-(float)tid * (1.0f / 16384.0f));
    float nrm = 0.f;
    {   float fv[32], bv[32];
#pragma unroll
        for (int q = 0; q < 32; ++q) { const int n = tid + 512 * q; fv[q] = bf2f(kf[n]); bv[q] = bf2f(kb[n >= 1 ? L - n : 0]); }
#pragma unroll
        for (int q = 0; q < 32; ++q) { const int n = tid + 512 * q; const float f = fv[q], b = n >= 1 ? bv[q] : 0.f; nrm += fabsf(f) + fabsf(b); X[p0 + 560 * q] = (f32x2){f + b, 0.f}; } }
    nrm = wave_sum(nrm); if ((tid & 63) == 0) red[tid >> 6] = nrm;
    bar();
    float tot = 0.f;
#pragma unroll
    for (int i = 0; i < 8; ++i) tot += red[i];
    const float scale = 1.0f / tot;
    fwd12(X, tid); pass3<0>(X, tid, KFo, scale);
    bar();
    asm volatile("" ::: "memory");
    {   float fv[32], bv[32];
        const int tq = opaque(tid);
#pragma unroll
        for (int q = 0; q < 32; ++q) { const int n = tq + 512 * q; fv[q] = bf2f(kf[n]); bv[q] = bf2f(kb[n >= 1 ? L - n : 0]); }
#pragma unroll
        for (int q = 0; q < 32; ++q) { const int n = tq + 512 * q; const float d = fv[q] - (n >= 1 ? bv[q] : 0.f); const f32x2 w = wN(base, q); X[p0 + 560 * q] = (f32x2){d * w.x, d * w.y}; } }
    bar();
    fwd12(X, tid); pass3<0>(X, tid, KFo + L, scale);
    bar();
}

__device__ __forceinline__ void stage_row(LAS unsigned char* lds, const bf16_t* row, int tid_) {
    const int tid = opaque(tid_), wv = __builtin_amdgcn_readfirstlane(tid >> 6), lane = tid & 63;
#pragma unroll
    for (int it = 0; it < 8; ++it) { const int e = (it * 8 + wv) * 64 + lane, b = e >> 11, ck = e & 2047;
        __builtin_amdgcn_global_load_lds((const unsigned*)(row + (size_t)b * SEQ + 8 * ck), (LAS unsigned*)(lds + (it * 8 + wv) * 1024), 16, 0, 0); }
}
__device__ __forceinline__ f32x2 conv3_lds(const LAS bf16_t* S, int n, float w0, float w1, float w2, float wb) {
    const int nm = n > 0 ? n - 1 : 0, np = n + 1 < SEQ ? n + 1 : SEQ - 1; const float wm = n > 0 ? w0 : 0.f, wp = n + 1 < SEQ ? w2 : 0.f;
    const float a0 = wb + w1 * bf2f(S[n]) + wm * bf2f(S[nm]) + wp * bf2f(S[np]);
    const float a1 = wb + w1 * bf2f(S[SEQ + n]) + wm * bf2f(S[SEQ + nm]) + wp * bf2f(S[SEQ + np]);
    return (f32x2){a0, a1};
}
__device__ __forceinline__ void hyena_unit(LAS unsigned char* lds, int c, const bf16_t* PTV, const spec_t* KFc, size_t ostride, const float* cw, const float* cb, const float* hbias,
                                           unsigned* Zs, unsigned* Rs, bf16_t* YMIX, int pm = 0) {
    xptr X = (xptr)lds;
    const int tid = opaque_i(threadIdx.x), p0 = tid + (tid >> 4);
#ifdef MK_HY_EXTRA
    for (int xr_ = 0; xr_ < MK_HY_EXTRA; ++xr_) {
        f32x2 dmy[32];
        bar(); fwd12(X, tid); pass3<1>(X, tid, KFc, 1.f); inv21(X, tid, dmy);
#pragma unroll
        for (int q = 0; q < 32; ++q) asm volatile("" :: "v"(dmy[q].x), "v"(dmy[q].y));
        bar();
    }
#endif
    f32x2 a[32];
    { const float w0 = cw[c], w1 = cw[768 + c], w2 = cw[1536 + c], wb = cb[c];
      bar(); stage_row(lds, PTV + (size_t)c * MT, tid); bar();
      const int t0 = opaque(tid);
#pragma unroll
      for (int q0 = 0; q0 < 32; q0 += 8) {
#pragma unroll
          for (int q = q0; q < q0 + 8; ++q) a[q] = conv3_lds((const LAS bf16_t*)lds, t0 + 512 * q, w0, w1, w2, wb);
          asm volatile("" ::: "memory"); }
      bar(); }
#pragma unroll 1
    for (int order = 0; order < 2; ++order) {
        const spec_t* Ke = KFc + (size_t)order * ostride; const spec_t* Ko = Ke + L;
        { const int t1 = opaque(tid);
#pragma unroll
          for (int q = 0; q < 32; ++q) { const unsigned zp = pg8::cvt_pk_bf16(a[q].x, a[q].y); Zs[t1 + 512 * q] = zp; X[p0 + 560 * q] = (f32x2){bf2f(zp & 0xffffu), bf2f(zp >> 16)}; } }
        bar();
#ifdef MK_HY_PM
        if (!(pm & 2))
#endif
        { fwd12(X, tid); pass3<1>(X, tid, const_cast<spec_t*>(Ke), 1.f); inv21(X, tid, a); }
        { const int t2 = opaque(tid);
#pragma unroll
          for (int q = 0; q < 32; ++q) Rs[t2 + 512 * q] = pg8::cvt_pk_bf16(a[q].x, a[q].y); }
        asm volatile("" ::: "memory");
        const int t3 = opaque(tid); const f32x2 base1 = expi(-(float)t3 * (1.0f / 16384.0f));
#pragma unroll
        for (int q = 0; q < 32; ++q) { const unsigned zp = Zs[t3 + 512 * q]; a[q] = (f32x2){bf2f(zp & 0xffffu), bf2f(zp >> 16)}; }
#pragma unroll
        for (int q = 0; q < 32; ++q) X[p0 + 560 * q] = cmul(a[q], wN(base1, q));
        bar();
#ifdef MK_HY_PM
        if (!(pm & 2))
#endif
        { fwd12(X, tid); pass3<1>(X, tid, const_cast<spec_t*>(Ko), 1.f); inv21(X, tid, a); }
        const int grow = (order == 0 ? 256 : 512) + c;
        const float g0 = cw[grow], g1 = cw[768 + grow], g2 = cw[1536 + grow], gb = cb[grow], hb = hbias[order * 256 + c];
        { const int t4 = opaque(tid); const f32x2 base2 = expi(-(float)t4 * (1.0f / 16384.0f));
#pragma unroll
          for (int q0 = 0; q0 < 32; q0 += 16) { unsigned r1p[16];
#pragma unroll
              for (int q = 0; q < 16; ++q) r1p[q] = Rs[t4 + 512 * (q0 + q)];
#pragma unroll
              for (int q = 0; q < 16; ++q) a[q0 + q] = (f32x2){bf2f(r1p[q] & 0xffffu), bf2f(r1p[q] >> 16)} + cmulc(a[q0 + q], wN(base2, q0 + q));
              asm volatile("" ::: "memory"); } }
        bar();
        stage_row(lds, PTV + (size_t)grow * MT, tid);
        bar();
        { const int t5 = opaque(tid);
#pragma unroll
          for (int q0 = 0; q0 < 32; q0 += 16) { unsigned zqp[16];
#pragma unroll
              for (int q = 0; q < 16; ++q) zqp[q] = Zs[t5 + 512 * (q0 + q)];
#pragma unroll
              for (int q = 0; q < 16; ++q) { const f32x2 gt = conv3_lds((const LAS bf16_t*)lds, t5 + 512 * (q0 + q), g0, g1, g2, gb);
                  a[q0 + q] = (f32x2){gt.x * (a[q0 + q].x * (1.0f / (float)N2) + hb * bf2f(zqp[q] & 0xffffu)), gt.y * (a[q0 + q].y * (1.0f / (float)N2) + hb * bf2f(zqp[q] >> 16))}; }
              asm volatile("" ::: "memory"); } }
        bar();
    }
    { bf16_t* yp = YMIX + (size_t)c * MT + tid;
#pragma unroll
      for (int q = 0; q < 32; ++q) { const unsigned pw_ = pg8::cvt_pk_bf16(a[q].x, a[q].y); yp[0] = (bf16_t)(pw_ & 0xffffu); yp[SEQ] = (bf16_t)(pw_ >> 16); yp += 512; asm volatile("" : "+v"(yp)); } }
}
}

constexpr int MK_LDS_BYTES = 147456;
static_assert(fft::LDS_RED + 64 <= MK_LDS_BYTES, "LDS map");
namespace lru {
constexpr int TC = 64, NCH = 260, NSU = 130;
constexpr int RS = 264, RSB = RS * 2;
constexpr int XR_OFF = 0, XR_BYTES = (TC + 3) * RSB;
constexpr int XG_OFF = XR_OFF + XR_BYTES;
constexpr int HY_OFF = XG_OFF + TC * RSB;
constexpr int CW_OFF = HY_OFF + TC * RSB;
constexpr int CAR_OFF = CW_OFF + 5 * 1024;
constexpr int U_OFF = CAR_OFF + 4 * 1024;
constexpr int LDS_END = U_OFF + TC * RSB;
static_assert(LDS_END <= 147456 - 64 && (U_OFF % 16) == 0 && (XG_OFF % 16) == 0 && (HY_OFF % 16) == 0 && (CW_OFF % 16) == 0, "lru LDS map");
constexpr float LOG2E = 1.4426950408889634f;
struct Params {
    const bf16_t* QKL; const bf16_t* LW;
    const float *cw, *cb, *ba, *bi, *lam;
    f32x2* AGG;
    bf16_t* YMIX;
};
__device__ __forceinline__ int chunk_row0(int b, int k) { return k < 4 ? NLAT + b * CTXL + 64 * k : b * SEQ + 64 * (k - 4); }
__device__ __forceinline__ float fsig(float x) { return __builtin_amdgcn_rcpf(1.0f + __builtin_amdgcn_exp2f(-LOG2E * x)); }

struct LaneConst { int ch[2]; };
struct DirConst { bf16x8 Bf[2][2][2]; float ba[2], bi[2], sp2[2]; };
__device__ __forceinline__ void load_dir(const Params& P, int dir, int n, int hf, int l15, int kg, const LaneConst& lc, DirConst& dc) {
#pragma unroll
    for (int ty = 0; ty < 2; ++ty)
#pragma unroll
        for (int cc = 0; cc < 2; ++cc)
#pragma unroll
            for (int ks = 0; ks < 2; ++ks) dc.Bf[ty][cc][ks] = *(const bf16x8*)(P.LW + ((((size_t)dir * 4 + n) * 2 + ty) * 64 + 32 * hf + 16 * cc + l15) * 64 + 32 * ks + 8 * kg);
#pragma unroll
    for (int cc = 0; cc < 2; ++cc) { dc.ba[cc] = -LOG2E * P.ba[dir * 256 + lc.ch[cc]]; dc.bi[cc] = -LOG2E * P.bi[dir * 256 + lc.ch[cc]]; dc.sp2[cc] = -8.0f * LOG2E * log1pf(expf(-P.lam[dir * 256 + lc.ch[cc]])); }
}
template <bool FINAL, int DIR>
__device__ __forceinline__ void tile_dir(LAS unsigned char* lds, const LaneConst& lc, const DirConst& dc, int n, int lane, int ss, LAS bf16_t* Hs, float (&car)[2], float (&Pm)[2], float (&Qm)[2]) {
    const int l15 = lane & 15, kg = lane >> 4;
    const LAS bf16_t* UU = (const LAS bf16_t*)(lds + U_OFF);
    bf16x8 Af[2];
#pragma unroll
    for (int ks = 0; ks < 2; ++ks) Af[ks] = *(const LAS bf16x8*)(UU + (16 * ss + l15) * RS + 64 * n + 32 * ks + 8 * kg);
#pragma unroll
    for (int cc = 0; cc < 2; ++cc) {
        f32x4 ar = (f32x4){0.f, 0.f, 0.f, 0.f}, ai = ar;
        ar = __builtin_amdgcn_mfma_f32_16x16x32_bf16(Af[0], dc.Bf[0][cc][0], ar, 0, 0, 0); ar = __builtin_amdgcn_mfma_f32_16x16x32_bf16(Af[1], dc.Bf[0][cc][1], ar, 0, 0, 0);
        ai = __builtin_amdgcn_mfma_f32_16x16x32_bf16(Af[0], dc.Bf[1][cc][0], ai, 0, 0, 0); ai = __builtin_amdgcn_mfma_f32_16x16x32_bf16(Af[1], dc.Bf[1][cc][1], ai, 0, 0, 0);
        const int ch = lc.ch[cc];
        float av[4], bv[4];
#pragma unroll
        for (int rg = 0; rg < 4; ++rg) { const int r = 16 * ss + 4 * kg + rg;
            const float u = bf2f(UU[r * RS + ch]);
            const float rgt = __builtin_amdgcn_rcpf(1.0f + __builtin_amdgcn_exp2f(ar[rg] + dc.ba[cc])), igt = __builtin_amdgcn_rcpf(1.0f + __builtin_amdgcn_exp2f(ai[rg] + dc.bi[cc]));
            const float x2 = rgt * dc.sp2[cc]; const float a = __builtin_amdgcn_exp2f(x2), a2 = a * a;
            av[rg] = a; bv[rg] = __builtin_amdgcn_sqrtf(fmaxf(1.0f - a2, 0.f)) * (igt * u); }
        float Pl = 1.f, Ql = 0.f;
#pragma unroll
        for (int i = 0; i < 4; ++i) { const int rg = DIR == 0 ? i : 3 - i; Ql = av[rg] * Ql + bv[rg]; Pl *= av[rg]; }
        const bool odd = (kg & 1) != 0, second = DIR == 0 ? odd : !odd;
        const auto sp = __builtin_amdgcn_permlane16_swap(__float_as_uint(Pl), __float_as_uint(Pl), false, false);
        const auto sq = __builtin_amdgcn_permlane16_swap(__float_as_uint(Ql), __float_as_uint(Ql), false, false);
        const float nbP = __uint_as_float(odd ? sp[0] : sp[1]), nbQ = __uint_as_float(odd ? sq[0] : sq[1]);
        const float TP = Pl * nbP, TQ = second ? Pl * nbQ + Ql : nbP * Ql + nbQ;
        const auto tp = __builtin_amdgcn_permlane32_swap(__float_as_uint(TP), __float_as_uint(TP), false, false);
        const auto tq = __builtin_amdgcn_permlane32_swap(__float_as_uint(TQ), __float_as_uint(TQ), false, false);
        const float PF = __uint_as_float(DIR == 0 ? tp[0] : tp[1]), QF = __uint_as_float(DIR == 0 ? tq[0] : tq[1]);
        const float PS = __uint_as_float(DIR == 0 ? tp[1] : tp[0]), QS = __uint_as_float(DIR == 0 ? tq[1] : tq[0]);
        const float Pt = PS * PF, Qt = PS * QF + QS;
        if (FINAL) {
            const int pos = DIR == 0 ? kg : 3 - kg;
            float Pe = 1.f, Qe = 0.f;
            if (pos == 1) { Pe = nbP; Qe = nbQ; } else if (pos == 2) { Pe = PF; Qe = QF; } else if (pos == 3) { Pe = nbP * PF; Qe = nbP * QF + nbQ; }
            float h = Pe * car[cc] + Qe;
#pragma unroll
            for (int i = 0; i < 4; ++i) { const int rg = DIR == 0 ? i : 3 - i; h = av[rg] * h + bv[rg]; Hs[(16 * ss + 4 * kg + rg) * RS + ch] = (bf16_t)pg8::cvt_pk_bf16(h, h); }
            car[cc] = Pt * car[cc] + Qt;
        } else { Qm[cc] = Pt * Qm[cc] + Qt; Pm[cc] = Pt * Pm[cc]; }
    }
}
__device__ __forceinline__ void load_chunk(LAS unsigned char* lds, const Params& P, int b, int k, bool with_xg, int tid) {
    const int Ls = k < 4 ? CTXL : SEQ, kk = k < 4 ? k : k - 4, seq0 = k < 4 ? NLAT + b * CTXL : b * SEQ, t0 = 64 * kk - 2;
    {   u32x4 vr[5];
#pragma unroll
        for (int i5 = 0; i5 < 5; ++i5) { const int e = tid + 512 * i5, i = e >> 5, cchunk = e & 31, t = t0 + i;
            vr[i5] = (u32x4){0u, 0u, 0u, 0u};
            if (e < (TC + 3) * 32 && t >= 0 && t < Ls) vr[i5] = *(const u32x4*)(P.QKL + (size_t)(seq0 + t) * NQKL + 1024 + 8 * cchunk); }
#pragma unroll
        for (int i5 = 0; i5 < 5; ++i5) { const int e = tid + 512 * i5, i = e >> 5, cchunk = e & 31; if (e < (TC + 3) * 32) *(LAS u32x4*)(lds + XR_OFF + i * RSB + cchunk * 16) = vr[i5]; }
        asm volatile("" ::: "memory"); }
    if (with_xg) { u32x4 vg[4];
#pragma unroll
        for (int i4 = 0; i4 < 4; ++i4) { const int e = tid + 512 * i4, i = e >> 5, cchunk = e & 31; vg[i4] = *(const u32x4*)(P.QKL + (size_t)(seq0 + 64 * kk + i) * NQKL + 1280 + 8 * cchunk); }
#pragma unroll
        for (int i4 = 0; i4 < 4; ++i4) { const int e = tid + 512 * i4, i = e >> 5, cchunk = e & 31; *(LAS u32x4*)(lds + XG_OFF + i * RSB + cchunk * 16) = vg[i4]; }
    }
}
template <bool FINAL>
__device__ __forceinline__ void super_unit(LAS unsigned char* lds, const Params& P, int su, int dmask = 0) {
    const int tid = opaque_i(threadIdx.x), lane = tid & 63, wid = tid >> 6, n = wid >> 1, hf = wid & 1, l15 = lane & 15, kg = lane >> 4;
    const bool isctx = su >= 256; const int b = isctx ? (su - 256) >> 2 : su >> 7, s = isctx ? ((su - 256) & 3) >> 1 : 2 + (su & 127), k0 = isctx ? (su - 256) & 3 : 2 * s, nchk = isctx ? 1 : 2;
    LAS float* CW = (LAS float*)(lds + CW_OFF); LAS float* CAR = (LAS float*)(lds + CAR_OFF);
    f32x2* AGG64 = P.AGG; f32x2* AGG128 = P.AGG + (size_t)2 * NCH * 2 * 256;
    __syncthreads();
    for (int e = tid; e < 5 * 256; e += 512) CW[e] = e < 1024 ? P.cw[e] : P.cb[e - 1024];
    if (FINAL) {
        const int dir = tid >> 8, ch = tid & 255;
        const f32x2* a64 = AGG64 + ((size_t)b * NCH * 2 + dir) * 256 + ch;
        const f32x2* a128 = AGG128 + ((size_t)b * NSU * 2 + dir) * 256 + ch;
        const int nc = isctx ? (dir == 0 ? k0 : 3 - k0) : 4;
        const int npos = nc + (isctx ? 0 : (dir == 0 ? s - 2 : 129 - s));
        float h = 0.f;
#pragma unroll 1
        for (int p0 = 0; p0 < 132; p0 += 33) {
            if (p0 >= npos) break;
            f32x2 v[33];
#pragma unroll
            for (int i = 0; i < 33; ++i) { const int p = p0 + i, pc = p < npos ? p : 0;
                const f32x2* src = pc < nc ? a64 + (size_t)(dir == 0 ? pc : 3 - pc) * 512 : a128 + (size_t)(dir == 0 ? 2 + (pc - nc) : 129 - (pc - nc)) * 512;
                v[i] = *src; }
#pragma unroll
            for (int i = 0; i < 33; ++i) { const bool live = p0 + i < npos; h = (live ? v[i].x : 1.f) * h + (live ? v[i].y : 0.f); }
        }
        if (dir == 0) CAR[0 * 512 + ch] = h;
        else if (isctx) CAR[0 * 512 + 256 + ch] = h;
        else { CAR[1 * 512 + 256 + ch] = h; const f32x2 v = AGG64[(((size_t)b * NCH + k0 + 1) * 2 + 1) * 256 + ch]; CAR[0 * 512 + 256 + ch] = v.x * h + v.y; }
    }
    LaneConst lc;
#pragma unroll
    for (int cc = 0; cc < 2; ++cc) lc.ch[cc] = 64 * n + 32 * hf + 16 * cc + l15;
    float car0[2] = {0.f, 0.f};
    float P0m[2][2], Q0m[2][2];
#pragma unroll 1
    for (int j = 0; j < nchk; ++j) {
        const int k = k0 + j, row0 = chunk_row0(b, k);
        if (j > 0) __syncthreads();
#ifdef MK_LRU_XL
        if (!FINAL) for (int xl_ = 0; xl_ < MK_LRU_XL; ++xl_) { load_chunk(lds, P, b, k, FINAL, tid); __syncthreads(); }
#endif
        load_chunk(lds, P, b, k, FINAL, tid);
        __syncthreads();
        {
            const int cg8 = 8 * (tid & 31); const LAS float* CWr = (const LAS float*)(lds + CW_OFF); const LAS bf16_t* XRr = (const LAS bf16_t*)(lds + XR_OFF);
            f32x4 wl[5], wh[5];
#pragma unroll
            for (int kx = 0; kx < 5; ++kx) { wl[kx] = *(const LAS f32x4*)(CWr + kx * 256 + cg8); wh[kx] = *(const LAS f32x4*)(CWr + kx * 256 + cg8 + 4); }
#pragma unroll
            for (int i = 0; i < 4; ++i) { const int tok = (tid >> 5) + 16 * i; f32x4 lo = wl[4], hi = wh[4];
#pragma unroll
                for (int kx = 0; kx < 4; ++kx) { const u32x4 xw = *(const LAS u32x4*)(XRr + (tok + kx) * RS + cg8);
                    lo[0] += wl[kx][0] * bf2f(xw.x & 0xffffu); lo[1] += wl[kx][1] * bf2f(xw.x >> 16); lo[2] += wl[kx][2] * bf2f(xw.y & 0xffffu); lo[3] += wl[kx][3] * bf2f(xw.y >> 16);
                    hi[0] += wh[kx][0] * bf2f(xw.z & 0xffffu); hi[1] += wh[kx][1] * bf2f(xw.z >> 16); hi[2] += wh[kx][2] * bf2f(xw.w & 0xffffu); hi[3] += wh[kx][3] * bf2f(xw.w >> 16); }
                u32x4 pw; pw.x = pg8::cvt_pk_bf16(lo[0], lo[1]); pw.y = pg8::cvt_pk_bf16(lo[2], lo[3]); pw.z = pg8::cvt_pk_bf16(hi[0], hi[1]); pw.w = pg8::cvt_pk_bf16(hi[2], hi[3]);
                *(LAS u32x4*)(lds + U_OFF + tok * RSB + cg8 * 2) = pw; }
        }
        __syncthreads();
        {
            float carF[2], carR[2], PmF[2] = {1.f, 1.f}, QmF[2] = {0.f, 0.f}, PmR[2] = {1.f, 1.f}, QmR[2] = {0.f, 0.f};
            if (FINAL) {
#pragma unroll
                for (int cc = 0; cc < 2; ++cc) { carF[cc] = j == 1 ? car0[cc] : CAR[0 * 256 + lc.ch[cc]]; carR[cc] = CAR[j * 512 + 256 + lc.ch[cc]]; }
            } else { carF[0] = carF[1] = carR[0] = carR[1] = 0.f; }
            LAS bf16_t* H0 = (LAS bf16_t*)(lds + HY_OFF); LAS bf16_t* H1 = (LAS bf16_t*)(lds + XR_OFF);
            {   DirConst dc0, dc1; load_dir(P, 0, n, hf, l15, kg, lc, dc0); load_dir(P, 1, n, hf, l15, kg, lc, dc1);
#ifdef MK_LRU_XS
                if (!FINAL) for (int xs_ = 0; xs_ < MK_LRU_XS; ++xs_) { float c1_[2] = {0.f, 0.f}, c2_[2] = {0.f, 0.f}, p1_[2] = {1.f, 1.f}, q1_[2] = {0.f, 0.f}, p2_[2] = {1.f, 1.f}, q2_[2] = {0.f, 0.f};
#pragma unroll 1
                    for (int sx = 0; sx < 4; ++sx) { tile_dir<false, 0>(lds, lc, dc0, n, lane, sx, H0, c1_, p1_, q1_); tile_dir<false, 1>(lds, lc, dc1, n, lane, 3 - sx, H1, c2_, p2_, q2_); }
                    asm volatile("" :: "v"(p1_[0]), "v"(q1_[0]), "v"(p2_[1]), "v"(q2_[1])); }
#endif
                if (!FINAL && dmask == 1) {
#pragma unroll 1
                    for (int sx = 0; sx < 4; ++sx) tile_dir<FINAL, 0>(lds, lc, dc0, n, lane, sx, H0, carF, PmF, QmF);
                } else if (!FINAL && dmask == 2) {
#pragma unroll 1
                    for (int sx = 0; sx < 4; ++sx) tile_dir<FINAL, 1>(lds, lc, dc1, n, lane, 3 - sx, H1, carR, PmR, QmR);
                } else {
#pragma unroll 1
                    for (int sx = 0; sx < 4; ++sx) { tile_dir<FINAL, 0>(lds, lc, dc0, n, lane, sx, H0, carF, PmF, QmF); tile_dir<FINAL, 1>(lds, lc, dc1, n, lane, 3 - sx, H1, carR, PmR, QmR); } } }
            if (FINAL) { car0[0] = carF[0]; car0[1] = carF[1]; }
            else {
#pragma unroll
                for (int cc = 0; cc < 2; ++cc) {
                    if (kg == 0) { if (dmask != 2) AGG64[(((size_t)b * NCH + k) * 2 + 0) * 256 + lc.ch[cc]] = (f32x2){PmF[cc], QmF[cc]}; if (dmask != 1) AGG64[(((size_t)b * NCH + k) * 2 + 1) * 256 + lc.ch[cc]] = (f32x2){PmR[cc], QmR[cc]}; }
                    if (j == 0) { P0m[0][cc] = PmF[cc]; Q0m[0][cc] = QmF[cc]; P0m[1][cc] = PmR[cc]; Q0m[1][cc] = QmR[cc]; }
                    else if (kg == 0) {
                        AGG128[(((size_t)b * NSU + s) * 2 + 0) * 256 + lc.ch[cc]] = (f32x2){P0m[0][cc] * PmF[cc], PmF[cc] * Q0m[0][cc] + QmF[cc]};
                        AGG128[(((size_t)b * NSU + s) * 2 + 1) * 256 + lc.ch[cc]] = (f32x2){P0m[1][cc] * PmR[cc], P0m[1][cc] * QmR[cc] + Q0m[1][cc]}; }
                }
            }
        }
        if (FINAL) {
            __syncthreads();
            for (int e = tid; e < TC * 32; e += 512) { const int i = e >> 5, cchunk = e & 31;
                const u32x4 hf4 = *(const LAS u32x4*)(lds + HY_OFF + i * RSB + cchunk * 16), hr4 = *(const LAS u32x4*)(lds + XR_OFF + i * RSB + cchunk * 16), xg4 = *(const LAS u32x4*)(lds + XG_OFF + i * RSB + cchunk * 16);
                u32x4 o;
#pragma unroll
                for (int w2 = 0; w2 < 4; ++w2) { float y2[2];
#pragma unroll
                    for (int hh = 0; hh < 2; ++hh) { const float hs = bf2f(hh ? hf4[w2] >> 16 : hf4[w2] & 0xffffu) + bf2f(hh ? hr4[w2] >> 16 : hr4[w2] & 0xffffu), xg = bf2f(hh ? xg4[w2] >> 16 : xg4[w2] & 0xffffu);
                        y2[hh] = hs * (xg * fsig(1.5957691216057308f * (xg + 0.044715f * xg * xg * xg))); }
                    o[w2] = pg8::cvt_pk_bf16(y2[0], y2[1]); }
                *(u32x4*)(P.YMIX + (size_t)(row0 + i) * D + 768 + 8 * cchunk) = o; }
        }
    }
}
}
namespace na {
constexpr float LOG2E = 1.4426950408889634f, QSCALE = 0.125f * LOG2E;
constexpr int KC_OFF = 0, VC_OFF = 32768;
constexpr int KL_OFF = 0, VL_OFF = 65536, RPB_OFF = 131072;
constexpr int RPB_PITCH = 17;
constexpr int LDS_END = RPB_OFF + 32 * RPB_PITCH * 4;
static_assert(LDS_END <= 147456, "na LDS map");
struct Params { const bf16_t* QKL; const bf16_t* VT; const float* rpb; bf16_t* YMIX; };

struct RowState { f32x4 o[4]; float m, l; };
template <bool LOCAL>
__device__ __forceinline__ void chunk(LAS unsigned char* lds, RowState& st, const bf16x8 (&Qf)[2], int kbase, int kstride_pair, int vbase, int lane, int cq, int drbase, int kc0) {
    const int l15 = lane & 15, kg = lane >> 4;
    const int kswz = ((l15 >> 2) << 1) | ((l15 >> 1) & 1);
    f32x4 S[8];
    bf16x8 kf[3][2][2];
#define NA_KLOAD(slot, tp) do { _Pragma("unroll") for (int tt = 0; tt < 2; ++tt) { const int t_ = 2 * (tp) + tt; \
            const int krow = LOCAL ? (KL_OFF + (((kbase + (t_ >> 1)) & 15) << 12)) : (kbase + (t_ >> 1) * 32 * 128); const int ka = krow + (8 * (l15 >> 2) + 4 * tt + (l15 & 3)) * 128; \
            kf[slot][tt][0] = *(const LAS bf16x8*)(lds + ka + (((0 + kg) ^ kswz) << 4)); kf[slot][tt][1] = *(const LAS bf16x8*)(lds + ka + (((4 + kg) ^ kswz) << 4)); } } while (0)
    NA_KLOAD(0, 0); NA_KLOAD(1, 1);
    __builtin_amdgcn_sched_barrier(0);
    float bias[2][4][4];
    if (LOCAL) {
        const int start = min(max(cq - 8, 0), GRIDW - 16);
#pragma unroll
        for (int hh = 0; hh < 2; ++hh)
#pragma unroll
            for (int rg = 0; rg < 4; ++rg) { const int kcol = kc0 + 8 * kg + 4 * hh + rg; const bool valid = (kcol >= start) && (kcol < start + 16);
                const LAS float* bp = (const LAS float*)(lds + RPB_OFF + ((valid ? kcol - cq + 15 : 31) * RPB_PITCH + drbase) * 4);
#pragma unroll
                for (int jr = 0; jr < 4; ++jr) bias[hh][rg][jr] = bp[jr]; }
    }
    __builtin_amdgcn_sched_barrier(0);
#pragma unroll
    for (int tp = 0; tp < 4; ++tp) {
        if (tp + 2 < 4) NA_KLOAD((tp + 2) % 3, tp + 2);
#pragma unroll
        for (int tt = 0; tt < 2; ++tt) { f32x4 s = (f32x4){0.f, 0.f, 0.f, 0.f};
            s = __builtin_amdgcn_mfma_f32_16x16x32_bf16(kf[tp % 3][tt][0], Qf[0], s, 0, 0, 0);
            s = __builtin_amdgcn_mfma_f32_16x16x32_bf16(kf[tp % 3][tt][1], Qf[1], s, 0, 0, 0);
            S[2 * tp + tt] = s; }
        __builtin_amdgcn_sched_barrier(0);
    }
#undef NA_KLOAD
    float mx = -3.0e38f;
#pragma unroll
    for (int t = 0; t < 8; ++t) {
        if (LOCAL) {
#pragma unroll
            for (int rg = 0; rg < 4; ++rg) S[t][rg] = __builtin_fmaf(S[t][rg], QSCALE, bias[t & 1][rg][t >> 1]);
        }
        mx = fmaxf(mx, fmaxf(fmaxf(S[t][0], S[t][1]), fmaxf(S[t][2], S[t][3])));
    }
    if (!LOCAL) mx *= QSCALE;
    mx = fmaxf(mx, __shfl_xor(mx, 16)); mx = fmaxf(mx, __shfl_xor(mx, 32));
    const float mn = fmaxf(st.m, mx), alpha = __builtin_amdgcn_exp2f(st.m - mn);
    st.m = mn; st.l *= alpha;
#pragma unroll
    for (int dt = 0; dt < 4; ++dt) st.o[dt] *= alpha;
    bf16x8 vfr[2][4];
#define NA_VLOAD(slot, jj) do { const int vgb_ = LOCAL ? (VL_OFF + (((kbase + (jj)) & 15) << 12)) : (vbase + (jj) * 4096); _Pragma("unroll") for (int dt = 0; dt < 4; ++dt) { const int d = 16 * dt + l15; \
            vfr[slot][dt] = *(const LAS bf16x8*)(lds + vgb_ + d * 64 + ((kg ^ ((0 - (d >> 2)) & 3)) << 4)); } } while (0)
    NA_VLOAD(0, 0);
    float ls = 0.f;
#pragma unroll
    for (int t = 0; t < 8; ++t)
#pragma unroll
        for (int rg = 0; rg < 4; ++rg) { const float p = __builtin_amdgcn_exp2f(LOCAL ? S[t][rg] - mn : __builtin_fmaf(S[t][rg], QSCALE, -mn)); S[t][rg] = p; ls += p; }
    st.l += ls;
#pragma unroll
    for (int j = 0; j < 4; ++j) {
        u32x4 pw; pw.x = pg8::cvt_pk_bf16(S[2 * j][0], S[2 * j][1]); pw.y = pg8::cvt_pk_bf16(S[2 * j][2], S[2 * j][3]); pw.z = pg8::cvt_pk_bf16(S[2 * j + 1][0], S[2 * j + 1][1]); pw.w = pg8::cvt_pk_bf16(S[2 * j + 1][2], S[2 * j + 1][3]);
        const bf16x8 Pf = __builtin_bit_cast(bf16x8, pw);
        if (j + 1 < 4) NA_VLOAD((j + 1) & 1, j + 1);
#pragma unroll
        for (int dt = 0; dt < 4; ++dt) st.o[dt] = __builtin_amdgcn_mfma_f32_16x16x32_bf16(vfr[j & 1][dt], Pf, st.o[dt], 0, 0, 0);
        __builtin_amdgcn_sched_barrier(0);
    }
#undef NA_VLOAD
}
__device__ __forceinline__ void smax_ctx(RowState& st, f32x4 (&S)[8], bf16x8 (&Pf)[4]) {
    float mx = -3.0e38f;
#pragma unroll
    for (int t = 0; t < 8; ++t) mx = fmaxf(mx, fmaxf(fmaxf(S[t][0], S[t][1]), fmaxf(S[t][2], S[t][3])));
    mx *= QSCALE;
    mx = fmaxf(mx, __shfl_xor(mx, 16)); mx = fmaxf(mx, __shfl_xor(mx, 32));
    const float mn = fmaxf(st.m, mx), alpha = __builtin_amdgcn_exp2f(st.m - mn);
    st.m = mn; st.l *= alpha;
#pragma unroll
    for (int dt = 0; dt < 4; ++dt) st.o[dt] *= alpha;
    float ls = 0.f;
#pragma unroll
    for (int t = 0; t < 8; ++t)
#pragma unroll
        for (int rg = 0; rg < 4; ++rg) { const float pp = __builtin_amdgcn_exp2f(__builtin_fmaf(S[t][rg], QSCALE, -mn)); S[t][rg] = pp; ls += pp; }
    st.l += ls;
#pragma unroll
    for (int j = 0; j < 4; ++j) { u32x4 pw; pw.x = pg8::cvt_pk_bf16(S[2 * j][0], S[2 * j][1]); pw.y = pg8::cvt_pk_bf16(S[2 * j][2], S[2 * j][3]); pw.z = pg8::cvt_pk_bf16(S[2 * j + 1][0], S[2 * j + 1][1]); pw.w = pg8::cvt_pk_bf16(S[2 * j + 1][2], S[2 * j + 1][3]);
        Pf[j] = __builtin_bit_cast(bf16x8, pw); }
}
__device__ __forceinline__ void chunk_ctx2(LAS unsigned char* lds, RowState& sa, RowState& sb, const bf16x8 (&Qa)[2], const bf16x8 (&Qb)[2], int kbase, int vbase, int lane) {
    const int l15 = lane & 15, kg = lane >> 4, kswz = ((l15 >> 2) << 1) | ((l15 >> 1) & 1);
    f32x4 Sa[8], Sb[8];
#pragma unroll
    for (int t = 0; t < 8; ++t) { const int ka = kbase + (t >> 1) * 32 * 128 + (8 * (l15 >> 2) + 4 * (t & 1) + (l15 & 3)) * 128;
        const bf16x8 k0 = *(const LAS bf16x8*)(lds + ka + (((0 + kg) ^ kswz) << 4)), k1 = *(const LAS bf16x8*)(lds + ka + (((4 + kg) ^ kswz) << 4));
        f32x4 s0 = (f32x4){0.f, 0.f, 0.f, 0.f}, s1 = s0;
        s0 = __builtin_amdgcn_mfma_f32_16x16x32_bf16(k0, Qa[0], s0, 0, 0, 0); s1 = __builtin_amdgcn_mfma_f32_16x16x32_bf16(k0, Qb[0], s1, 0, 0, 0);
        s0 = __builtin_amdgcn_mfma_f32_16x16x32_bf16(k1, Qa[1], s0, 0, 0, 0); s1 = __builtin_amdgcn_mfma_f32_16x16x32_bf16(k1, Qb[1], s1, 0, 0, 0);
        Sa[t] = s0; Sb[t] = s1; if (t & 1) __builtin_amdgcn_sched_barrier(0); }
    bf16x8 Pa[4], Pb[4];
    smax_ctx(sa, Sa, Pa); smax_ctx(sb, Sb, Pb);
#pragma unroll
    for (int j = 0; j < 4; ++j) { const int vgb = vbase + j * 4096;
#pragma unroll
        for (int dt = 0; dt < 4; ++dt) { const int d = 16 * dt + l15;
            const bf16x8 vf = *(const LAS bf16x8*)(lds + vgb + d * 64 + ((kg ^ ((0 - (d >> 2)) & 3)) << 4));
            sa.o[dt] = __builtin_amdgcn_mfma_f32_16x16x32_bf16(vf, Pa[j], sa.o[dt], 0, 0, 0); sb.o[dt] = __builtin_amdgcn_mfma_f32_16x16x32_bf16(vf, Pb[j], sb.o[dt], 0, 0, 0); }
    }
}
__device__ __forceinline__ void glds16(const void* g, LAS unsigned char* l) { __builtin_amdgcn_global_load_lds((const unsigned*)g, (LAS unsigned*)l, 16, 0, 0); }
__device__ __forceinline__ void stage_ctx(LAS unsigned char* lds, const Params& P, int b, int h) {
    const int tids = opaque_i(threadIdx.x), wv = __builtin_amdgcn_readfirstlane(tids >> 6), lane = tids & 63;
#pragma unroll
    for (int it = 0; it < 4; ++it) { const int e = (it * 8 + wv) * 64 + lane, key = e >> 3, c = (e & 7) ^ ((((key >> 3) & 3) << 1) | ((key >> 1) & 1));
        glds16(P.QKL + (size_t)(NLAT + b * CTXL + key) * NQKL + 512 + h * 64 + 8 * c, lds + KC_OFF + (it * 8 + wv) * 1024); }
#pragma unroll
    for (int it = 0; it < 4; ++it) { const int e = (it * 8 + wv) * 64 + lane, g32 = e >> 8, d = (e >> 2) & 63, j8l = (e & 3) ^ ((0 - (d >> 2)) & 3);
        glds16(P.VT + (size_t)(h * 64 + d) * MT + NLAT + b * CTXL + 32 * g32 + 8 * j8l, lds + VC_OFF + (it * 8 + wv) * 1024); }
}
__device__ __forceinline__ void load_q(const Params& P, int row, int h, int lane, bf16x8 (&Qf)[2]) {
    const bf16_t* qp = P.QKL + (size_t)row * NQKL + h * 64 + 8 * (lane >> 4);
    Qf[0] = *(const bf16x8*)(qp); Qf[1] = *(const bf16x8*)(qp + 32);
}
__device__ __forceinline__ void finish_row(const Params& P, RowState& st, int row, int h, int lane) {
    float l = st.l; l += __shfl_xor(l, 16); l += __shfl_xor(l, 32);
    const float inv = 1.0f / l;
    bf16_t* op = P.YMIX + (size_t)row * D + 256 + h * 64 + 4 * (lane >> 4);
#pragma unroll
    for (int dt = 0; dt < 4; ++dt) { const f32x4 o = st.o[dt] * inv; u32x2 w; w.x = pg8::cvt_pk_bf16(o[0], o[1]); w.y = pg8::cvt_pk_bf16(o[2], o[3]); *(u32x2*)(op + 16 * dt) = w; }
}
__device__ __forceinline__ void init_row(RowState& st) {
#pragma unroll
    for (int dt = 0; dt < 4; ++dt) st.o[dt] = (f32x4){0.f, 0.f, 0.f, 0.f};
    st.m = -1.0e30f; st.l = 0.f;
}
__device__ __forceinline__ void stage_rows(LAS unsigned char* lds, const Params& P, int b, int h, int kc0, int Rlo, int Rhi, int wv, int lane) {
#pragma unroll
    for (int i = 0; i < 4; ++i) { const int R = Rlo + i;
        if (R <= Rhi) {
            if (wv < 4) { const int e = wv * 64 + lane, col = e >> 3, c = (e & 7) ^ ((((col >> 3) & 3) << 1) | ((col >> 1) & 1));
                glds16(P.QKL + (size_t)(b * SEQ + R * GRIDW + kc0 + col) * NQKL + 512 + h * 64 + 8 * c, lds + KL_OFF + (R & 15) * 4096 + wv * 1024); }
            else { const int e = (wv - 4) * 64 + lane, d = (e >> 2) & 63, j8 = (e & 3) ^ ((0 - (d >> 2)) & 3);
                glds16(P.VT + (size_t)(h * 64 + d) * MT + b * SEQ + R * GRIDW + kc0 + 8 * j8, lds + VL_OFF + (R & 15) * 4096 + (wv - 4) * 1024); } } }
}
__device__ __forceinline__ void latent_unit(LAS unsigned char* lds, const Params& P, int u, int pm = 0) {
    const int b = u >> 8, h = (u >> 5) & 7, n = (u >> 3) & 3, rr = u & 7, r0 = 32 * rr;
    const int tid = opaque_i(threadIdx.x), lane = tid & 63, w = tid >> 6, l15 = lane & 15;
    const int kc0 = n == 0 ? 0 : (n == 1 ? 8 : (n == 2 ? 24 : 32)), cq = 16 * n + l15;
    __syncthreads();
    stage_ctx(lds, P, b, h);
    for (int e = tid; e < 15 * 32; e += 512) { const int dr = e >> 5, dc = e & 31; *(LAS float*)(lds + RPB_OFF + (dc * RPB_PITCH + dr) * 4) = dc < 31 ? P.rpb[(h * 15 + dr) * 31 + dc] * LOG2E : -1.0e30f; }
    __syncthreads();
    RowState st[4]; bf16x8 Qf[2][2], Qn[2][2];
    load_q(P, b * SEQ + (r0 + w) * GRIDW + cq, h, lane, Qf[0]); load_q(P, b * SEQ + (r0 + 8 + w) * GRIDW + cq, h, lane, Qf[1]);
    init_row(st[0]); init_row(st[1]);
    load_q(P, b * SEQ + (r0 + 16 + w) * GRIDW + cq, h, lane, Qn[0]); load_q(P, b * SEQ + (r0 + 24 + w) * GRIDW + cq, h, lane, Qn[1]);
#pragma unroll 1
    for (int cc = 0; cc < 2; ++cc) {
#ifdef MK_NA_PM
        if (pm & 2) continue;
#endif
        chunk_ctx2(lds, st[0], st[1], Qf[0], Qf[1], KC_OFF + cc * 128 * 128, VC_OFF + cc * 4 * 4096, lane); }
    load_q(P, b * SEQ + (r0 + w) * GRIDW + cq, h, lane, Qf[0]);
    init_row(st[2]); init_row(st[3]);
#pragma unroll 1
    for (int cc = 0; cc < 2; ++cc) {
#ifdef MK_NA_PM
        if (pm & 2) continue;
#endif
        chunk_ctx2(lds, st[2], st[3], Qn[0], Qn[1], KC_OFF + cc * 128 * 128, VC_OFF + cc * 4 * 4096, lane); }
    __syncthreads();
    const int wv = __builtin_amdgcn_readfirstlane(tid >> 6);
    int staged;
    { const int L0 = min(max(r0 - 4, 0), GROWS - 8), H0 = min(max(r0 + 3, 0), GROWS - 8) + 3;
      for (int R = L0; R <= H0; R += 4) stage_rows(lds, P, b, h, kc0, R, min(R + 3, H0), wv, lane);
      staged = H0; }
    __syncthreads();
#pragma unroll
    for (int g = 0; g < 4; ++g) {
        const int rg0 = r0 + 8 * g;
        const int r = rg0 + w, rs = min(max(rg0 + wv - 4, 0), GROWS - 8), row = b * SEQ + r * GRIDW + cq;
        const int rs7 = min(max(rg0 + 3, 0), GROWS - 8), rs7n = min(max(rg0 + 11, 0), GROWS - 8);
#pragma unroll 1
        for (int cc = 0; cc < 2; ++cc) {
            const int Hn = cc == 0 ? rs7 + 7 : (g < 3 ? rs7n + 3 : staged);
            if (Hn > staged) {
#ifdef MK_NA_PM
                if (!(pm & 8))
#endif
                stage_rows(lds, P, b, h, kc0, staged + 1, Hn, wv, lane); staged = Hn; }
            if (cc == 0 && g < 3) load_q(P, b * SEQ + (r0 + 8 * (g + 1) + w) * GRIDW + cq, h, lane, Qf[(g + 1) & 1]);
#ifdef MK_NA_PM
            if (!(pm & 4))
#endif
            chunk<true>(lds, st[g], Qf[g & 1], rs + 4 * cc, 0, 0, lane, cq, rs + 4 * cc - r + 7, kc0);
            __syncthreads();
        }
        finish_row(P, st[g], row, h, lane);
    }
}
__device__ __forceinline__ void ctx_unit(LAS unsigned char* lds, const Params& P, int u) {
    const int b = u >> 4, h = (u >> 1) & 7, half = u & 1, tidc = opaque_i(threadIdx.x), lane = tidc & 63, w = tidc >> 6;
    __syncthreads();
    stage_ctx(lds, P, b, h);
    __syncthreads();
    RowState st; bf16x8 Qf[2]; init_row(st);
    const int row = NLAT + b * CTXL + 128 * half + 16 * w + (lane & 15);
    load_q(P, row, h, lane, Qf);
#pragma unroll 1
    for (int cc = 0; cc < 2; ++cc) chunk<false>(lds, st, Qf, KC_OFF + cc * 128 * 128, 0, VC_OFF + cc * 4 * 4096, lane, 0, 0, 0);
    finish_row(P, st, row, h, lane);
}
}

#include <hip/hip_cooperative_groups.h>
namespace cg = cooperative_groups;
constexpr int NPHASE = 2 + 9 * DEPTH;
constexpr int FEARLY = 496;

struct MKArgs { const float* in[31]; float* out; unsigned char* ws; int ph_lo, ph_hi; };

#define XB_TMO      128
#define XB_XCNT(j)  (256  + 64 * (j))
#define XB_XSUB(j)  (1280 + 64 * (j))
#define XB_XGEN(j)  (2304 + 64 * (j))
#define XB_TOP      3328
#define XB_TOPGEN   3392
#define XCD_BAR_WORDS 3456
#define XB_SPIN_CAP (1u << 22)

__device__ __forceinline__ unsigned xb_ld(unsigned* p)              { return __hip_atomic_load(p, __ATOMIC_RELAXED, __HIP_MEMORY_SCOPE_AGENT); }
__device__ __forceinline__ unsigned xb_add(unsigned* p, unsigned v) { return __hip_atomic_fetch_add(p, v, __ATOMIC_RELAXED, __HIP_MEMORY_SCOPE_AGENT); }
__device__ __forceinline__ unsigned xb_xcc_id() { return (unsigned)__builtin_amdgcn_s_getreg((3 << 11) | 20) & 0xFu; }
#define XB_SPIN(cond, bar) do { unsigned _sp = 0; while (cond) { __builtin_amdgcn_s_sleep(1); \
    if ((++_sp & 255u) == 0u) { if (xb_ld(&(bar)[XB_TMO])) break; if (_sp > XB_SPIN_CAP) { atomicAdd(&(bar)[XB_TMO], 1u); break; } } } } while (0)

struct XcdBarrier {
    unsigned* bar; unsigned x;
    volatile LAS unsigned* st;
};

__device__ __forceinline__ XcdBarrier xcd_barrier_post(unsigned* bar, volatile LAS unsigned* st) {
    XcdBarrier b; b.bar = bar; b.x = xb_xcc_id(); b.st = st;
    if (threadIdx.x == 0) (void)xb_add(&bar[XB_XCNT(b.x)], 1u);
    return b;
}
__device__ __forceinline__ void xcd_barrier_complete(unsigned* bar, unsigned x, unsigned& nloc, unsigned& nx) {
    const unsigned G = gridDim.x * gridDim.y * gridDim.z;
    unsigned sum, cnt, mine, sp = 0u;
    for (;;) {
        sum = 0u; cnt = 0u; mine = 0u;
#pragma unroll
        for (unsigned j = 0; j < 16; ++j) { const unsigned c = xb_ld(&bar[XB_XCNT(j)]); sum += c; cnt += (c > 0u) ? 1u : 0u; mine = (j == x) ? c : mine; }
        if (sum == G) break;
        __builtin_amdgcn_s_sleep(1);
        if ((++sp & 255u) == 0u) { if (xb_ld(&bar[XB_TMO])) break; if (sp > XB_SPIN_CAP) { atomicAdd(&bar[XB_TMO], 1u); break; } }
    }
    nloc = mine > 0u ? mine : 1u; nx = cnt > 0u ? cnt : 1u;
}

__device__ __forceinline__ void xcd_barrier(const XcdBarrier& b) {
    asm volatile("s_waitcnt vmcnt(0)" ::: "memory");
    __syncthreads();
    if (threadIdx.x == 0) {
        unsigned* bar = b.bar;
        __builtin_amdgcn_s_waitcnt(0);
        unsigned nloc = b.st[0], nx = b.st[1];
        if (nloc == 0u) { xcd_barrier_complete(bar, b.x, nloc, nx); b.st[0] = nloc; b.st[1] = nx; }
        const unsigned old = xb_add(&bar[XB_XSUB(b.x)], 1u);
        const unsigned gen = old / nloc;
        if (old + 1u == (gen + 1u) * nloc) {
            __builtin_amdgcn_fence(__ATOMIC_RELEASE, "agent");
            asm volatile("s_waitcnt vmcnt(0)" ::: "memory");
            const unsigned og = xb_add(&bar[XB_TOP], 1u);
            const unsigned tg = og / nx;
            if (og + 1u == (tg + 1u) * nx) xb_add(&bar[XB_TOPGEN], 1u);
            else XB_SPIN(xb_ld(&bar[XB_TOPGEN]) == tg, bar);
            __builtin_amdgcn_fence(__ATOMIC_ACQUIRE, "agent");
            xb_add(&bar[XB_XGEN(b.x)], 1u);
            asm volatile("s_waitcnt vmcnt(0)" ::: "memory");
        } else {
            XB_SPIN(xb_ld(&bar[XB_XGEN(b.x)]) == gen, bar);
            __builtin_amdgcn_fence(__ATOMIC_ACQUIRE, "agent");
            asm volatile("s_waitcnt vmcnt(0)" ::: "memory");
        }
    }
    __syncthreads();
}


namespace mk {
struct Ctx { LAS unsigned char* lds; int tid, lane, wave, G, bx; };

__device__ __forceinline__ void p_weights(const Ctx& c, const MKArgs& a) {
    LAS float* scr = (LAS float*)c.lds + c.wave * 64 * 33;
    for (int it = c.bx * 8 + c.wave; it < (c.G == 256 ? WI_IN : DEPTH * WI_LAYER); it += c.G * 8) wconv_item(it, a.in[10], a.in[11], a.in[29], a.in[30], a.ws, scr, c.lane);
    bf16_t* LW = (bf16_t*)(a.ws + WS_LW);
    for (int gid = c.bx * 512 + c.tid; gid < DEPTH * 2 * 4 * 2 * 64 * 64; gid += c.G * 512) {
        const int i = gid & 63, o = (gid >> 6) & 63, ty = (gid >> 12) & 1, nb = (gid >> 13) & 3, dir = (gid >> 15) & 1, l = gid >> 16;
        const float* src = ty == 0 ? a.in[24] : a.in[26];
        LW[gid] = (bf16_t)f2bf(-1.4426950408889634f * src[((((size_t)l * 2 + dir) * 4 + nb) * 64 + i) * 64 + o]); }
}
__device__ __forceinline__ void p_weights_late(const Ctx& c, const MKArgs& a, int first_block, int it_lo, int it_hi) {
    if (c.bx < first_block) return;
    LAS float* scr = (LAS float*)c.lds + c.wave * 64 * 33;
    for (int it = it_lo + (c.bx - first_block) * 8 + c.wave; it < it_hi; it += (c.G - first_block) * 8) wconv_item(it, a.in[10], a.in[11], a.in[29], a.in[30], a.ws, scr, c.lane);
}
__device__ __forceinline__ void p_mod(const Ctx& c, const MKArgs& a, int l_lo, int l_hi, int first_block = 0) {
    LAS float* sc = (LAS float*)(c.lds + 67584); LAS float* red = sc + 3 * D;
    const float* cvec = a.in[1]; const float* cctx = a.in[3]; const float* ada_w = a.in[4]; const float* ada_b = a.in[5]; float* MOD = (float*)(a.ws + WS_MOD);
    for (int i = c.tid; i < 3 * D; i += 512) { const int cd = i / D, k = i % D; const float v = cd < 2 ? cvec[cd * D + k] : cctx[k]; sc[i] = v / (1.0f + expf(-v)); }
    __syncthreads();
    for (int item = l_lo * 96 + (c.bx - first_block); c.bx >= first_block && item < l_hi * 96; item += c.G - first_block) {
        const int l = item / 96, n = (item % 96) * 64 + c.lane;
        const float* w = ada_w + (size_t)l * D * 6 * D + (size_t)(128 * c.wave) * 6 * D + n;
        float a0 = 0.f, a1 = 0.f, a2 = 0.f;
#pragma unroll 32
        for (int k = 0; k < 128; ++k) { const float wv = w[(size_t)k * 6 * D]; const int kk = 128 * c.wave + k; a0 += sc[kk] * wv; a1 += sc[D + kk] * wv; a2 += sc[2 * D + kk] * wv; }
        red[(c.wave * 3 + 0) * 64 + c.lane] = a0; red[(c.wave * 3 + 1) * 64 + c.lane] = a1; red[(c.wave * 3 + 2) * 64 + c.lane] = a2;
        __syncthreads();
        if (c.tid < 192) { const int cd = c.tid >> 6, ln = c.tid & 63; float s = ada_b[l * 6 * D + (item % 96) * 64 + ln];
#pragma unroll
            for (int w8 = 0; w8 < 8; ++w8) s += red[(w8 * 3 + cd) * 64 + ln];
            MOD[(size_t)(l * 3 + cd) * 6 * D + (item % 96) * 64 + ln] = s; }
        __syncthreads();
    }
}
__device__ __forceinline__ void p_filt_h2(const Ctx& c, const MKArgs& a, int l_lo, int l_hi, int first_block = 0) {
    LAS float* z = (LAS float*)(c.lds + 90112); LAS float* h1 = z + 8 * 36;
    const float* w1 = a.in[14]; const float* b1 = a.in[15]; const float* w2 = a.in[16]; const float* b2 = a.in[17]; const float* freq = a.in[19]; float* H2 = (float*)(a.ws + WS_H2);
    const int pl = c.tid >> 6, j = c.tid & 63;
    float W1c[33], W2c[64], b1v = 0.f, b2v = 0.f, f0 = 0.f, f1 = 0.f; int lcur = -1;
    for (int item = l_lo * (FPOS / 8) + (c.bx - first_block); c.bx >= first_block && item < l_hi * (FPOS / 8); item += c.G - first_block) {
        const int l = item / (FPOS / 8), p0 = (item % (FPOS / 8)) * 8, p = p0 + pl;
        if (l != lcur) { lcur = l;
#pragma unroll
            for (int i = 0; i < 33; ++i) W1c[i] = w1[l * 33 * 64 + i * 64 + j];
#pragma unroll
            for (int i = 0; i < 64; ++i) W2c[i] = w2[l * 64 * 64 + i * 64 + j];
            b1v = b1[l * 64 + j]; b2v = b2[l * 64 + j]; f0 = freq[(l * 2 + 0) * 64 + j]; f1 = freq[(l * 2 + 1) * 64 + j]; }
        const float t = p < SEQ ? (float)p / (float)SEQ : (float)(p - SEQ) / (float)CTXL;
        if (j < 33) { float v; if (j == 0) v = t; else { const int bnd = j <= 16 ? j : j - 16; float s, cs; sincospif(2.0f * t * (float)bnd, &s, &cs); v = j <= 16 ? cs : s; } z[pl * 36 + j] = v; }
        __syncthreads();
        float acc = b1v;
#pragma unroll
        for (int i4 = 0; i4 < 8; ++i4) { const f32x4 zv = *(const LAS f32x4*)(z + pl * 36 + 4 * i4); acc += zv[0] * W1c[4 * i4] + zv[1] * W1c[4 * i4 + 1] + zv[2] * W1c[4 * i4 + 2] + zv[3] * W1c[4 * i4 + 3]; }
        acc += z[pl * 36 + 32] * W1c[32];
        h1[pl * 64 + j] = sinf(f0 * acc);
        __syncthreads();
        float a2 = b2v;
#pragma unroll
        for (int i4 = 0; i4 < 16; ++i4) { const f32x4 hv = *(const LAS f32x4*)(h1 + pl * 64 + 4 * i4); a2 += hv[0] * W2c[4 * i4] + hv[1] * W2c[4 * i4 + 1] + hv[2] * W2c[4 * i4 + 2] + hv[3] * W2c[4 * i4 + 3]; }
        H2[((size_t)l * FPOS + p) * 64 + j] = sinf(f1 * a2);
    }
    __syncthreads();
}
__device__ __forceinline__ unsigned filt_lo2(float a0, float a1, unsigned ph) { return pg8::cvt_pk_bf16(a0 - __uint_as_float(ph << 16), a1 - __uint_as_float(ph & 0xffff0000u)); }
__device__ __forceinline__ void filt_split8(const f32x4& x0, const f32x4& x1, bf16x8& hi, bf16x8& lo) {
    u32x4 h, lw;
    h.x = pg8::cvt_pk_bf16(x0[0], x0[1]); h.y = pg8::cvt_pk_bf16(x0[2], x0[3]); h.z = pg8::cvt_pk_bf16(x1[0], x1[1]); h.w = pg8::cvt_pk_bf16(x1[2], x1[3]);
    lw.x = filt_lo2(x0[0], x0[1], h.x); lw.y = filt_lo2(x0[2], x0[3], h.y); lw.z = filt_lo2(x1[0], x1[1], h.z); lw.w = filt_lo2(x1[2], x1[3], h.w);
    hi = __builtin_bit_cast(bf16x8, h); lo = __builtin_bit_cast(bf16x8, lw);
}
__device__ __forceinline__ void p_filt_k(const Ctx& c, const MKArgs& a, int l, bool with_ctx, int first_block = 0) {
    if (c.bx < first_block) return;
    const float* H2l = (const float*)(a.ws + WS_H2) + (size_t)l * FPOS * 64; const float* w3l = a.in[18] + (size_t)l * 64 * 1024;
    bf16_t* KFB = (bf16_t*)(a.ws + WS_KF); float* KFC = (float*)(a.ws + WS_KFC);
    const int lane = c.lane, l15 = lane & 15, kg = lane >> 4;
    const int W = (c.bx - first_block) * 8 + c.wave, npg = ((c.G - first_block) * 8) >> 4, cg = W & 15, pg = W >> 4;
    const int ntile = (SEQ + (with_ctx ? CTXL : 0)) / 16;
    if (pg < npg) {
        const int c0 = cg * 64;
        bf16x8 Bh[4][2], Bl[4][2]; float dl[4];
#pragma unroll
        for (int ct = 0; ct < 4; ++ct) {
#pragma unroll
            for (int ks = 0; ks < 2; ++ks) { f32x4 w0, w1;
                const float* wp = w3l + (size_t)(32 * ks + 8 * kg) * 1024 + c0 + 16 * ct + l15; asm volatile("" : "+v"(wp));
#pragma unroll
                for (int i = 0; i < 4; ++i) { w0[i] = *wp; wp += 1024; asm volatile("" : "+v"(wp)); }
#pragma unroll
                for (int i = 0; i < 4; ++i) { w1[i] = *wp; wp += 1024; asm volatile("" : "+v"(wp)); }
                filt_split8(w0, w1, Bh[ct][ks], Bl[ct][ks]); }
            const int ch = (c0 + 16 * ct + l15) & 255; const float d0 = 15.350567286626973f, d1 = 3.0701134573253946f;
            dl[ct] = -1.4426950408889634f * (d0 + (d1 - d0) * ((float)ch / 255.0f)); }
        f32x4 xa[2][2];
        int pt = pg;
        if (pt < ntile) {
#pragma unroll
            for (int ks = 0; ks < 2; ++ks)
#pragma unroll
                for (int hf = 0; hf < 2; ++hf) xa[ks][hf] = *(const f32x4*)(H2l + (size_t)(pt * 16 + l15) * 64 + 32 * ks + 8 * kg + 4 * hf); }
#pragma unroll 1
        for (; pt < ntile; pt += npg) {
            bf16x8 Ah[2], Al[2];
#pragma unroll
            for (int ks = 0; ks < 2; ++ks) filt_split8(xa[ks][0], xa[ks][1], Ah[ks], Al[ks]);
            if (pt + npg < ntile) {
#pragma unroll
                for (int ks = 0; ks < 2; ++ks)
#pragma unroll
                    for (int hf = 0; hf < 2; ++hf) xa[ks][hf] = *(const f32x4*)(H2l + (size_t)((pt + npg) * 16 + l15) * 64 + 32 * ks + 8 * kg + 4 * hf); }
            const int p0 = pt * 16; const bool isctx = p0 >= SEQ; const int pb = (isctx ? p0 - SEQ : p0) + 4 * kg; const float invL = isctx ? 1.0f / (float)CTXL : 1.0f / (float)SEQ;
#pragma unroll
            for (int ct = 0; ct < 4; ++ct) {
                f32x4 acc = (f32x4){0.f, 0.f, 0.f, 0.f};
#pragma unroll
                for (int ks = 0; ks < 2; ++ks) { acc = __builtin_amdgcn_mfma_f32_16x16x32_bf16(Al[ks], Bh[ct][ks], acc, 0, 0, 0); acc = __builtin_amdgcn_mfma_f32_16x16x32_bf16(Ah[ks], Bl[ct][ks], acc, 0, 0, 0);
                    acc = __builtin_amdgcn_mfma_f32_16x16x32_bf16(Ah[ks], Bh[ct][ks], acc, 0, 0, 0); }
                const int col = c0 + 16 * ct + l15;
                f32x4 o;
#pragma unroll
                for (int r = 0; r < 4; ++r) o[r] = acc[r] * __builtin_amdgcn_exp2f((float)(pb + r) * invL * dl[ct]);
                if (isctx) *(f32x4*)(KFC + (size_t)col * CTXL + pb) = o;
                else { u32x2 w; w.x = pg8::cvt_pk_bf16(o[0], o[1]); w.y = pg8::cvt_pk_bf16(o[2], o[3]); *(u32x2*)(KFB + (size_t)col * SEQ + pb) = w; }
            }
        }
    }
    __syncthreads();
}
__device__ __forceinline__ void p_rownorm0(const Ctx& c, const MKArgs& a) {
    const float* x = a.in[0]; const float* ctx = a.in[2]; const float* g = a.in[6]; const float* MOD0 = (const float*)(a.ws + WS_MOD); bf16_t* H = (bf16_t*)(a.ws + WS_H);
    const int lane = c.lane;
    for (int row0 = 2 * (c.bx * 8 + c.wave); row0 < MT; row0 += 2 * c.G * 8) {
        f32x4 v[2][4]; float ss[2] = {0.f, 0.f}; int cond[2];
#pragma unroll
        for (int r = 0; r < 2; ++r) { const int row = row0 + r; const bool isctx = row >= NLAT; cond[r] = isctx ? 2 : row / SEQ;
            const float* xr = isctx ? ctx + (size_t)(row - NLAT) * D : x + (size_t)row * D;
#pragma unroll
            for (int j = 0; j < 4; ++j) v[r][j] = __builtin_nontemporal_load((const f32x4*)(xr + 4 * lane + 256 * j)); }
#pragma unroll
        for (int r = 0; r < 2; ++r)
#pragma unroll
            for (int j = 0; j < 4; ++j) ss[r] += v[r][j][0] * v[r][j][0] + v[r][j][1] * v[r][j][1] + v[r][j][2] * v[r][j][2] + v[r][j][3] * v[r][j][3];
#pragma unroll
        for (int o = 1; o < 64; o <<= 1) { ss[0] += __shfl_xor(ss[0], o); ss[1] += __shfl_xor(ss[1], o); }
#pragma unroll
        for (int r = 0; r < 2; ++r) { const float rinv = 1.0f / sqrtf(ss[r] * (1.0f / D) + 1e-6f);
            const float* sh = MOD0 + (size_t)cond[r] * 6 * D; const float* sc = sh + D;
#pragma unroll
            for (int j = 0; j < 4; ++j) { const int col = 4 * lane + 256 * j; const f32x4 gv = *(const f32x4*)(g + col), scv = *(const f32x4*)(sc + col), shv = *(const f32x4*)(sh + col);
                float o[4];
#pragma unroll
                for (int e = 0; e < 4; ++e) o[e] = v[r][j][e] * rinv * gv[e] * (1.0f + scv[e]) + shv[e];
                u32x2 w; w.x = pg8::cvt_pk_bf16(o[0], o[1]); w.y = pg8::cvt_pk_bf16(o[2], o[3]); *(u32x2*)(H + (size_t)(row0 + r) * D + col) = w; } }
    }
}
__device__ __forceinline__ void p_rowpass(const Ctx& c, const bf16_t* Y, const float* xin_lat, const float* xin_ctx, float* xout_lat, float* xout_ctx, const float* g_post, const float* modp, int gate_idx,
                                          const float* g_next, const float* modn, int nidx, bf16_t* H, int nrows, bool xin_bf, bool xout_bf) {
    LAS float* VA = (LAS float*)c.lds; LAS float* VB = VA + 3 * D; LAS float* VC = VB + 3 * D;
    __syncthreads();
    for (int i = c.tid; i < 3 * D; i += 512) { const int cd = i / D, col = i % D;
        VA[i] = modp[(size_t)cd * 6 * D + gate_idx * D + col] * g_post[col];
        if (g_next) { VB[i] = g_next[col] * (1.0f + modn[(size_t)cd * 6 * D + (nidx + 1) * D + col]); VC[i] = modn[(size_t)cd * 6 * D + nidx * D + col]; } }
    __syncthreads();
    const int lane = c.lane;
    constexpr int NR = 2;
    for (int row0 = NR * (c.bx * 8 + c.wave); row0 < nrows; row0 += NR * c.G * 8) {
        float y[NR][4][4]; f32x4 xv[NR][4]; float ss[NR]; int cond[NR]; float* xo[NR];
#pragma unroll
        for (int r = 0; r < NR; ++r) { ss[r] = 0.f; const int row = row0 + r; const bool isctx = row >= NLAT; cond[r] = isctx ? 2 : row / SEQ;
            const float* xi = isctx ? xin_ctx + (size_t)(row - NLAT) * D : xin_lat + (size_t)row * D;
            xo[r] = isctx ? xout_ctx + (size_t)(row - NLAT) * D : xout_lat + (size_t)row * D;
            if (xin_bf && !isctx) {
#pragma unroll
                for (int j = 0; j < 4; ++j) { const u32x2 w = __builtin_nontemporal_load((const u32x2*)(Y + (size_t)row * D + 4 * lane + 256 * j)); const u32x2 xw = __builtin_nontemporal_load((const u32x2*)((const bf16_t*)xi + 4 * lane + 256 * j));
                    xv[r][j][0] = bf2f(xw.x & 0xffffu); xv[r][j][1] = bf2f(xw.x >> 16); xv[r][j][2] = bf2f(xw.y & 0xffffu); xv[r][j][3] = bf2f(xw.y >> 16);
                    y[r][j][0] = bf2f(w.x & 0xffffu); y[r][j][1] = bf2f(w.x >> 16); y[r][j][2] = bf2f(w.y & 0xffffu); y[r][j][3] = bf2f(w.y >> 16); }
            } else {
#pragma unroll
                for (int j = 0; j < 4; ++j) { const u32x2 w = __builtin_nontemporal_load((const u32x2*)(Y + (size_t)row * D + 4 * lane + 256 * j)); xv[r][j] = __builtin_nontemporal_load((const f32x4*)(xi + 4 * lane + 256 * j));
                    y[r][j][0] = bf2f(w.x & 0xffffu); y[r][j][1] = bf2f(w.x >> 16); y[r][j][2] = bf2f(w.y & 0xffffu); y[r][j][3] = bf2f(w.y >> 16); }
            } }
#pragma unroll
        for (int r = 0; r < NR; ++r)
#pragma unroll
            for (int j = 0; j < 4; ++j) ss[r] += y[r][j][0] * y[r][j][0] + y[r][j][1] * y[r][j][1] + y[r][j][2] * y[r][j][2] + y[r][j][3] * y[r][j][3];
#pragma unroll
        for (int o = 1; o < 64; o <<= 1) {
#pragma unroll
            for (int r = 0; r < NR; ++r) ss[r] += __shfl_xor(ss[r], o); }
        float s2[NR];
#pragma unroll
        for (int r = 0; r < NR; ++r) { s2[r] = 0.f; const float rinv = 1.0f / sqrtf(ss[r] * (1.0f / D) + 1e-6f);
#pragma unroll
            for (int j = 0; j < 4; ++j) { const int col = 4 * lane + 256 * j; const f32x4 av = *(const LAS f32x4*)(VA + cond[r] * D + col);
#pragma unroll
                for (int e = 0; e < 4; ++e) { xv[r][j][e] += av[e] * (y[r][j][e] * rinv); s2[r] += xv[r][j][e] * xv[r][j][e]; }
                if (xout_bf && cond[r] != 2) { u32x2 xw; xw.x = pg8::cvt_pk_bf16(xv[r][j][0], xv[r][j][1]); xw.y = pg8::cvt_pk_bf16(xv[r][j][2], xv[r][j][3]); __builtin_nontemporal_store(xw, (u32x2*)((bf16_t*)xo[r] + col)); }
                else __builtin_nontemporal_store(xv[r][j], (f32x4*)(xo[r] + col)); } }
        if (g_next) {
#pragma unroll
            for (int o = 1; o < 64; o <<= 1) {
#pragma unroll
                for (int r = 0; r < NR; ++r) s2[r] += __shfl_xor(s2[r], o); }
#pragma unroll
            for (int r = 0; r < NR; ++r) { const float r2 = 1.0f / sqrtf(s2[r] * (1.0f / D) + 1e-6f);
#pragma unroll
                for (int j = 0; j < 4; ++j) { const int col = 4 * lane + 256 * j; const f32x4 bv = *(const LAS f32x4*)(VB + cond[r] * D + col), cv = *(const LAS f32x4*)(VC + cond[r] * D + col);
                    u32x2 w; w.x = pg8::cvt_pk_bf16(xv[r][j][0] * r2 * bv[0] + cv[0], xv[r][j][1] * r2 * bv[1] + cv[1]); w.y = pg8::cvt_pk_bf16(xv[r][j][2] * r2 * bv[2] + cv[2], xv[r][j][3] * r2 * bv[3] + cv[3]);
                    *(u32x2*)(H + (size_t)(row0 + r) * D + col) = w; } }
        }
    }
    __syncthreads();
}
__device__ __forceinline__ void p_hy_transpose(const Ctx& c, const bf16_t* YHT, bf16_t* YMIX, bool shift8) {
    constexpr int PITCH = 272;
    const bool sh = shift8 && c.G == 256;
    for (int item = sh ? (c.bx < 8 ? NLAT : (c.bx < 16 ? c.bx - 8 : c.bx)) : c.bx; item < NLAT / 128; item += (sh ? (item < 8 ? 8 : NLAT) : c.G)) {
        const int tok0 = item * 128;
        __syncthreads();
        { u32x4 v[8];
#pragma unroll
          for (int i = 0; i < 8; ++i) { const int e = c.tid + 512 * i, ch = e >> 4, pc = e & 15; v[i] = *(const u32x4*)(YHT + (size_t)ch * MT + tok0 + 8 * pc); }
#pragma unroll
          for (int i = 0; i < 8; ++i) { const int e = c.tid + 512 * i, ch = e >> 4, pc = e & 15; *(LAS u32x4*)(c.lds + ch * PITCH + pc * 16) = v[i]; } }
        __syncthreads();
        const int tok = c.tid >> 2, qt = c.tid & 3;
#pragma unroll
        for (int s8 = 0; s8 < 8; ++s8) { const int ch0 = 64 * qt + 8 * s8; unsigned h[8];
#pragma unroll
            for (int j = 0; j < 8; ++j) h[j] = *(const LAS bf16_t*)(c.lds + (ch0 + j) * PITCH + tok * 2);
            u32x4 o; o.x = h[0] | (h[1] << 16); o.y = h[2] | (h[3] << 16); o.z = h[4] | (h[5] << 16); o.w = h[6] | (h[7] << 16);
            *(u32x4*)(YMIX + (size_t)(tok0 + tok) * D + ch0) = o; }
    }
    __syncthreads();
}
__device__ __forceinline__ float conv3_at(const bf16_t* rowp, int s, int Lseq, float w0, float w1, float w2, float bias) {
    float v = bias + w1 * bf2f(rowp[s]);
    if (s > 0) v += w0 * bf2f(rowp[s - 1]);
    if (s + 1 < Lseq) v += w2 * bf2f(rowp[s + 1]);
    return v;
}
__device__ __forceinline__ void hy_ctx_unit(const Ctx& cx, int c, const bf16_t* PTV, const float* KFC, const float* cw, const float* cb, const float* hbias, bf16_t* YMIX) {
    LAS float* zin = (LAS float*)cx.lds; LAS float* kc = zin + 512; LAS float* red = kc + 512; LAS float* part = red + 16;
    const int tid = cx.tid, b = tid >> 8, t = tid & 255, lane = tid & 63, wave = tid >> 6;
    const int og = 4 * (tid & 127), sq = tid >> 7, b2 = og >> 8, t2 = og & 255;
    const bf16_t* base = PTV + NLAT + b * CTXL;
    float zcur = conv3_at(base + (size_t)c * MT, t, CTXL, cw[c], cw[768 + c], cw[1536 + c], cb[c]);
    for (int order = 0; order < 2; ++order) {
        __syncthreads();
        zin[b * 256 + t] = zcur;
        const float* kf = KFC + (size_t)((order * 2 + 0) * 256 + c) * CTXL; const float* kb = KFC + (size_t)((order * 2 + 1) * 256 + c) * CTXL;
        float kv = 0.f; if (tid >= 1) { const int d = tid - 256; kv = d >= 0 ? kf[d] : kb[-d]; } kc[tid] = kv;
        const float s = wave_sum(fabsf(kv)); if (lane == 0) red[wave] = s;
        __syncthreads();
        float tot = 0.f;
#pragma unroll
        for (int i = 0; i < 8; ++i) tot += red[i];
        {   f32x4 a4 = (f32x4){0.f, 0.f, 0.f, 0.f};
#pragma unroll 4
            for (int s2 = 64 * sq; s2 < 64 * sq + 64; s2 += 4) {
                const f32x4 z4 = *(const LAS f32x4*)(zin + b2 * 256 + s2);
                const f32x4 k0 = *(const LAS f32x4*)(kc + t2 - s2 + 252), k1 = *(const LAS f32x4*)(kc + t2 - s2 + 256);
                const float k8[8] = {k0[0], k0[1], k0[2], k0[3], k1[0], k1[1], k1[2], k1[3]};
#pragma unroll
                for (int i = 0; i < 4; ++i)
#pragma unroll
                    for (int j = 0; j < 4; ++j) a4[i] += k8[4 + i - j] * z4[j]; }
            *(LAS f32x4*)(part + sq * 512 + og) = a4; }
        __syncthreads();
        const float acc = (part[tid] + part[512 + tid]) + (part[1024 + tid] + part[1536 + tid]);
        const int grow = (order == 0 ? 256 : 512) + c;
        const float gate = conv3_at(base + (size_t)grow * MT, t, CTXL, cw[grow], cw[768 + grow], cw[1536 + grow], cb[grow]);
        zcur = gate * (acc / tot + hbias[order * 256 + c] * zcur);
    }
    YMIX[(size_t)(NLAT + b * CTXL + t) * D + c] = (bf16_t)f2bf(zcur);
    __syncthreads();
}
}

__global__ void __launch_bounds__(512, 2) mk_fwd(MKArgs a) {
    extern __shared__ __attribute__((aligned(16))) unsigned char lds_raw[];
    cg::grid_group grid = cg::this_grid();
    mk::Ctx c; c.lds = (LAS unsigned char*)lds_raw; c.tid = threadIdx.x; c.lane = c.tid & 63; c.wave = __builtin_amdgcn_readfirstlane(c.tid >> 6); c.G = gridDim.x; c.bx = blockIdx.x;
#define FRESH() do { c.tid = opaque_i(threadIdx.x); c.lane = c.tid & 63; c.wave = __builtin_amdgcn_readfirstlane(c.tid >> 6); } while (0)
    unsigned char* ws = a.ws; float* out = a.out;
    bf16_t* Win_t = (bf16_t*)(ws + WS_WIN); bf16_t* Wout_t = (bf16_t*)(ws + WS_WOUT); bf16_t* Wgu_t = (bf16_t*)(ws + WS_WGU); bf16_t* Wdn_t = (bf16_t*)(ws + WS_WDN);
    float* MOD = (float*)(ws + WS_MOD); float* XC = (float*)(ws + WS_XC);
    bf16_t* H = (bf16_t*)(ws + WS_H); bf16_t* Y = (bf16_t*)(ws + WS_Y); bf16_t* PTV = (bf16_t*)(ws + WS_PTV); bf16_t* QKL = (bf16_t*)(ws + WS_QKL); bf16_t* ACT = (bf16_t*)(ws + WS_ACT);
    bf16_t* YMIX = (bf16_t*)(ws + WS_YMIX); fft::spec_t* KFS = (fft::spec_t*)(ws + WS_H); f32x2* HSCR = (f32x2*)(ws + WS_KF);
    const int lo = a.ph_lo, hi = a.ph_hi;
    unsigned* barw = (unsigned*)(ws + WS_CTL);
    if (lo > hi) grid.sync();
    if (c.tid < 16) ((LAS unsigned*)(c.lds + MK_LDS_BYTES - 64))[c.tid] = 0u;
    __syncthreads();
    XcdBarrier xbar; xbar.bar = barw; xbar.x = 0; xbar.st = (volatile LAS unsigned*)(c.lds + MK_LDS_BYTES - 64);
    if (hi - lo > 1) xbar = xcd_barrier_post(barw, (volatile LAS unsigned*)(c.lds + MK_LDS_BYTES - 64));
    pg8::Epi E;
#define IN(k) (lo <= (k) && (k) < hi)
#define SEAM(k) do { if (IN(k) && IN((k) + 1)) xcd_barrier(xbar); } while (0)
#ifndef MK_DUP
#define MK_DUP 0
#endif
#ifndef MK_DUP2
#define MK_DUP2 0
#endif
#ifndef MK_DUPN
#define MK_DUPN 1
#endif
#define REP2(b) for (int rep2_ = 0; rep2_ <= (int)((l == 1) && (((unsigned)(MK_DUP2) >> (b)) & 1u)) * MK_DUPN; ++rep2_)
#define REP(k) for (int rep_ = 0; rep_ <= (int)(((unsigned)(MK_DUP) >> (k)) & 1u); ++rep_)
    if (IN(0)) REP(0) { FRESH(); mk::p_weights(c, a); __syncthreads(); mk::p_mod(c, a, 0, DEPTH); mk::p_filt_h2(c, a, 0, (c.G == 256) ? 1 : DEPTH); }
    SEAM(0);
#ifdef MK_XSYNC
    if (lo == 0 && hi == NPHASE) for (int i_ = 0; i_ < MK_XSYNC; ++i_) xcd_barrier(xbar);
#endif
    if (IN(1)) REP(1) { FRESH();
#pragma unroll 1
        for (int stg = 0; stg < 2; ++stg) { if ((stg ^ ((c.bx >> 3) & 1)) == 0) mk::p_rownorm0(c, a); else mk::p_filt_k(c, a, 0, true); } }
    SEAM(1);
#pragma unroll 1
    for (int l = 0; l < DEPTH; ++l) {
        const int pb = 2 + 9 * l; const bool lastl = (l == DEPTH - 1);
        const float* modl = MOD + (size_t)l * 3 * 6 * D;
        const int nrows = lastl ? NLAT : MT;
        if (IN(pb + 0)) REP(pb + 0) {
            pg8::Sched S; const bf16_t* W = Win_t + (size_t)l * INW * D;
            const bf16_t* Hin = (l == 0) ? H : YMIX;
            S.ph.s0 = pg8::GSeg{W, Hin, PTV, NPTV / 256, MT / 256, MT, 0}; S.ph.s1 = pg8::GSeg{Hin, W + (size_t)NPTV * D, QKL, MT / 256, NQKL / 256, NQKL, 0};
            S.ph.n0 = (NPTV / 256) * (MT / 256); S.ph.total = S.ph.n0 + (MT / 256) * (NQKL / 256); S.ph.K = D; S.ph.pad = 0; S.G = c.G; S.c = c.bx;
            pg8::gemm_phase(c.lds, S, E);
            if (l == 0 && c.G == 256) { FRESH(); mk::p_weights_late(c, a, 150, WI_IN, WI_LAYER); }
        }
        SEAM(pb + 0);
        if (IN(pb + 1)) REP(pb + 1) {
            const bf16_t* KF = (const bf16_t*)(ws + WS_KF);
            const int rot = (c.bx >> 3) % 3;
#pragma unroll 1
            for (int stg = 0; stg < 3; ++stg) { const int which = (stg + rot) % 3;
                __syncthreads();
                if (which == 0) {
                    REP2(0) for (int u = (l == 0 || c.G != 256) ? c.bx : 512; u < 512; u += c.G)     { const int order = u >> 8, ch = u & 255;
                        fft::filter_unit(c.lds, KF + (size_t)((order * 2 + 0) * 256 + ch) * SEQ, KF + (size_t)((order * 2 + 1) * 256 + ch) * SEQ, KFS + ((size_t)order * 256 + ch) * 2 * SEQ); }
                } else if (which == 1) {
                    na::Params np{QKL, PTV + (size_t)768 * MT, a.in[21] + (size_t)l * 8 * 15 * 31, YMIX}; const int nunits = lastl ? 512 : 544;
                    REP2(1) { for (int u = c.bx; u < 512; u += c.G) na::latent_unit(c.lds, np, u
#ifdef MK_NA_PM
                            , (rep2_ < (int)((l == 1) && ((MK_DUP2 >> 1) & 1u)) * MK_DUPN) ? MK_NA_PM : 0
#endif
                            );
                        if (nunits > 512) for (int u = c.bx - 8; u >= 0 && u < 32; u += c.G) na::ctx_unit(c.lds, np, u); }
                } else {
                    lru::Params lp{QKL, (const bf16_t*)(ws + WS_LW) + (size_t)l * 2 * 4 * 2 * 64 * 64, a.in[22] + (size_t)l * 4 * 256, a.in[23] + (size_t)l * 256, a.in[25] + (size_t)l * 512, a.in[27] + (size_t)l * 512,
                                    a.in[28] + (size_t)l * 512, (f32x2*)(ws + WS_AGG), YMIX};
                    REP2(2) { if (c.G == 256) { lru::super_unit<false>(c.lds, lp, c.bx);
                                  const int hu = c.bx < 8 ? c.bx : (c.bx >= 40 && c.bx < 48 ? c.bx - 32 : -1);
                                  if (hu >= 0) lru::super_unit<false>(c.lds, lp, 256 + (hu >> 1), 1 + (hu & 1)); }
                              else for (int su = c.bx; su < 264; su += c.G) lru::super_unit<false>(c.lds, lp, su); }
                }
            }
            if (!lastl) { __syncthreads(); FRESH();
                const bool hskip = c.G == 256 && (c.bx < 8 || (c.bx >= 40 && c.bx < 48));
                const int hextra = (c.G == 256 && c.bx >= 48 && c.bx < 64) ? (c.bx < 56 ? c.bx - 48 : c.bx - 16) : -1;
                for (int u = hskip ? 256 : c.bx; u < 256; u += c.G) mk::hy_ctx_unit(c, u, PTV, (const float*)(ws + WS_KFC), a.in[12] + (size_t)l * 3 * 768, a.in[13] + (size_t)l * 768, a.in[20] + (size_t)l * 512, YMIX);
                if (hextra >= 0) mk::hy_ctx_unit(c, hextra, PTV, (const float*)(ws + WS_KFC), a.in[12] + (size_t)l * 3 * 768, a.in[13] + (size_t)l * 768, a.in[20] + (size_t)l * 512, YMIX); }
        }
        if (!(l != 0 && c.G == 256 && lo == 0 && hi == NPHASE)) SEAM(pb + 1);
        if (IN(pb + 2)) REP(pb + 2) {
            unsigned* Zs = (unsigned*)HSCR + (size_t)c.bx * SEQ; unsigned* Rs = (unsigned*)HSCR + (size_t)(256 + c.bx) * SEQ;
            REP2(3) for (int u = c.bx; u < 256; u += c.G) { const int ch = (c.G == 256) ? (u & 7) * 32 + (u >> 3) : u;
                fft::hyena_unit(c.lds, ch, PTV, KFS + (size_t)ch * 2 * SEQ, (size_t)256 * 2 * SEQ, a.in[12] + (size_t)l * 3 * 768, a.in[13] + (size_t)l * 768, a.in[20] + (size_t)l * 512, Zs, Rs, (bf16_t*)(ws + WS_YHT)); }
        }
        SEAM(pb + 2);
        if (IN(pb + 3)) REP(pb + 3) {
#pragma unroll 1
            for (int stg = 0; stg < 2; ++stg) { const int which = stg ^ ((c.bx >> 3) & 1);
                __syncthreads();
                if (which == 0) { FRESH(); mk::p_hy_transpose(c, (const bf16_t*)(ws + WS_YHT), YMIX, !lastl); }
                else {
                    lru::Params lp{QKL, (const bf16_t*)(ws + WS_LW) + (size_t)l * 2 * 4 * 2 * 64 * 64, a.in[22] + (size_t)l * 4 * 256, a.in[23] + (size_t)l * 256, a.in[25] + (size_t)l * 512, a.in[27] + (size_t)l * 512,
                                    a.in[28] + (size_t)l * 512, (f32x2*)(ws + WS_AGG), YMIX};
                    REP2(4) for (int su = c.bx; su < (lastl ? 256 : 264); su += c.G) lru::super_unit<true>(c.lds, lp, su);
                }
            }
        }
        SEAM(pb + 3);
        if (IN(pb + 4)) REP(pb + 4) {
            pg8::Sched S; const int nMt = (lastl ? NLAT : MT) / 256; S.ph.s0 = pg8::GSeg{YMIX, Wout_t + (size_t)l * D * D, Y, nMt, D / 256, D, 0}; S.ph.s1 = S.ph.s0; S.ph.n0 = S.ph.total = nMt * (D / 256); S.ph.K = D; S.ph.pad = 0; S.G = c.G; S.c = c.bx;
            pg8::gemm_phase(c.lds, S, E);
            if (l == 0 && c.G == 256) { FRESH(); mk::p_filt_h2(c, a, 1, DEPTH, 8); }
        }
        SEAM(pb + 4);
        if (IN(pb + 5)) { FRESH();
#ifdef MK_DUP_RP
            if (l == 1) mk::p_rowpass(c, YMIX, a.in[0], XC, (float*)(ws + WS_PTV), (float*)(ws + WS_PTV) + (size_t)NLAT * D, a.in[7] + (size_t)l * D, modl, 2, a.in[8] + (size_t)l * D, modl, 3, (bf16_t*)(ws + WS_KF), NLAT, false, false);
#endif
            mk::p_rowpass(c, Y, l == 0 ? a.in[0] : out, l == 0 ? a.in[2] : XC, out, XC, a.in[7] + (size_t)l * D, modl, 2, a.in[8] + (size_t)l * D, modl, 3, H, nrows, l != 0, true);
            if (!lastl && c.G != 256) mk::p_filt_k(c, a, l + 1, false);
        }
        SEAM(pb + 5);
        if (IN(pb + 6)) REP(pb + 6) {
            pg8::Sched S; const int nMt = (lastl ? NLAT : MT) / 256; S.ph.s0 = pg8::GSeg{H, Wgu_t + (size_t)l * 2 * DFF * D, ACT, nMt, 2 * DFF / 256, DFF, 1}; S.ph.s1 = S.ph.s0; S.ph.n0 = S.ph.total = nMt * (2 * DFF / 256); S.ph.K = D; S.ph.pad = 0; S.G = c.G; S.c = c.bx;
            pg8::gemm_phase(c.lds, S, E);
            if (!lastl && c.G == 256) { FRESH(); mk::p_weights_late(c, a, 44, (l + 1) * WI_LAYER, (l + 2) * WI_LAYER); __syncthreads(); mk::p_filt_k(c, a, l + 1, false, 44); }
        }
        SEAM(pb + 6);
        if (IN(pb + 7)) REP(pb + 7) {
            pg8::Sched S; const int nMt = (lastl ? NLAT : MT) / 256; S.ph.s0 = pg8::GSeg{ACT, Wdn_t + (size_t)l * D * DFF, Y, nMt, D / 256, D, 0}; S.ph.s1 = S.ph.s0; S.ph.n0 = S.ph.total = nMt * (D / 256); S.ph.K = DFF; S.ph.pad = 0; S.G = c.G; S.c = c.bx;
            pg8::gemm_phase(c.lds, S, E);
            if (!lastl && c.G == 256 && c.bx >= 8) {
                const bf16_t* KF = (const bf16_t*)(ws + WS_KF);
                for (int u = 2 * (c.bx - 8); u < 2 * (c.bx - 8) + 2; ++u) { const int order = u >> 8, ch = u & 255;
                    fft::filter_unit(c.lds, KF + (size_t)((order * 2 + 0) * 256 + ch) * SEQ, KF + (size_t)((order * 2 + 1) * 256 + ch) * SEQ, KFS + ((size_t)order * 256 + ch) * 2 * SEQ); }
            }
        }
        SEAM(pb + 7);
        if (IN(pb + 8)) { FRESH();
            mk::Ctx c2 = c; bool dofilt = false;
            if (!lastl && c.G == 256) { dofilt = c.bx >= 16 && c.bx < 32; c2.bx = c.bx < 16 ? c.bx : c.bx - 16; c2.G = 240; }
            if (dofilt) { const bf16_t* KF = (const bf16_t*)(ws + WS_KF); const int u = FEARLY + c.bx - 16, order = u >> 8, ch = u & 255;
                fft::filter_unit(c.lds, KF + (size_t)((order * 2 + 0) * 256 + ch) * SEQ, KF + (size_t)((order * 2 + 1) * 256 + ch) * SEQ, KFS + ((size_t)order * 256 + ch) * 2 * SEQ); }
            else mk::p_rowpass(c2, Y, out, XC, out, XC, a.in[9] + (size_t)l * D, modl, 5, lastl ? (const float*)nullptr : a.in[6] + (size_t)(l + 1) * D, lastl ? modl : modl + 3 * 6 * D, 0, YMIX, nrows, true, !lastl);
        }
        SEAM(pb + 8);
    }
#undef IN
#undef SEAM
#undef REP
#undef REP2
}

#ifndef MK_N_LAUNCHES
#define MK_N_LAUNCHES 1
#endif
extern "C" void kernel_launch(void* const* d_in, const int* in_sizes, int n_in, void* d_out, int out_size, void* d_ws, size_t ws_size, hipStream_t stream) {
    static int grid = 0;
    if (grid == 0) {
        if (n_in != 31 || in_sizes[0] != NLAT * D || out_size != NLAT * D || ws_size < WS_END) { fprintf(stderr, "kernel_launch: unexpected shapes (n_in %d, in0 %d, out %d, ws %zu)\n", n_in, n_in > 0 ? in_sizes[0] : -1, out_size, ws_size); grid = -1; return; }
        if (hipFuncSetAttribute((const void*)mk_fwd, hipFuncAttributeMaxDynamicSharedMemorySize, MK_LDS_BYTES) != hipSuccess) { fprintf(stderr, "kernel_launch: hipFuncSetAttribute failed\n"); grid = -1; return; }
        int dev = 0, cus = 0, per_cu = 0;
        hipGetDevice(&dev); hipDeviceGetAttribute(&cus, hipDeviceAttributeMultiprocessorCount, dev);
        hipOccupancyMaxActiveBlocksPerMultiprocessor(&per_cu, (const void*)mk_fwd, 512, MK_LDS_BYTES);
        if (per_cu < 1) { fprintf(stderr, "kernel_launch: occupancy query says %d workgroups per CU\n", per_cu); per_cu = 1; }
        grid = cus * per_cu; if (grid > 256) grid = 256;
        (void)hipGetLastError();
    }
    if (grid < 0) return;
    MKArgs a{};
    for (int i = 0; i < 31; ++i) a.in[i] = (const float*)d_in[i];
    a.out = (float*)d_out; a.ws = (unsigned char*)d_ws;
    if (MK_N_LAUNCHES == 1) {
        a.ph_lo = 0; a.ph_hi = NPHASE;
        if (hipMemsetAsync((char*)d_ws + WS_CTL, 0, XCD_BAR_WORDS * 4, stream) != hipSuccess) { fprintf(stderr, "kernel_launch: hipMemsetAsync of the barrier words failed\n"); return; }
        void* args[] = {&a};
        const hipError_t e = hipLaunchCooperativeKernel((const void*)mk_fwd, dim3(grid), dim3(512), args, MK_LDS_BYTES, stream);
        if (e != hipSuccess) fprintf(stderr, "kernel_launch: cooperative launch failed: %s (grid %d)\n", hipGetErrorString(e), grid);
    } else {
        for (int p = 0; p < NPHASE; ++p) { a.ph_lo = p; a.ph_hi = p + 1; hipLaunchKernelGGL(mk_fwd, dim3(grid), dim3(512), MK_LDS_BYTES, stream, a); }
    }
}
```
